# Optimizing an MI355X kernel written in HIP

```python
import math
import jax, jax.numpy as jnp
from jax import lax
import numpy as np

D_MODEL = 2048
BATCH = 2
SEQ = 8192
DEPTH = 4

SSD_WIDTH = D_MODEL // 2
NSA_WIDTH = D_MODEL // 4
CONV_CH = D_MODEL // 4
D_MIX = SSD_WIDTH + NSA_WIDTH + CONV_CH
SSD_HEAD_DIM = 64
SSD_HEADS = SSD_WIDTH // SSD_HEAD_DIM
SSD_GROUPS = 2
SSD_STATE = 128
SSD_CONV = 4
SSD_CHUNK = 128
SSD_XBC = SSD_WIDTH + 2 * SSD_GROUPS * SSD_STATE
NSA_HEAD_DIM = 64
NSA_HEADS = NSA_WIDTH // NSA_HEAD_DIM
NSA_KV_GROUPS = 2
NSA_KV = NSA_KV_GROUPS * NSA_HEAD_DIM
CMP_BLOCK = 32
CMP_STRIDE = 16
CMP_HIDDEN = 256
SLC_BLOCK = 64
SLC_TOPN = 16
WINDOW = 512
Q_BLOCK = 128
FORCE_BONUS = 1000.0
CONV_KERNEL = 31
D_FF = 5632
HALF = 0.5
EPS = 1e-6
NEG = -1e30

IN_SPLITS = (SSD_WIDTH, SSD_XBC, SSD_HEADS,
             NSA_WIDTH, NSA_KV, NSA_KV, NSA_KV, NSA_KV, NSA_KV, NSA_KV, 3 * NSA_HEADS,
             2 * CONV_CH)
D_IN = sum(IN_SPLITS)

kernel_name = "hybrid_ssd_nsa_conformer_macaron"

F32 = jnp.float32


def rms_norm(u, w):
    uf = u.astype(F32)
    y = uf * lax.rsqrt(jnp.mean(uf * uf, axis=-1, keepdims=True) + EPS)
    return (y * w.astype(F32)).astype(u.dtype)


def swiglu(u, w_gu, w_down):
    g, v = jnp.split(u @ w_gu, 2, axis=-1)
    return (jax.nn.silu(g) * v) @ w_down


def causal_depthwise_conv(u, w, b):
    k, c = w.shape
    y = lax.conv_general_dilated(u, w[:, None, :].astype(u.dtype), window_strides=(1,),
                                 padding=[(k - 1, 0)], dimension_numbers=('NWC', 'WIO', 'NWC'),
                                 feature_group_count=c)
    return y + b.astype(y.dtype)


def masked_softmax(s, valid):
    s = jnp.where(valid, s.astype(F32), NEG)
    return jax.nn.softmax(s, axis=-1) * valid


def ssd_scan(x, dt, a, bm, cm):
    bsz, s, h, p = x.shape
    g, n = bm.shape[2], bm.shape[3]
    hg = h // g
    l = SSD_CHUNK
    nc = s // l
    xc = x.astype(F32).reshape(bsz, nc, l, g, hg, p)
    dtc = dt.reshape(bsz, nc, l, g, hg)
    bc = bm.astype(F32).reshape(bsz, nc, l, g, n)
    cc = cm.astype(F32).reshape(bsz, nc, l, g, n)
    cs = jnp.cumsum(dtc * a.reshape(g, hg), axis=2)
    tril = jnp.tril(jnp.ones((l, l), bool))[:, :, None, None]
    seg = cs[:, :, :, None] - cs[:, :, None, :]
    decay = jnp.exp(jnp.where(tril, seg, -jnp.inf))
    cb = jnp.einsum('bclgn,bcsgn->bclsg', cc, bc)
    w = cb[..., None] * decay * dtc[:, :, None]
    y_diag = jnp.einsum('bclsgh,bcsghp->bclghp', w, xc)
    decay_end = jnp.exp(cs[:, :, -1:] - cs) * dtc
    states = jnp.einsum('bcsgn,bcsghp->bcghpn', bc, xc * decay_end[..., None])
    chunk_decay = jnp.exp(cs[:, :, -1])

    def step(hs, inp):
        st, dec = inp
        return hs * dec[..., None, None] + st, hs

    h0 = jnp.zeros((bsz, g, hg, p, n), F32)
    _, h_prev = lax.scan(step, h0, (jnp.moveaxis(states, 1, 0), jnp.moveaxis(chunk_decay, 1, 0)))
    h_prev = jnp.moveaxis(h_prev, 0, 1)
    y_off = jnp.einsum('bclgn,bcghpn->bclghp', cc, h_prev) * jnp.exp(cs)[..., None]
    return (y_diag + y_off).reshape(bsz, s, h, p)


def ssd_mixer(z, xbc, dt_raw, conv_w, conv_b, dt_bias, a_log, d_skip, norm_w):
    bsz, s, _ = z.shape
    xbc = jax.nn.silu(causal_depthwise_conv(xbc, conv_w, conv_b))
    xs, bm, cm = jnp.split(xbc, [SSD_WIDTH, SSD_WIDTH + SSD_GROUPS * SSD_STATE], axis=-1)
    xs = xs.reshape(bsz, s, SSD_HEADS, SSD_HEAD_DIM)
    bm = bm.reshape(bsz, s, SSD_GROUPS, SSD_STATE)
    cm = cm.reshape(bsz, s, SSD_GROUPS, SSD_STATE)
    dt = jax.nn.softplus(dt_raw.astype(F32) + dt_bias.astype(F32))
    a = -jnp.exp(a_log.astype(F32))
    y = ssd_scan(xs, dt, a, bm, cm) + d_skip.astype(F32)[:, None] * xs.astype(F32)
    gsz = SSD_WIDTH // SSD_GROUPS
    y = y.reshape(bsz, s, SSD_GROUPS, gsz) * jax.nn.silu(z.astype(F32)).reshape(bsz, s, SSD_GROUPS, gsz)
    y = y * lax.rsqrt(jnp.mean(y * y, axis=-1, keepdims=True) + EPS)
    return (y.reshape(bsz, s, SSD_WIDTH) * norm_w.astype(F32)).astype(z.dtype)


def compress_blocks(u, blk_idx, pe, w1, b1, w2):
    bsz = u.shape[0]
    n_cmp = blk_idx.shape[0]
    blocks = u[:, blk_idx] + pe[:, None, :].astype(u.dtype)
    blocks = blocks.transpose(0, 3, 1, 2, 4).reshape(bsz, NSA_KV_GROUPS, n_cmp, CMP_BLOCK * NSA_HEAD_DIM)
    return jax.nn.silu(blocks @ w1 + b1) @ w2


def cmp_to_slc_weights(n_cmp, nb):
    c0 = np.arange(n_cmp)[:, None] * CMP_STRIDE
    s0 = np.arange(nb)[None, :] * SLC_BLOCK
    ov = np.minimum(c0 + CMP_BLOCK, s0 + SLC_BLOCK) - np.maximum(c0, s0)
    return jnp.asarray(np.maximum(ov, 0) / CMP_STRIDE, dtype=F32)


def nsa_mixer(q, kc_raw, vc_raw, ks, vs, kw, vw, gate_logits,
              k_pe, k_w1, k_b1, k_w2, v_pe, v_w1, v_b1, v_w2):
    bsz, s, _ = q.shape
    g, hg, dh = NSA_KV_GROUPS, NSA_HEADS // NSA_KV_GROUPS, NSA_HEAD_DIM
    n_cmp = (s - CMP_BLOCK) // CMP_STRIDE + 1
    nb = s // SLC_BLOCK
    n_sel = min(SLC_TOPN, nb)
    nqb = s // Q_BLOCK
    scale = dh ** -0.5
    kv = lambda a: a.reshape(bsz, s, g, dh)
    qh = q.reshape(bsz, s, g, hg, dh).transpose(0, 2, 3, 1, 4)
    gates = jax.nn.sigmoid(gate_logits.astype(F32)).reshape(bsz, s, g, hg, 3).transpose(0, 2, 3, 1, 4)
    blk_idx = np.arange(n_cmp)[:, None] * CMP_STRIDE + np.arange(CMP_BLOCK)[None, :]
    kc = compress_blocks(kv(kc_raw), blk_idx, k_pe, k_w1, k_b1, k_w2)
    vc = compress_blocks(kv(vc_raw), blk_idx, v_pe, v_w1, v_b1, v_w2)
    cmp_end = jnp.asarray(np.arange(n_cmp) * CMP_STRIDE + CMP_BLOCK - 1, jnp.int32)
    overlap = cmp_to_slc_weights(n_cmp, nb)
    ksb = kv(ks).reshape(bsz, nb, SLC_BLOCK, g, dh).transpose(0, 3, 1, 2, 4)
    vsb = kv(vs).reshape(bsz, nb, SLC_BLOCK, g, dh).transpose(0, 3, 1, 2, 4)
    pad = ((0, 0), (0, 0), (WINDOW, 0), (0, 0))
    kwp = jnp.pad(kv(kw).transpose(0, 2, 1, 3), pad)
    vwp = jnp.pad(kv(vw).transpose(0, 2, 1, 3), pad)
    blk_start = jnp.arange(nb) * SLC_BLOCK
    blk_id = jnp.arange(nb)
    gather = jax.vmap(jax.vmap(lambda tbl, i: tbl[i]))

    def one_block(qi):
        q0 = qi * Q_BLOCK
        t = q0 + jnp.arange(Q_BLOCK)
        qb = lax.dynamic_slice_in_dim(qh, q0, Q_BLOCK, axis=3)
        gb = lax.dynamic_slice_in_dim(gates, q0, Q_BLOCK, axis=3)
        valid_c = cmp_end[None, :] <= t[:, None]
        p_c = masked_softmax(jnp.einsum('bghqd,bgnd->bghqn', qb, kc) * scale, valid_c)
        o_c = jnp.einsum('bghqn,bgnd->bghqd', p_c, vc)
        imp = jnp.einsum('bghqn,nj->bgqj', p_c, overlap)
        cur = t // SLC_BLOCK
        forced = (blk_id[None, :] == 0) | (blk_id[None, :] == cur[:, None]) | (blk_id[None, :] == cur[:, None] - 1)
        imp = jnp.where(blk_start[None, :] <= t[:, None], imp + FORCE_BONUS * forced, NEG)
        _, sel = lax.top_k(imp, n_sel)
        k_sel = gather(ksb, sel).reshape(bsz, g, Q_BLOCK, n_sel * SLC_BLOCK, dh)
        v_sel = gather(vsb, sel).reshape(bsz, g, Q_BLOCK, n_sel * SLC_BLOCK, dh)
        pos_s = (sel[..., None] * SLC_BLOCK + jnp.arange(SLC_BLOCK)).reshape(bsz, g, Q_BLOCK, n_sel * SLC_BLOCK)
        valid_s = (pos_s <= t[:, None])[:, :, None]
        p_s = masked_softmax(jnp.einsum('bghqd,bgqkd->bghqk', qb, k_sel) * scale, valid_s)
        o_s = jnp.einsum('bghqk,bgqkd->bghqd', p_s, v_sel)
        k_w = lax.dynamic_slice_in_dim(kwp, q0, WINDOW + Q_BLOCK, axis=2)
        v_w = lax.dynamic_slice_in_dim(vwp, q0, WINDOW + Q_BLOCK, axis=2)
        pos_w = q0 - WINDOW + jnp.arange(WINDOW + Q_BLOCK)
        dist = t[:, None] - pos_w[None, :]
        valid_w = (dist >= 0) & (dist < WINDOW) & (pos_w[None, :] >= 0)
        p_w = masked_softmax(jnp.einsum('bghqd,bgkd->bghqk', qb, k_w) * scale, valid_w)
        o_w = jnp.einsum('bghqk,bgkd->bghqd', p_w, v_w)
        return gb[..., 0:1] * o_c + gb[..., 1:2] * o_s + gb[..., 2:3] * o_w

    o = lax.map(one_block, jnp.arange(nqb))
    return o.transpose(1, 0, 4, 2, 3, 5).reshape(bsz, s, NSA_WIDTH)


def conformer_conv(glu_in, dw_w, dw_b, ln_w, ln_b):
    a, gt = jnp.split(glu_in, 2, axis=-1)
    v = causal_depthwise_conv(a * jax.nn.sigmoid(gt), dw_w, dw_b)
    vf = v.astype(F32)
    mu = jnp.mean(vf, axis=-1, keepdims=True)
    var = jnp.mean(jnp.square(vf - mu), axis=-1, keepdims=True)
    vf = (vf - mu) * lax.rsqrt(var + EPS) * ln_w.astype(F32) + ln_b.astype(F32)
    return jax.nn.silu(vf).astype(glu_in.dtype)


def hybrid_mixer(u, w_in, ssd_conv_w, ssd_conv_b, ssd_dt_bias, ssd_a_log, ssd_d, ssd_norm_w,
                 nsa_k_pe, nsa_k_w1, nsa_k_b1, nsa_k_w2, nsa_v_pe, nsa_v_w1, nsa_v_b1, nsa_v_w2,
                 cnv_dw_w, cnv_dw_b, cnv_ln_w, cnv_ln_b, w_out):
    proj = u @ w_in
    (z, xbc, dt_raw, q, kc, vc, ks, vs, kw, vw, gl, glu) = jnp.split(
        proj, np.cumsum(IN_SPLITS)[:-1].tolist(), axis=-1)
    y_ssd = ssd_mixer(z, xbc, dt_raw, ssd_conv_w, ssd_conv_b, ssd_dt_bias, ssd_a_log, ssd_d, ssd_norm_w)
    y_nsa = nsa_mixer(q, kc, vc, ks, vs, kw, vw, gl, nsa_k_pe, nsa_k_w1, nsa_k_b1, nsa_k_w2,
                      nsa_v_pe, nsa_v_w1, nsa_v_b1, nsa_v_w2)
    y_cnv = conformer_conv(glu, cnv_dw_w, cnv_dw_b, cnv_ln_w, cnv_ln_b)
    y = jnp.concatenate([y_ssd.astype(u.dtype), y_nsa.astype(u.dtype), y_cnv.astype(u.dtype)], axis=-1)
    return y @ w_out


def setup_inputs(seed: int = 0) -> dict:
    key = jax.random.key(seed)
    keys = iter(jax.random.split(key, 40))
    L, D = DEPTH, D_MODEL

    def nrm(shape, scale):
        return jax.random.normal(next(keys), shape, F32) * scale

    def gain(shape):
        return 1.0 + nrm(shape, 0.05)

    x = nrm((BATCH, SEQ, D), 1.0)
    ffn1_pre_norm = gain((L, D))
    ffn1_w_gu = nrm((L, D, 2 * D_FF), D ** -0.5)
    ffn1_w_down = nrm((L, D_FF, D), D_FF ** -0.5)
    ffn1_post_norm = gain((L, D))
    mix_pre_norm = gain((L, D))
    w_in = nrm((L, D, D_IN), D ** -0.5)
    ssd_conv_w = nrm((L, SSD_CONV, SSD_XBC), SSD_CONV ** -0.5)
    ssd_conv_b = nrm((L, SSD_XBC), 0.02)
    dt0 = jnp.exp(jax.random.uniform(next(keys), (L, SSD_HEADS), F32, math.log(1e-3), math.log(1e-1)))
    ssd_dt_bias = dt0 + jnp.log(-jnp.expm1(-dt0))
    ssd_a_log = jnp.log(jax.random.uniform(next(keys), (L, SSD_HEADS), F32, 1.0, 16.0))
    ssd_d = gain((L, SSD_HEADS))
    ssd_norm_w = gain((L, SSD_WIDTH))
    fan_c = CMP_BLOCK * NSA_HEAD_DIM
    nsa_k_pe = nrm((L, CMP_BLOCK, NSA_HEAD_DIM), 0.1)
    nsa_k_w1 = nrm((L, fan_c, CMP_HIDDEN), fan_c ** -0.5)
    nsa_k_b1 = nrm((L, CMP_HIDDEN), 0.02)
    nsa_k_w2 = nrm((L, CMP_HIDDEN, NSA_HEAD_DIM), CMP_HIDDEN ** -0.5)
    nsa_v_pe = nrm((L, CMP_BLOCK, NSA_HEAD_DIM), 0.1)
    nsa_v_w1 = nrm((L, fan_c, CMP_HIDDEN), fan_c ** -0.5)
    nsa_v_b1 = nrm((L, CMP_HIDDEN), 0.02)
    nsa_v_w2 = nrm((L, CMP_HIDDEN, NSA_HEAD_DIM), CMP_HIDDEN ** -0.5)
    cnv_dw_w = nrm((L, CONV_KERNEL, CONV_CH), CONV_KERNEL ** -0.5)
    cnv_dw_b = nrm((L, CONV_CH), 0.02)
    cnv_ln_w = gain((L, CONV_CH))
    cnv_ln_b = nrm((L, CONV_CH), 0.02)
    w_out = nrm((L, D_MIX, D), D_MIX ** -0.5)
    mix_post_norm = gain((L, D))
    ffn2_pre_norm = gain((L, D))
    ffn2_w_gu = nrm((L, D, 2 * D_FF), D ** -0.5)
    ffn2_w_down = nrm((L, D_FF, D), D_FF ** -0.5)
    ffn2_post_norm = gain((L, D))
    return {"x": x, "ffn1_pre_norm": ffn1_pre_norm, "ffn1_w_gu": ffn1_w_gu, "ffn1_w_down": ffn1_w_down,
            "ffn1_post_norm": ffn1_post_norm, "mix_pre_norm": mix_pre_norm, "w_in": w_in,
            "ssd_conv_w": ssd_conv_w, "ssd_conv_b": ssd_conv_b, "ssd_dt_bias": ssd_dt_bias,
            "ssd_a_log": ssd_a_log, "ssd_d": ssd_d, "ssd_norm_w": ssd_norm_w,
            "nsa_k_pe": nsa_k_pe, "nsa_k_w1": nsa_k_w1, "nsa_k_b1": nsa_k_b1, "nsa_k_w2": nsa_k_w2,
            "nsa_v_pe": nsa_v_pe, "nsa_v_w1": nsa_v_w1, "nsa_v_b1": nsa_v_b1, "nsa_v_w2": nsa_v_w2,
            "cnv_dw_w": cnv_dw_w, "cnv_dw_b": cnv_dw_b, "cnv_ln_w": cnv_ln_w, "cnv_ln_b": cnv_ln_b,
            "w_out": w_out, "mix_post_norm": mix_post_norm, "ffn2_pre_norm": ffn2_pre_norm,
            "ffn2_w_gu": ffn2_w_gu, "ffn2_w_down": ffn2_w_down, "ffn2_post_norm": ffn2_post_norm}


def reference(x, ffn1_pre_norm, ffn1_w_gu, ffn1_w_down, ffn1_post_norm, mix_pre_norm, w_in,
              ssd_conv_w, ssd_conv_b, ssd_dt_bias, ssd_a_log, ssd_d, ssd_norm_w,
              nsa_k_pe, nsa_k_w1, nsa_k_b1, nsa_k_w2, nsa_v_pe, nsa_v_w1, nsa_v_b1, nsa_v_w2,
              cnv_dw_w, cnv_dw_b, cnv_ln_w, cnv_ln_b, w_out, mix_post_norm,
              ffn2_pre_norm, ffn2_w_gu, ffn2_w_down, ffn2_post_norm):
    h = x
    for l in range(DEPTH):
        u = rms_norm(h, ffn1_pre_norm[l])
        h = h + HALF * rms_norm(swiglu(u, ffn1_w_gu[l], ffn1_w_down[l]), ffn1_post_norm[l])
        u = rms_norm(h, mix_pre_norm[l])
        m = hybrid_mixer(u, w_in[l], ssd_conv_w[l], ssd_conv_b[l], ssd_dt_bias[l], ssd_a_log[l],
                         ssd_d[l], ssd_norm_w[l], nsa_k_pe[l], nsa_k_w1[l], nsa_k_b1[l], nsa_k_w2[l],
                         nsa_v_pe[l], nsa_v_w1[l], nsa_v_b1[l], nsa_v_w2[l],
                         cnv_dw_w[l], cnv_dw_b[l], cnv_ln_w[l], cnv_ln_b[l], w_out[l])
        h = h + rms_norm(m, mix_post_norm[l])
        u = rms_norm(h, ffn2_pre_norm[l])
        h = h + HALF * rms_norm(swiglu(u, ffn2_w_gu[l], ffn2_w_down[l]), ffn2_post_norm[l])
    return h
```

```cpp
#include <hip/hip_runtime.h>
#include <cstdio>
#include <cstdint>
#include <cmath>

#ifndef MK_PER_PHASE
#define MK_PER_PHASE 0
#endif

#define LAS __attribute__((address_space(3)))
#define GAS __attribute__((address_space(1)))

namespace pg8 {
#define PG8_LAS __attribute__((address_space(3)))
typedef unsigned short bf16_t;
typedef short bf16x8 __attribute__((ext_vector_type(8)));
typedef float f32x4 __attribute__((ext_vector_type(4)));
typedef unsigned u32x4 __attribute__((ext_vector_type(4)));
constexpr int BM = 256, BK = 64, HALF = 128, HTB = HALF * BK * 2  , STAGE_BYTES = 8 * HTB, NXCD = 8, WGM = 4;

__host__ __device__ __forceinline__ int lds_byte(int r, int c) { const int st = (r >> 4) * 2 + (c >> 5), rr = r & 15, cc = c & 31, ob = rr * 64 + cc * 2; return st * 1024 + (ob ^ (((ob >> 9) & 1) << 5)); }
__host__ __device__ __forceinline__ void stage_rc(int b, int& R, int& C) { const int st = b / 1024, sb = b % 1024, swz = sb ^ (((sb >> 9) & 1) << 5); R = (st >> 1) * 16 + swz / 64; C = (st & 1) * 32 + (swz % 64) / 2; }
__host__ __device__ __forceinline__ int perm32(int rho) { const int n = rho >> 4, i = rho & 15; return 8 * (i >> 2) + 4 * n + (i & 3); }

struct Unit { int pm, pn; };

struct StaticOrder {
    int nM, nN, nwg, G, c, wgm;
    __host__ __device__ void init(int M, int N, int G_, int c_, int wgm_ = WGM) { nM = M / BM; nN = N / BM; nwg = nM * nN; G = G_; c = c_; wgm = wgm_; }
    __host__ __device__ bool next(int i, Unit& u) const {
        const long L = (long)i * G + c; if (L >= nwg) return false;
        int wgid = (int)L; { const int q = nwg / NXCD, r = nwg % NXCD, xcd = wgid % NXCD, off = wgid / NXCD; wgid = (xcd < r ? xcd * (q + 1) : r * (q + 1) + (xcd - r) * q) + off; }
        const int nig = wgm * nN, gid = wgid / nig, fm = gid * wgm, gsz = (nM - fm) < wgm ? (nM - fm) : wgm;
        u.pm = fm + ((wgid % nig) % gsz); u.pn = (wgid % nig) / gsz; return true;
    }
    __device__ __forceinline__ void a_ready(const Unit&) const {}
    __device__ __forceinline__ void done(const Unit&) const {}
};


struct Gemm { const bf16_t* A; const bf16_t* Bt; int M, N, K; int lda; int kstepA; int amode;
    __device__ __forceinline__ size_t abase(int pm) const {
        if (amode == 0) return (size_t)pm * BM * (size_t)lda * 2;
        return ((size_t)((pm >> 2) * 8192 + (pm & 1) * 4096) * 5120 + (size_t)((pm >> 1) & 1) * 64) * 2;
    }
};
struct OneUnit {
    Unit u0;
    __device__ __forceinline__ bool next(int i, Unit& u) const { if (i != 0) return false; u = u0; return true; }
    __device__ __forceinline__ void a_ready(const Unit&) const {}
    __device__ __forceinline__ void done(const Unit&) const {}
};

typedef float f32x2_t __attribute__((ext_vector_type(2))); typedef __bf16 bf16x2_t __attribute__((ext_vector_type(2)));
__device__ __forceinline__ unsigned cvt_pk_bf16(float lo, float hi) { const f32x2_t v = {lo, hi}; const bf16x2_t b = __builtin_convertvector(v, bf16x2_t); return __builtin_bit_cast(unsigned, b); }
__device__ __forceinline__ float silu_f(float x) { return x * __builtin_amdgcn_rcpf(1.0f + __expf(-x)); }

struct EpiStore {
    static constexpr bool PERM = true, AFTER_DRAIN = false, ROWSCALE = false;
    bf16_t* O; int ldc;
    __device__ __forceinline__ void operator()(const f32x4 (&acc)[2][2][4][2], const Unit& u, int wr, int wc, int fr, int fq, const PG8_LAS float* rsl) const {
        const int row0 = u.pm * BM + wr * 64 + fr, col0 = u.pn * BM + wc * 32 + 8 * fq;
#pragma unroll
        for (int ai = 0; ai < 2; ++ai)
#pragma unroll
            for (int m = 0; m < 4; ++m) { bf16_t* rowp = O + (size_t)(row0 + ai * HALF + m * 16) * ldc + col0;
#pragma unroll
                for (int bj = 0; bj < 2; ++bj) { const f32x4 v0 = acc[ai][bj][m][0], v1 = acc[ai][bj][m][1];
                    u32x4 w; w.x = cvt_pk_bf16(v0[0], v0[1]); w.y = cvt_pk_bf16(v0[2], v0[3]); w.z = cvt_pk_bf16(v1[0], v1[1]); w.w = cvt_pk_bf16(v1[2], v1[3]);
                    *(u32x4*)(rowp + bj * HALF) = w; } }
    }
};
struct EpiProj {
    static constexpr bool PERM = true, AFTER_DRAIN = false, ROWSCALE = true;
    bf16_t* O; int ldc; bf16_t* KV; const float* rs;
    __device__ __forceinline__ void operator()(const f32x4 (&acc)[2][2][4][2], const Unit& u, int wr, int wc, int fr, int fq, const PG8_LAS float* rsl) const {
        const bool kvt = (u.pn >= 16 && u.pn <= 18);
        const int pitch = kvt ? 64 : ldc;
        const int rloc = (kvt ? ((u.pm * BM) & 8191) : u.pm * BM) + wr * 64 + fr;
        bf16_t* base[2];
#pragma unroll
        for (int bj = 0; bj < 2; ++bj)
            base[bj] = kvt ? KV + (size_t)((((u.pn - 16) * 2 + bj) * 2 + ((u.pm * BM) >> 13)) * 2 + (wc >> 1)) * 8192 * 64 + (wc & 1) * 32 + 8 * fq
                           : O + u.pn * BM + bj * HALF + wc * 32 + 8 * fq;
#pragma unroll
        for (int ai = 0; ai < 2; ++ai)
#pragma unroll
            for (int m = 0; m < 4; ++m) { const size_t roff = (size_t)(rloc + ai * HALF + m * 16) * pitch; const float r = rsl[wr * 64 + fr + ai * HALF + m * 16];
#pragma unroll
                for (int bj = 0; bj < 2; ++bj) { const f32x4 v0 = acc[ai][bj][m][0] * r, v1 = acc[ai][bj][m][1] * r;
                    u32x4 w; w.x = cvt_pk_bf16(v0[0], v0[1]); w.y = cvt_pk_bf16(v0[2], v0[3]); w.z = cvt_pk_bf16(v1[0], v1[1]); w.w = cvt_pk_bf16(v1[2], v1[3]);
                    *(u32x4*)(base[bj] + roff) = w; } }
    }
};
struct EpiSwiglu {
    static constexpr bool PERM = true, AFTER_DRAIN = false, ROWSCALE = true;
    bf16_t* O; int ldc; const float* rs;
    __device__ __forceinline__ void operator()(const f32x4 (&acc)[2][2][4][2], const Unit& u, int wr, int wc, int fr, int fq, const PG8_LAS float* rsl) const {
        const int row0 = u.pm * BM + wr * 64 + fr, col0 = u.pn * HALF + wc * 32 + 8 * fq;
#pragma unroll
        for (int ai = 0; ai < 2; ++ai)
#pragma unroll
            for (int m = 0; m < 4; ++m) { bf16_t* rowp = O + (size_t)(row0 + ai * HALF + m * 16) * ldc + col0; const float r = rsl[wr * 64 + fr + ai * HALF + m * 16];
                const f32x4 g0 = acc[ai][0][m][0] * r, g1 = acc[ai][0][m][1] * r, v0 = acc[ai][1][m][0] * r, v1 = acc[ai][1][m][1] * r;
                u32x4 w;
                w.x = cvt_pk_bf16(silu_f(g0[0]) * v0[0], silu_f(g0[1]) * v0[1]); w.y = cvt_pk_bf16(silu_f(g0[2]) * v0[2], silu_f(g0[3]) * v0[3]);
                w.z = cvt_pk_bf16(silu_f(g1[0]) * v1[0], silu_f(g1[1]) * v1[1]); w.w = cvt_pk_bf16(silu_f(g1[2]) * v1[2], silu_f(g1[3]) * v1[3]);
                *(u32x4*)rowp = w; }
    }
};
struct EpiBiasSilu {
    static constexpr bool PERM = true, AFTER_DRAIN = false, ROWSCALE = false;
    bf16_t* O; int ldc; const PG8_LAS float* bias;
    __device__ __forceinline__ void operator()(const f32x4 (&acc)[2][2][4][2], const Unit& u, int wr, int wc, int fr, int fq, const PG8_LAS float* rsl) const {
        const int row0 = u.pm * BM + wr * 64 + fr, col0 = u.pn * BM + wc * 32 + 8 * fq;
#pragma unroll
        for (int bj = 0; bj < 2; ++bj) {
            const f32x4 b0 = *(const PG8_LAS f32x4*)(bias + col0 + bj * HALF), b1 = *(const PG8_LAS f32x4*)(bias + col0 + bj * HALF + 4);
#pragma unroll
            for (int ai = 0; ai < 2; ++ai)
#pragma unroll
                for (int m = 0; m < 4; ++m) { bf16_t* rowp = O + (size_t)(row0 + ai * HALF + m * 16) * ldc + col0 + bj * HALF;
                    const f32x4 v0 = acc[ai][bj][m][0] + b0, v1 = acc[ai][bj][m][1] + b1;
                    u32x4 w; w.x = cvt_pk_bf16(silu_f(v0[0]), silu_f(v0[1])); w.y = cvt_pk_bf16(silu_f(v0[2]), silu_f(v0[3]));
                    w.z = cvt_pk_bf16(silu_f(v1[0]), silu_f(v1[1])); w.w = cvt_pk_bf16(silu_f(v1[2]), silu_f(v1[3]));
                    *(u32x4*)rowp = w; }
        }
    }
};

template <class Epi, class Sched, bool ALIGN_EPI = false, bool SP2 = false>
__device__ __forceinline__ void gemm_phase(PG8_LAS unsigned char* lds, const Gemm g, const Sched& S, const Epi& E) {
    const int tid = threadIdx.x, wid = __builtin_amdgcn_readfirstlane(tid >> 6), lane = tid & 63, wr = wid >> 2, wc = wid & 3, fr = lane & 15, fq = lane >> 4;
    const int K = g.K, nt = K / BK;
    unsigned voffA[2], voffB[2];
#pragma unroll
    for (int i = 0; i < 2; ++i) { int R, C; stage_rc(tid * 16 + i * 8192, R, C); const int Rb = Epi::PERM ? ((R & ~31) + perm32(R & 31)) : R;
        voffA[i] = (unsigned)(R * g.lda + C) * 2u; voffB[i] = (unsigned)(Rb * K + C) * 2u; }
    const size_t kstepB = (size_t)(BK * 2), kstepA = (size_t)g.kstepA;
    const size_t hstepB = (size_t)HALF * K * 2, hstepA = (size_t)HALF * g.lda * 2;
    const size_t tstepB = 2 * hstepB;
    const unsigned ldsw = (unsigned)wid * 1024u;
    const int aoff = lds_byte(wr * 64 + fr, fq * 8), boff = lds_byte(wc * 32 + fr, fq * 8);
#define PG8_SA(b, h) (((b) * 2 + (h)) * HTB)
#define PG8_RSL (8 * HTB + 1024)
#define PG8_SB(b, h) ((4 + (b) * 2 + (h)) * HTB)
#define PG8_STAGE(bufoff, gbase, voff) do { _Pragma("unroll") for (int _i = 0; _i < 2; ++_i) \
        __builtin_amdgcn_global_load_lds((const unsigned*)((const char*)(gbase) + (voff)[_i]), (PG8_LAS unsigned*)(lds + (bufoff) + ldsw + _i * 8192), 16, 0, 0); } while (0)
#define PG8_LDA(dst, b, h) do { _Pragma("unroll") for (int m = 0; m < 4; ++m) _Pragma("unroll") for (int k = 0; k < 2; ++k) dst[m][k] = *(const PG8_LAS bf16x8*)(lds + PG8_SA(b, h) + aoff + m * 2048 + k * 1024); } while (0)
#define PG8_LDB(dst, b, h) do { _Pragma("unroll") for (int n = 0; n < 2; ++n) _Pragma("unroll") for (int k = 0; k < 2; ++k) dst[n][k] = *(const PG8_LAS bf16x8*)(lds + PG8_SB(b, h) + boff + n * 2048 + k * 1024); } while (0)
#define PG8_MMA(ai, bj, At, Bt) do { __builtin_amdgcn_s_setprio(1); _Pragma("unroll") for (int m = 0; m < 4; ++m) _Pragma("unroll") for (int n = 0; n < 2; ++n) _Pragma("unroll") for (int k = 0; k < 2; ++k) \
        acc[ai][bj][m][n] = __builtin_amdgcn_mfma_f32_16x16x32_bf16(Bt[n][k], At[m][k], acc[ai][bj][m][n], 0, 0, 0); __builtin_amdgcn_s_setprio(0); } while (0)
#define PG8_WAIT_V(n) asm volatile("s_waitcnt vmcnt(" #n ")" ::: "memory")
#define PG8_WAIT_L(n) asm volatile("s_waitcnt lgkmcnt(" #n ")" ::: "memory")
#define PG8_BAR __builtin_amdgcn_s_barrier()
#define PG8_SCHED __builtin_amdgcn_sched_barrier(0)
    Unit cur, nxt; int ui = 0;
    if (!S.next(0, cur)) return;
    f32x4 acc[2][2][4][2];
#pragma unroll
    for (int a = 0; a < 2; ++a)
#pragma unroll
        for (int b = 0; b < 2; ++b)
#pragma unroll
            for (int m = 0; m < 4; ++m)
#pragma unroll
                for (int n = 0; n < 2; ++n) acc[a][b][m][n] = (f32x4){0.f, 0.f, 0.f, 0.f};
    bf16x8 At[4][2], B0[2][2], B1[2][2];
    const char* cA = (const char*)g.A + g.abase(cur.pm); const char* cB = (const char*)g.Bt + (size_t)cur.pn * tstepB;
    S.a_ready(cur);
    if constexpr (SP2) {
        PG8_STAGE(PG8_SB(0, 0), cB, voffB); PG8_STAGE(PG8_SB(0, 1), cB + hstepB, voffB); PG8_STAGE(PG8_SA(0, 0), cA, voffA); PG8_STAGE(PG8_SA(0, 1), cA + hstepA, voffA);
        if (wr == 1) PG8_BAR;
        PG8_WAIT_V(2); PG8_BAR;
        PG8_STAGE(PG8_SB(1, 0), cB + kstepB, voffB); PG8_STAGE(PG8_SA(1, 0), cA + kstepA, voffA); PG8_STAGE(PG8_SB(1, 1), cB + hstepB + kstepB, voffB);
        PG8_WAIT_V(6); PG8_BAR;
    } else {
        PG8_STAGE(PG8_SB(0, 0), cB, voffB); PG8_STAGE(PG8_SA(0, 0), cA, voffA); PG8_STAGE(PG8_SB(0, 1), cB + hstepB, voffB); PG8_STAGE(PG8_SA(0, 1), cA + hstepA, voffA);
        if (wr == 1) PG8_BAR;
        PG8_WAIT_V(4); PG8_BAR;
        PG8_STAGE(PG8_SB(1, 0), cB + kstepB, voffB); PG8_STAGE(PG8_SA(1, 0), cA + kstepA, voffA); PG8_STAGE(PG8_SB(1, 1), cB + hstepB + kstepB, voffB);
        PG8_WAIT_V(6); PG8_BAR;
    }
    for (;;) {
        const bool has_next = S.next(ui + 1, nxt);
        const char* nA = has_next ? (const char*)g.A + g.abase(nxt.pm) : cA + (size_t)(nt - 2) * kstepA; const char* nB = has_next ? (const char*)g.Bt + (size_t)nxt.pn * tstepB : cB + (size_t)(nt - 2) * kstepB;
        if constexpr (Epi::ROWSCALE) { if (wid < 4) __builtin_amdgcn_global_load_lds((const unsigned*)(E.rs + cur.pm * BM + wid * 64 + lane), (PG8_LAS unsigned*)(lds + PG8_RSL + (ui & 1) * 1024 + wid * 256), 4, 0, 0); }
        for (int t = 0; t < nt; t += 2) {
            const bool last = (t == nt - 2);
            const char* a1 = cA + (size_t)(t + 1) * kstepA;
            const char* a2 = last ? nA : cA + (size_t)(t + 2) * kstepA; const char* b2 = last ? nB : cB + (size_t)(t + 2) * kstepB;
            const char* a3 = a2 + kstepA; const char* b3 = b2 + kstepB;
            if (last && has_next) S.a_ready(nxt);
            if constexpr (SP2) {
            PG8_LDB(B0, 0, 0); PG8_LDB(B1, 0, 1); PG8_SCHED; PG8_LDA(At, 0, 0); PG8_STAGE(PG8_SA(1, 1), a1 + hstepA, voffA);
            PG8_WAIT_V(8); PG8_WAIT_L(0); PG8_BAR; PG8_MMA(0, 0, At, B0); PG8_MMA(0, 1, At, B1); PG8_BAR; PG8_SCHED;
            PG8_LDA(At, 0, 1); PG8_STAGE(PG8_SB(0, 0), b2, voffB); PG8_STAGE(PG8_SB(0, 1), b2 + hstepB, voffB); PG8_STAGE(PG8_SA(0, 0), a2, voffA);
            PG8_WAIT_V(8); PG8_WAIT_L(0); PG8_BAR; PG8_MMA(1, 0, At, B0); PG8_MMA(1, 1, At, B1); PG8_BAR; PG8_SCHED;
            PG8_LDB(B0, 1, 0); PG8_LDB(B1, 1, 1); PG8_SCHED; PG8_LDA(At, 1, 0); PG8_STAGE(PG8_SA(0, 1), a2 + hstepA, voffA);
            PG8_WAIT_V(8); PG8_WAIT_L(0); PG8_BAR; PG8_MMA(0, 0, At, B0); PG8_MMA(0, 1, At, B1); PG8_BAR; PG8_SCHED;
            PG8_LDA(At, 1, 1); PG8_STAGE(PG8_SB(1, 0), b3, voffB); PG8_STAGE(PG8_SB(1, 1), b3 + hstepB, voffB); PG8_STAGE(PG8_SA(1, 0), a3, voffA);
            PG8_WAIT_V(8); PG8_WAIT_L(0); PG8_BAR; PG8_MMA(1, 0, At, B0); PG8_MMA(1, 1, At, B1); PG8_BAR; PG8_SCHED;
            } else {
            PG8_LDB(B0, 0, 0); PG8_SCHED; PG8_LDA(At, 0, 0); PG8_STAGE(PG8_SA(1, 1), a1 + hstepA, voffA);
            PG8_WAIT_L(8); PG8_BAR; PG8_WAIT_L(0); PG8_MMA(0, 0, At, B0); PG8_BAR; PG8_SCHED;
            PG8_LDB(B1, 0, 1); PG8_STAGE(PG8_SB(0, 0), b2, voffB);
            PG8_BAR; PG8_WAIT_L(0); PG8_MMA(0, 1, At, B1); PG8_BAR;
            PG8_LDA(At, 0, 1); PG8_STAGE(PG8_SA(0, 0), a2, voffA);
            PG8_BAR; PG8_WAIT_L(0); PG8_MMA(1, 0, At, B0); PG8_BAR; PG8_SCHED;
            PG8_STAGE(PG8_SB(0, 1), b2 + hstepB, voffB);
            PG8_WAIT_V(6); PG8_BAR; PG8_MMA(1, 1, At, B1); PG8_BAR;
            PG8_LDB(B0, 1, 0); PG8_SCHED; PG8_LDA(At, 1, 0); PG8_STAGE(PG8_SA(0, 1), a2 + hstepA, voffA);
            PG8_WAIT_L(8); PG8_BAR; PG8_WAIT_L(0); PG8_MMA(0, 0, At, B0); PG8_BAR; PG8_SCHED;
            PG8_LDB(B1, 1, 1); PG8_STAGE(PG8_SB(1, 0), b3, voffB);
            PG8_BAR; PG8_WAIT_L(0); PG8_MMA(0, 1, At, B1); PG8_BAR;
            PG8_LDA(At, 1, 1); PG8_STAGE(PG8_SA(1, 0), a3, voffA);
            PG8_BAR; PG8_WAIT_L(0); PG8_MMA(1, 0, At, B0); PG8_BAR; PG8_SCHED;
            PG8_STAGE(PG8_SB(1, 1), b3 + hstepB, voffB);
            PG8_WAIT_V(6); PG8_BAR; PG8_MMA(1, 1, At, B1); PG8_BAR;
            }
        }
        if constexpr (ALIGN_EPI) { if (wr == 0) PG8_BAR; }
        if constexpr (!Epi::AFTER_DRAIN) { E(acc, cur, wr, wc, fr, fq, (const PG8_LAS float*)(lds + PG8_RSL + (ui & 1) * 1024)); S.done(cur); }
        if (!has_next) break;
#pragma unroll
        for (int a = 0; a < 2; ++a)
#pragma unroll
            for (int b = 0; b < 2; ++b)
#pragma unroll
                for (int m = 0; m < 4; ++m)
#pragma unroll
                    for (int n = 0; n < 2; ++n) acc[a][b][m][n] = (f32x4){0.f, 0.f, 0.f, 0.f};
        cur = nxt; cA = nA; cB = nB; ++ui;
        if constexpr (ALIGN_EPI) { if (wr == 1) PG8_BAR; }
    }
    PG8_WAIT_V(0);
    if constexpr (!ALIGN_EPI) { if (wr == 0) PG8_BAR; }
    PG8_BAR;
    if constexpr (Epi::AFTER_DRAIN) { E.fused(acc, cur, wr, wc, fr, fq, lds, wid, lane); S.done(cur); }
#undef PG8_SA
#undef PG8_RSL
#undef PG8_SB
#undef PG8_STAGE
#undef PG8_LDA
#undef PG8_LDB
#undef PG8_MMA
#undef PG8_WAIT_V
#undef PG8_WAIT_L
#undef PG8_BAR
#undef PG8_SCHED
}
}


using pg8::bf16_t; using pg8::bf16x8; using pg8::f32x4; using pg8::u32x4; using pg8::cvt_pk_bf16; using pg8::silu_f;
typedef short s16x4 __attribute__((ext_vector_type(4)));
typedef float f32x2 __attribute__((ext_vector_type(2)));
typedef unsigned u32x2 __attribute__((ext_vector_type(2)));

constexpr int DM = 2048, NB = 2, SEQ = 8192, M = NB * SEQ, DEPTH = 4, DFF = 5632, DIN = 4904, NPROJ = 5120;
constexpr int NWAVES = 8, NTHR = 512;
constexpr float EPS = 1e-6f;
constexpr int PC_Z = 0, PC_XBC = 1024, PC_GLU = 2560, PC_Q = 3584, PC_KC = 4096, PC_VC = 4224, PC_KS = 4352, PC_VS = 4480, PC_KW = 4608, PC_VW = 4736, PC_DT = 4864, PC_GL = 4880;
__device__ __forceinline__ int win_src_col(int j) {
    if (j < 2560) return j;
    if (j < 3584) return 3880 + (j - 2560);
    if (j < 4096) return 2576 + (j - 3584);
    if (j < 4864) return 3088 + (j - 4096);
    if (j < 4880) return 2560 + (j - 4864);
    if (j < 4904) return 3856 + (j - 4880);
    return -1;
}
__device__ __forceinline__ int gu_src_col(int R) { const int pn = R >> 8, rr = R & 255; return rr < 128 ? 128 * pn + rr : DFF + 128 * pn + (rr - 128); }

constexpr size_t MiB = 1u << 20;
constexpr size_t WS_CTL = 0, CTL_ZERO_BYTES = 1 * MiB;
constexpr size_t WS_WGU1 = 2 * MiB;
constexpr size_t WS_WGU2 = WS_WGU1 + 44 * MiB;
constexpr size_t WS_WD1 = WS_WGU2 + 44 * MiB;
constexpr size_t WS_WD2 = WS_WD1 + 22 * MiB;
constexpr size_t WS_WIN = WS_WD2 + 22 * MiB;
constexpr size_t WS_WOUT = WS_WIN + 20 * MiB;
constexpr size_t WS_W1 = WS_WOUT + 8 * MiB;
constexpr size_t WS_U = 180 * MiB;
constexpr size_t WS_T = 244 * MiB;
constexpr size_t WS_HID = 308 * MiB;
constexpr size_t WS_PROJ = 486 * MiB;
constexpr size_t WS_Y = 648 * MiB;
constexpr size_t WS_XACT = 712 * MiB;
constexpr size_t WS_STATES = 760 * MiB;
constexpr size_t WS_HP = 824 * MiB;
constexpr size_t WS_DT = 856 * MiB;
constexpr size_t WS_CS = 857 * MiB;
constexpr size_t WS_CDEC = 858 * MiB;
constexpr size_t WS_PEP = WS_CDEC + 64 * 1024;
constexpr size_t WS_KC = 859 * MiB;
constexpr size_t WS_H1 = 860 * MiB;
constexpr size_t WS_RS = 863 * MiB;
constexpr size_t WS_KV = 864 * MiB;
constexpr size_t WS_END = 890 * MiB;
static_assert(WS_W1 + 2 * MiB <= WS_U, "weights fit below U");
static_assert(WS_HID + (size_t)M * DFF * 2 <= WS_PROJ && WS_PROJ + (size_t)(M + 64) * NPROJ * 2 <= WS_Y, "ws map");

constexpr int LDS_WORK = 150 * 1024;
constexpr int LDS_CTL_OFF = LDS_WORK;
constexpr int LDS_BYTES = 152 * 1024;

typedef GAS unsigned gu32;
#define RLX_AGENT __ATOMIC_RELAXED, __HIP_MEMORY_SCOPE_AGENT
#define LDS_WAIT() asm volatile("s_waitcnt lgkmcnt(0)" ::: "memory")
#define VM_WAIT() asm volatile("s_waitcnt vmcnt(0)" ::: "memory")
__device__ __forceinline__ float bf2f(unsigned v) { return __uint_as_float(v << 16); }
__device__ __forceinline__ float bflo(unsigned u) { return __uint_as_float(u << 16); }
__device__ __forceinline__ float bfhi(unsigned u) { return __uint_as_float(u & 0xffff0000u); }
__device__ __forceinline__ float wave_sum(float v) {
#pragma unroll
    for (int o = 1; o < 64; o <<= 1) v += __shfl_xor(v, o);
    return v;
}
struct Ctx { LAS unsigned char* lds; int tid, lane, wave, G, bid; };

__device__ __forceinline__ bf16x8 frag_row(const LAS unsigned char* base, int pitch, int row0, int k0, int lane) {
    return *(const LAS bf16x8*)(base + (row0 + (lane & 15)) * pitch + (k0 + 8 * (lane >> 4)) * 2);
}
__device__ __forceinline__ s16x4 tr16(const LAS unsigned char* p) { return __builtin_bit_cast(s16x4, __builtin_amdgcn_ds_read_tr16_b64_v4i16((LAS s16x4*)p)); }
__device__ __forceinline__ bf16x8 frag_tr(const LAS unsigned char* base, int pitch, int k0, int n0, int lane) {
    const int g = lane >> 4, q = (lane & 15) >> 2, p = lane & 3;
    const LAS unsigned char* a = base + (k0 + 8 * g + q) * pitch + (n0 + 4 * p) * 2;
    const s16x4 lo = tr16(a), hi = tr16(a + 4 * pitch);
    return (bf16x8){lo[0], lo[1], lo[2], lo[3], hi[0], hi[1], hi[2], hi[3]};
}
#define MFMA16(a, b, c) __builtin_amdgcn_mfma_f32_16x16x32_bf16((a), (b), (c), 0, 0, 0)

#define XB_TMO      128
#define XB_XCNT(j)  (256  + 64 * (j))
#define XB_XSUB(j)  (1280 + 64 * (j))
#define XB_XGEN(j)  (2304 + 64 * (j))
#define XB_TOP      3328
#define XB_TOPGEN   3392
#define XCD_BAR_WORDS 3456
#define XB_SPIN_CAP (1u << 18)

__device__ __forceinline__ unsigned xb_ld(unsigned* p)              { return __hip_atomic_load(p, __ATOMIC_RELAXED, __HIP_MEMORY_SCOPE_AGENT); }
__device__ __forceinline__ unsigned xb_add(unsigned* p, unsigned v) { return __hip_atomic_fetch_add(p, v, __ATOMIC_RELAXED, __HIP_MEMORY_SCOPE_AGENT); }
__device__ __forceinline__ unsigned xb_xcc_id() { return (unsigned)__builtin_amdgcn_s_getreg((3 << 11) | 20) & 0xFu; }
#define XB_SPIN(cond, bar) do { unsigned _sp = 0; while (cond) { __builtin_amdgcn_s_sleep(1); \
    if ((++_sp & 255u) == 0u) { if (xb_ld(&(bar)[XB_TMO])) break; if (_sp > XB_SPIN_CAP) { atomicAdd(&(bar)[XB_TMO], 1u); break; } } } } while (0)

struct XcdBarrier {
    unsigned* bar; unsigned x;
    volatile LAS unsigned* st;
};

__device__ __forceinline__ XcdBarrier xcd_barrier_post(unsigned* bar, volatile LAS unsigned* st) {
    XcdBarrier b; b.bar = bar; b.x = xb_xcc_id(); b.st = st;
    if (threadIdx.x == 0) (void)xb_add(&bar[XB_XCNT(b.x)], 1u);
    return b;
}
__device__ __forceinline__ void xcd_barrier_complete(unsigned* bar, unsigned x, unsigned& nloc, unsigned& nx) {
    const unsigned G = gridDim.x * gridDim.y * gridDim.z;
    unsigned sum, cnt, mine, sp = 0u;
    for (;;) {
        sum = 0u; cnt = 0u; mine = 0u;
#pragma unroll
        for (unsigned j = 0; j < 16; ++j) { const unsigned c = xb_ld(&bar[XB_XCNT(j)]); sum += c; cnt += (c > 0u) ? 1u : 0u; mine = (j == x) ? c : mine; }
        if (sum == G) break;
        __builtin_amdgcn_s_sleep(1);
        if ((++sp & 255u) == 0u) { if (xb_ld(&bar[XB_TMO])) break; if (sp > XB_SPIN_CAP) { atomicAdd(&bar[XB_TMO], 1u); break; } }
    }
    nloc = mine > 0u ? mine : 1u; nx = cnt > 0u ? cnt : 1u;
}

__device__ __forceinline__ void xcd_barrier(const XcdBarrier& b) {
    asm volatile("s_waitcnt vmcnt(0)" ::: "memory");
    __syncthreads();
    if (threadIdx.x == 0) {
        unsigned* bar = b.bar;
        __builtin_amdgcn_s_waitcnt(0);
        unsigned nloc = b.st[0], nx = b.st[1];
        if (nloc == 0u) { xcd_barrier_complete(bar, b.x, nloc, nx); b.st[0] = nloc; b.st[1] = nx; }
        const unsigned old = xb_add(&bar[XB_XSUB(b.x)], 1u);
        const unsigned gen = old / nloc;
        if (old + 1u == (gen + 1u) * nloc) {
            __builtin_amdgcn_fence(__ATOMIC_RELEASE, "agent");
            asm volatile("s_waitcnt vmcnt(0)" ::: "memory");
            const unsigned og = xb_add(&bar[XB_TOP], 1u);
            const unsigned tg = og / nx;
            if (og + 1u == (tg + 1u) * nx) xb_add(&bar[XB_TOPGEN], 1u);
            else XB_SPIN(xb_ld(&bar[XB_TOPGEN]) == tg, bar);
            __builtin_amdgcn_fence(__ATOMIC_ACQUIRE, "agent");
            xb_add(&bar[XB_XGEN(b.x)], 1u);
            asm volatile("s_waitcnt vmcnt(0)" ::: "memory");
        } else {
            XB_SPIN(xb_ld(&bar[XB_XGEN(b.x)]) == gen, bar);
            __builtin_amdgcn_fence(__ATOMIC_ACQUIRE, "agent");
            asm volatile("s_waitcnt vmcnt(0)" ::: "memory");
        }
    }
    __syncthreads();
}


struct MapId { __device__ __forceinline__ int operator()(int r) const { return r; } };
struct MapGu { __device__ __forceinline__ int operator()(int r) const { return gu_src_col(r); } };
struct MapIn { __device__ __forceinline__ int operator()(int r) const { return win_src_col(r); } };
template <class Map>
__device__ __forceinline__ void tr_item(const float* W, int K, int ldw, bf16_t* WT, LAS float* scr, int item, int nblk, int lane, Map map, const float* kscale = nullptr) {
    const int kb = item / nblk, nb = item % nblk, k0 = 64 * kb, n0 = 64 * nb;
    const int r4 = lane >> 4, c4 = lane & 15;
    const int src = map(n0 + 4 * c4);
    f32x4 v[16];
    const float* wp = W + (size_t)(k0 + r4) * ldw + (src >= 0 ? src : 0);
#pragma unroll
    for (int i = 0; i < 16; ++i) v[i] = *(const f32x4*)(wp + (size_t)(4 * i) * ldw);
    if (src < 0) {
#pragma unroll
        for (int i = 0; i < 16; ++i) v[i] = (f32x4){0.f, 0.f, 0.f, 0.f};
    }
    if (kscale) {
#pragma unroll
        for (int i = 0; i < 16; ++i) v[i] = v[i] * kscale[k0 + 4 * i + r4];
    }
#pragma unroll
    for (int i = 0; i < 16; ++i) { LAS float* d = scr + (4 * i + r4) * 65 + 4 * c4; d[0] = v[i][0]; d[1] = v[i][1]; d[2] = v[i][2]; d[3] = v[i][3]; }
    LDS_WAIT(); asm volatile("" ::: "memory");
    const int c = lane & 7;
#pragma unroll
    for (int j = 0; j < 8; ++j) { const int n = (lane >> 3) + 8 * j; const LAS float* sp = scr + (8 * c) * 65 + n;
        u32x4 o; o.x = cvt_pk_bf16(sp[0 * 65], sp[1 * 65]); o.y = cvt_pk_bf16(sp[2 * 65], sp[3 * 65]); o.z = cvt_pk_bf16(sp[4 * 65], sp[5 * 65]); o.w = cvt_pk_bf16(sp[6 * 65], sp[7 * 65]);
        *(u32x4*)(WT + (size_t)(n0 + n) * K + k0 + 8 * c) = o; }
    LDS_WAIT(); asm volatile("" ::: "memory");
}
struct LayerW {
    const float *gu1, *d1, *gu2, *d2, *win, *wout, *w1k, *w1v, *kpe, *vpe, *pre1, *prem, *pre2;
};
__device__ __forceinline__ void phase_convert(const Ctx& c, const LayerW& L, unsigned char* ws) {
    LAS float* scr = (LAS float*)(c.lds + c.wave * 16640);
    constexpr int B_GU = (DM / 256) * (2 * DFF / 128), B_D = (DFF / 256) * (DM / 128), B_IN = (DM / 256) * (NPROJ / 128), B_O = (DM / 256) * (DM / 128), B_1 = (DM / 256) * (256 / 128);
    constexpr int NBI = 2 * B_GU + 2 * B_D + B_IN + B_O + 2 * B_1;
    const int wk = c.wave >> 1, wn = c.wave & 1;
#define TR_CALL(W_, K_, LDW_, WT_, N_, MAP_, KS_) do { const int nb2n = (N_) / 128, kb = 4 * (r / nb2n) + wk, nb = 2 * (r % nb2n) + wn; tr_item(W_, K_, LDW_, WT_, scr, kb * ((N_) / 64) + nb, (N_) / 64, c.lane, MAP_, KS_); } while (0)
    for (int it = c.bid; it < NBI; it += c.G) {
        int r = it;
        if (r < B_GU) { TR_CALL(L.gu1, DM, 2 * DFF, (bf16_t*)(ws + WS_WGU1), 2 * DFF, MapGu(), L.pre1); continue; } r -= B_GU;
        if (r < B_GU) { TR_CALL(L.gu2, DM, 2 * DFF, (bf16_t*)(ws + WS_WGU2), 2 * DFF, MapGu(), L.pre2); continue; } r -= B_GU;
        if (r < B_D) { TR_CALL(L.d1, DFF, DM, (bf16_t*)(ws + WS_WD1), DM, MapId(), nullptr); continue; } r -= B_D;
        if (r < B_D) { TR_CALL(L.d2, DFF, DM, (bf16_t*)(ws + WS_WD2), DM, MapId(), nullptr); continue; } r -= B_D;
        if (r < B_IN) { TR_CALL(L.win, DM, DIN, (bf16_t*)(ws + WS_WIN), NPROJ, MapIn(), L.prem); continue; } r -= B_IN;
        if (r < B_O) { TR_CALL(L.wout, DM, DM, (bf16_t*)(ws + WS_WOUT), DM, MapId(), nullptr); continue; } r -= B_O;
        if (r < B_1) { TR_CALL(L.w1k, DM, 256, (bf16_t*)(ws + WS_W1), 256, MapId(), nullptr); continue; } r -= B_1;
        TR_CALL(L.w1v, DM, 256, (bf16_t*)(ws + WS_W1) + 256 * DM, 256, MapId(), nullptr);
    }
#undef TR_CALL
    for (int seg = c.bid; seg < 256; seg += c.G) {
        const int kv = c.tid >> 8, col = c.tid & 255;
        const float* pe = kv ? L.vpe : L.kpe; const float* w1 = kv ? L.w1v : L.w1k;
        float s = 0.f;
#pragma unroll
        for (int k = 0; k < 8; ++k) s += pe[8 * seg + k] * w1[(size_t)(8 * seg + k) * 256 + col];
        ((float*)(ws + WS_PEP))[(kv * 256 + seg) * 256 + col] = s;
    }
}

__device__ __forceinline__ void phase_norm(const Ctx& c, const float* xin, const bf16_t* T, float alpha, const float* wpost, bf16_t* HB, float* RS, float* outf) {
    const int gw = c.bid * NWAVES + c.wave, NGW = c.G * NWAVES;
    if (xin) {
        for (int row = gw; row < M; row += NGW) {
            const size_t i0 = (size_t)row * 512 + c.lane; float ss = 0.f;
#pragma unroll
            for (int j = 0; j < 8; ++j) { const f32x4 hv = ((const f32x4*)xin)[i0 + 64 * j]; ss += (hv[0] * hv[0] + hv[1] * hv[1]) + (hv[2] * hv[2] + hv[3] * hv[3]);
                u32x2 pk; pk.x = cvt_pk_bf16(hv[0], hv[1]); pk.y = cvt_pk_bf16(hv[2], hv[3]); ((u32x2*)HB)[i0 + 64 * j] = pk; }
            const float rs = 1.0f / sqrtf(wave_sum(ss) * (1.0f / DM) + EPS);
            if (c.lane == 0) RS[row] = rs;
        }
        return;
    }
    for (int row = gw; row < M; row += 2 * NGW) {
        const bool two = row + NGW < M;
        const size_t i0 = (size_t)row * 512 + c.lane, i1 = (size_t)(two ? row + NGW : row) * 512 + c.lane;
        u32x2 tw[2][8], hw[2][8];
#pragma unroll
        for (int j = 0; j < 8; ++j) { tw[0][j] = ((const u32x2*)T)[i0 + 64 * j]; tw[1][j] = ((const u32x2*)T)[i1 + 64 * j]; }
#pragma unroll
        for (int j = 0; j < 8; ++j) { hw[0][j] = ((const u32x2*)HB)[i0 + 64 * j]; hw[1][j] = ((const u32x2*)HB)[i1 + 64 * j]; }
        f32x4 wp[8];
#pragma unroll
        for (int j = 0; j < 8; ++j) wp[j] = ((const f32x4*)wpost)[c.lane + 64 * j];
#pragma unroll
        for (int q = 0; q < 2; ++q) {
            if (q == 1 && !two) break;
            const size_t iq = q ? i1 : i0; const int rq = q ? row + NGW : row;
            f32x4 tv[8]; float ss = 0.f;
#pragma unroll
            for (int j = 0; j < 8; ++j) { tv[j] = (f32x4){bflo(tw[q][j].x), bfhi(tw[q][j].x), bflo(tw[q][j].y), bfhi(tw[q][j].y)};
                ss += (tv[j][0] * tv[j][0] + tv[j][1] * tv[j][1]) + (tv[j][2] * tv[j][2] + tv[j][3] * tv[j][3]); }
            const float rs = alpha / sqrtf(wave_sum(ss) * (1.0f / DM) + EPS);
            float s2 = 0.f;
#pragma unroll
            for (int j = 0; j < 8; ++j) { const f32x4 hv = (f32x4){bflo(hw[q][j].x), bfhi(hw[q][j].x), bflo(hw[q][j].y), bfhi(hw[q][j].y)} + tv[j] * rs * wp[j];
                if (outf) ((f32x4*)outf)[iq + 64 * j] = hv;
                else { s2 += (hv[0] * hv[0] + hv[1] * hv[1]) + (hv[2] * hv[2] + hv[3] * hv[3]);
                    u32x2 pk; pk.x = cvt_pk_bf16(hv[0], hv[1]); pk.y = cvt_pk_bf16(hv[2], hv[3]); ((u32x2*)HB)[iq + 64 * j] = pk; } }
            if (!outf) { const float r2 = 1.0f / sqrtf(wave_sum(s2) * (1.0f / DM) + EPS); if (c.lane == 0) RS[rq] = r2; }
        }
    }
}

struct SsdW { const float *conv_w, *conv_b, *dt_bias, *a_log, *dskip, *norm_w; };
__device__ __forceinline__ float softplus_f(float x) { return x > 20.f ? x : log1pf(__expf(x)); }

__device__ __forceinline__ void ssd_conv8(const bf16_t* PROJ, const SsdW& W, int b, int s, int ch0, float (&out)[8]) {
    const f32x4 b0 = *(const f32x4*)(W.conv_b + ch0), b1 = *(const f32x4*)(W.conv_b + ch0 + 4);
    float acc[8] = {b0[0], b0[1], b0[2], b0[3], b1[0], b1[1], b1[2], b1[3]};
#pragma unroll
    for (int k = 0; k < 4; ++k) {
        const int sr = s - 3 + k;
        if (sr >= 0) {
            const u32x4 x = *(const u32x4*)(PROJ + (size_t)(b * SEQ + sr) * NPROJ + PC_XBC + ch0);
            const f32x4 w0 = *(const f32x4*)(W.conv_w + k * 1536 + ch0), w1 = *(const f32x4*)(W.conv_w + k * 1536 + ch0 + 4);
            acc[0] += w0[0] * bflo(x.x); acc[1] += w0[1] * bfhi(x.x); acc[2] += w0[2] * bflo(x.y); acc[3] += w0[3] * bfhi(x.y);
            acc[4] += w1[0] * bflo(x.z); acc[5] += w1[1] * bfhi(x.z); acc[6] += w1[2] * bflo(x.w); acc[7] += w1[3] * bfhi(x.w);
        }
    }
#pragma unroll
    for (int e = 0; e < 8; ++e) out[e] = silu_f(acc[e]);
}
struct Conv8W { f32x4 w[4][2]; f32x4 b[2]; };
__device__ __forceinline__ Conv8W conv8_load_w(const SsdW& W, int ch0) { Conv8W r;
#pragma unroll
    for (int k = 0; k < 4; ++k) { r.w[k][0] = *(const f32x4*)(W.conv_w + k * 1536 + ch0); r.w[k][1] = *(const f32x4*)(W.conv_w + k * 1536 + ch0 + 4); }
    r.b[0] = *(const f32x4*)(W.conv_b + ch0); r.b[1] = *(const f32x4*)(W.conv_b + ch0 + 4); return r; }
__device__ __forceinline__ void conv8_load_x(const bf16_t* PROJ, int b, int s, int ch0, u32x4 (&x)[4]) {
#pragma unroll
    for (int k = 0; k < 4; ++k) { const int sr = s - 3 + k; x[k] = (u32x4){0u, 0u, 0u, 0u}; if (sr >= 0) x[k] = *(const u32x4*)(PROJ + (size_t)(b * SEQ + sr) * NPROJ + PC_XBC + ch0); } }
__device__ __forceinline__ void conv8_apply(const Conv8W& cw, const u32x4 (&x)[4], float (&out)[8]) {
    float acc[8] = {cw.b[0][0], cw.b[0][1], cw.b[0][2], cw.b[0][3], cw.b[1][0], cw.b[1][1], cw.b[1][2], cw.b[1][3]};
#pragma unroll
    for (int k = 0; k < 4; ++k) {
        acc[0] += cw.w[k][0][0] * bflo(x[k].x); acc[1] += cw.w[k][0][1] * bfhi(x[k].x); acc[2] += cw.w[k][0][2] * bflo(x[k].y); acc[3] += cw.w[k][0][3] * bfhi(x[k].y);
        acc[4] += cw.w[k][1][0] * bflo(x[k].z); acc[5] += cw.w[k][1][1] * bfhi(x[k].z); acc[6] += cw.w[k][1][2] * bflo(x[k].w); acc[7] += cw.w[k][1][3] * bfhi(x[k].w); }
#pragma unroll
    for (int e = 0; e < 8; ++e) out[e] = silu_f(acc[e]);
}
__device__ __forceinline__ u32x4 pack8(const float (&v)[8]) { u32x4 w; w.x = cvt_pk_bf16(v[0], v[1]); w.y = cvt_pk_bf16(v[2], v[3]); w.z = cvt_pk_bf16(v[4], v[5]); w.w = cvt_pk_bf16(v[6], v[7]); return w; }

constexpr int P136 = 272, P72 = 144;
__device__ __forceinline__ void ssd_a_unit(const Ctx& c, const SsdW& W, unsigned char* ws, int unit) {
    const int g = unit & 1, ch = (unit >> 1) & 63, b = unit >> 7;
    const bf16_t* PROJ = (const bf16_t*)(ws + WS_PROJ); bf16_t* XACT = (bf16_t*)(ws + WS_XACT);
    float* DT = (float*)(ws + WS_DT); float* CS = (float*)(ws + WS_CS); float* CDEC = (float*)(ws + WS_CDEC); bf16_t* ST = (bf16_t*)(ws + WS_STATES);
    LAS float* sclS = (LAS float*)(c.lds + 8192);
    LAS unsigned char* Bs = c.lds + 12288;
    LAS unsigned char* Xs = c.lds + 12288 + 128 * P136;
    const int m0 = b * SEQ + ch * 128;
    const int q8 = c.tid & 7, xs = c.tid >> 3;
    Conv8W hw = conv8_load_w(W, 64 * (8 * g) + 8 * q8);
    u32x4 hx[2][4];
#pragma unroll
    for (int i = 0; i < 2; ++i) conv8_load_x(PROJ, b, ch * 128 + xs + 64 * i, 64 * (8 * g) + 8 * q8, hx[i]);
    __syncthreads();
    {
        const int hh = 8 * g + c.wave; const float bias = W.dt_bias[hh], a = -__expf(W.a_log[hh]);
        const int s0 = 2 * c.lane;
        const float r0 = bf2f(PROJ[(size_t)(m0 + s0) * NPROJ + PC_DT + hh]), r1 = bf2f(PROJ[(size_t)(m0 + s0 + 1) * NPROJ + PC_DT + hh]);
        const float dt0 = softplus_f(r0 + bias), dt1 = softplus_f(r1 + bias);
        const float v0 = a * dt0, pair = v0 + a * dt1;
        float x = pair;
#pragma unroll
        for (int o = 1; o < 64; o <<= 1) { const float y = __shfl_up(x, o); if (c.lane >= o) x += y; }
        const float cs0 = (x - pair) + v0, cs1 = x, tot = __shfl(x, 63);
        sclS[c.wave * 128 + s0] = __expf(tot - cs0) * dt0; sclS[c.wave * 128 + s0 + 1] = __expf(tot - cs1) * dt1;
        DT[(size_t)(m0 + s0) * 16 + hh] = dt0; DT[(size_t)(m0 + s0 + 1) * 16 + hh] = dt1;
        CS[(size_t)(m0 + s0) * 16 + hh] = cs0; CS[(size_t)(m0 + s0 + 1) * 16 + hh] = cs1;
        if (c.lane == 63) CDEC[(b * 64 + ch) * 16 + hh] = __expf(tot);
    }
    {
        const int q = c.tid & 31, ch0 = (q < 16) ? 1024 + 128 * g + 8 * q : 1280 + 128 * g + 8 * (q - 16);
        const Conv8W cw = conv8_load_w(W, ch0);
#pragma unroll
        for (int k0 = 0; k0 < 8; k0 += 4) {
            u32x4 x[4][4];
#pragma unroll
            for (int i = 0; i < 4; ++i) conv8_load_x(PROJ, b, ch * 128 + (c.tid >> 5) + 16 * (k0 + i), ch0, x[i]);
#pragma unroll
            for (int i = 0; i < 4; ++i) { const int s = (c.tid >> 5) + 16 * (k0 + i);
                float v[8]; conv8_apply(cw, x[i], v);
                const u32x4 pk = pack8(v);
                *(u32x4*)(XACT + (size_t)(m0 + s) * 1536 + ch0) = pk;
                if (q < 16) *(LAS u32x4*)(Bs + s * P136 + q * 16) = pk; }
        }
    }
    for (int h8 = 0; h8 < 8; ++h8) {
        const int hh = 8 * g + h8;
        __syncthreads();
        {
            const int ch0 = 64 * hh + 8 * q8;
            float v[2][8];
#pragma unroll
            for (int i = 0; i < 2; ++i) conv8_apply(hw, hx[i], v[i]);
            if (h8 < 7) { hw = conv8_load_w(W, ch0 + 64);
#pragma unroll
                for (int i = 0; i < 2; ++i) conv8_load_x(PROJ, b, ch * 128 + xs + 64 * i, ch0 + 64, hx[i]); }
#pragma unroll
            for (int i = 0; i < 2; ++i) { const int s = xs + 64 * i;
                *(u32x4*)(XACT + (size_t)(m0 + s) * 1536 + ch0) = pack8(v[i]);
                const float sc = sclS[h8 * 128 + s];
#pragma unroll
                for (int e = 0; e < 8; ++e) v[i][e] *= sc;
                *(LAS u32x4*)(Xs + s * P72 + q8 * 16) = pack8(v[i]); }
        }
        __syncthreads();
        const int pt = c.wave & 3, ntg = c.wave >> 2;
        f32x4 acc[4];
#pragma unroll
        for (int nt = 0; nt < 4; ++nt) acc[nt] = (f32x4){0.f, 0.f, 0.f, 0.f};
#pragma unroll
        for (int ks = 0; ks < 4; ++ks) {
            const bf16x8 xf = frag_tr(Xs, P72, 32 * ks, 16 * pt, c.lane);
#pragma unroll
            for (int nt = 0; nt < 4; ++nt) { const bf16x8 bf = frag_tr(Bs, P136, 32 * ks, 16 * (4 * ntg + nt), c.lane); acc[nt] = MFMA16(bf, xf, acc[nt]); }
        }
        bf16_t* stp = ST + ((size_t)((b * 64 + ch) * 16 + hh) * 64 + 16 * pt + (c.lane & 15)) * 128 + 4 * (c.lane >> 4);
#pragma unroll
        for (int nt = 0; nt < 4; ++nt) { u32x2 pk; pk.x = cvt_pk_bf16(acc[nt][0], acc[nt][1]); pk.y = cvt_pk_bf16(acc[nt][2], acc[nt][3]); *(u32x2*)(stp + 16 * (4 * ntg + nt)) = pk; }
    }
}

__device__ __forceinline__ void phase_ssd_scan(const Ctx& c, unsigned char* ws) {
    const unsigned* ST = (const unsigned*)(ws + WS_STATES); const float* CDEC = (const float*)(ws + WS_CDEC); unsigned* HP = (unsigned*)(ws + WS_HP);
    for (int chain = c.bid * NTHR + c.tid; chain < NB * 16 * 64 * 64; chain += c.G * NTHR) {
        const int n2 = chain & 63, p = (chain >> 6) & 63, hh = (chain >> 12) & 15, b = chain >> 16;
        f32x2 run = (f32x2){0.f, 0.f};
#pragma unroll 16
        for (int ch = 0; ch < 64; ++ch) {
            const size_t idx = ((size_t)((b * 64 + ch) * 16 + hh) * 64 + p) * 64 + n2;
            const unsigned sp = ST[idx]; const f32x2 s = (f32x2){bflo(sp), bfhi(sp)}; const float dec = CDEC[(b * 64 + ch) * 16 + hh];
            HP[idx] = cvt_pk_bf16(run[0], run[1]);
            run = run * dec + s;
        }
    }
}

__device__ __forceinline__ void ssd_b_unit(const Ctx& c, const SsdW& W, unsigned char* ws, int unit) {
    const int g = unit & 1, ch = (unit >> 1) & 63, b = unit >> 7;
    const bf16_t* PROJ = (const bf16_t*)(ws + WS_PROJ); const bf16_t* XACT = (const bf16_t*)(ws + WS_XACT); const bf16_t* HP = (const bf16_t*)(ws + WS_HP);
    const float* DT = (const float*)(ws + WS_DT); const float* CS = (const float*)(ws + WS_CS); bf16_t* Y = (bf16_t*)(ws + WS_Y);
    LAS float* csS = (LAS float*)(c.lds);
    LAS float* dtS = (LAS float*)(c.lds + 4096);
    LAS unsigned char* Cs = c.lds + 8192;
    LAS unsigned char* Ws = Cs + 128 * P136;
    LAS unsigned char* CBs = Ws + 128 * P136;
    LAS unsigned char* Xs = CBs + 128 * P136;
    LAS unsigned char* Hs = Xs + 128 * P72;
    const int m0 = b * SEQ + ch * 128, lane = c.lane, w = c.wave;
    __syncthreads();
    {
        u32x4 sv[8]; float cv[2], dv[2];
#pragma unroll
        for (int i = 0; i < 8; ++i) { const int it = c.tid + NTHR * i, s = it >> 5, q = it & 31;
            sv[i] = *(const u32x4*)(XACT + (size_t)(m0 + s) * 1536 + ((q < 16) ? 1280 + 128 * g + 8 * q : 1024 + 128 * g + 8 * (q - 16))); }
#pragma unroll
        for (int i = 0; i < 2; ++i) { const int it = c.tid + NTHR * i, s = it >> 3, h8 = it & 7; cv[i] = CS[(size_t)(m0 + s) * 16 + 8 * g + h8]; dv[i] = DT[(size_t)(m0 + s) * 16 + 8 * g + h8]; }
#pragma unroll
        for (int i = 0; i < 8; ++i) { const int it = c.tid + NTHR * i, s = it >> 5, q = it & 31; *(LAS u32x4*)(((q < 16) ? Cs : Ws) + s * P136 + (q & 15) * 16) = sv[i]; }
#pragma unroll
        for (int i = 0; i < 2; ++i) { const int it = c.tid + NTHR * i, s = it >> 3, h8 = it & 7; csS[h8 * 128 + s] = cv[i]; dtS[h8 * 128 + s] = dv[i]; }
    }
    __syncthreads();
    bf16x8 cfr[4];
#pragma unroll
    for (int ks = 0; ks < 4; ++ks) cfr[ks] = frag_row(Cs, P136, 16 * w, 32 * ks, lane);
    for (int st = 0; st <= w; ++st) {
        f32x4 a = (f32x4){0.f, 0.f, 0.f, 0.f};
#pragma unroll
        for (int ks = 0; ks < 4; ++ks) a = MFMA16(frag_row(Ws, P136, 16 * st, 32 * ks, lane), cfr[ks], a);
        u32x2 pk; pk.x = cvt_pk_bf16(a[0], a[1]); pk.y = cvt_pk_bf16(a[2], a[3]);
        *(LAS u32x2*)(CBs + (16 * w + (lane & 15)) * P136 + (16 * st + 4 * (lane >> 4)) * 2) = pk;
    }
    float ssq = 0.f;
    const int tok = 16 * w + (lane & 15);
    const int xs0 = c.tid >> 3, xq = c.tid & 7, hp0 = c.tid >> 4, hq = c.tid & 15;
    u32x4 xr[2], hr[2];
#define SSDB_FETCH(hh_) do { \
        xr[0] = *(const u32x4*)(XACT + (size_t)(m0 + xs0) * 1536 + 64 * (hh_) + 8 * xq); xr[1] = *(const u32x4*)(XACT + (size_t)(m0 + xs0 + 64) * 1536 + 64 * (hh_) + 8 * xq); \
        hr[0] = *(const u32x4*)(HP + ((size_t)((b * 64 + ch) * 16 + (hh_)) * 64 + hp0) * 128 + 8 * hq); hr[1] = *(const u32x4*)(HP + ((size_t)((b * 64 + ch) * 16 + (hh_)) * 64 + hp0 + 32) * 128 + 8 * hq); } while (0)
    SSDB_FETCH(8 * g);
    for (int h8 = 0; h8 < 8; ++h8) {
        const int hh = 8 * g + h8;
        u32x2 zv[4];
#pragma unroll
        for (int pt = 0; pt < 4; ++pt) zv[pt] = *(const u32x2*)(PROJ + (size_t)(m0 + tok) * NPROJ + PC_Z + 64 * hh + 16 * pt + 4 * (lane >> 4));
        __syncthreads();
        *(LAS u32x4*)(Xs + xs0 * P72 + xq * 16) = xr[0]; *(LAS u32x4*)(Xs + (xs0 + 64) * P72 + xq * 16) = xr[1];
        *(LAS u32x4*)(Hs + hp0 * P136 + hq * 16) = hr[0]; *(LAS u32x4*)(Hs + (hp0 + 32) * P136 + hq * 16) = hr[1];
        if (h8 < 7) SSDB_FETCH(hh + 1);
        for (int it = c.tid; it < 128 * 16; it += NTHR) {
            const int l = it >> 4, q = it & 15, s0 = 8 * q;
            u32x4 o = (u32x4){0u, 0u, 0u, 0u};
            if (s0 <= l) {
                const u32x4 cb = *(const LAS u32x4*)(CBs + l * P136 + q * 16); const float cl = csS[h8 * 128 + l];
                float v[8] = {bflo(cb.x), bfhi(cb.x), bflo(cb.y), bfhi(cb.y), bflo(cb.z), bfhi(cb.z), bflo(cb.w), bfhi(cb.w)};
                const f32x4 c0 = *(const LAS f32x4*)(csS + h8 * 128 + s0), c1 = *(const LAS f32x4*)(csS + h8 * 128 + s0 + 4), d0 = *(const LAS f32x4*)(dtS + h8 * 128 + s0), d1 = *(const LAS f32x4*)(dtS + h8 * 128 + s0 + 4);
                const float csv[8] = {c0[0], c0[1], c0[2], c0[3], c1[0], c1[1], c1[2], c1[3]}, dtv[8] = {d0[0], d0[1], d0[2], d0[3], d1[0], d1[1], d1[2], d1[3]};
#pragma unroll
                for (int e = 0; e < 8; ++e) { const int s = s0 + e; v[e] = (s <= l) ? v[e] * __expf(cl - csv[e]) * dtv[e] : 0.f; }
                o = pack8(v);
            }
            *(LAS u32x4*)(Ws + l * P136 + q * 16) = o;
        }
        __syncthreads();
        const int nks = (w >> 1) + 1;
        const float ecs = __expf(csS[h8 * 128 + tok]), dsk = W.dskip[hh];
#pragma unroll
        for (int pt = 0; pt < 4; ++pt) {
            f32x4 yd = (f32x4){0.f, 0.f, 0.f, 0.f}, yo = (f32x4){0.f, 0.f, 0.f, 0.f};
            for (int ks = 0; ks < nks; ++ks) yd = MFMA16(frag_tr(Xs, P72, 32 * ks, 16 * pt, lane), frag_row(Ws, P136, 16 * w, 32 * ks, lane), yd);
#pragma unroll
            for (int ks = 0; ks < 4; ++ks) yo = MFMA16(frag_row(Hs, P136, 16 * pt, 32 * ks, lane), cfr[ks], yo);
            const int p0 = 16 * pt + 4 * (lane >> 4);
            const u32x2 xv = *(const LAS u32x2*)(Xs + tok * P72 + p0 * 2);
            const float xx[4] = {bflo(xv.x), bfhi(xv.x), bflo(xv.y), bfhi(xv.y)}, zz[4] = {bflo(zv[pt].x), bfhi(zv[pt].x), bflo(zv[pt].y), bfhi(zv[pt].y)};
            float yv[4];
#pragma unroll
            for (int r = 0; r < 4; ++r) { yv[r] = (yd[r] + ecs * yo[r] + dsk * xx[r]) * silu_f(zz[r]); ssq += yv[r] * yv[r]; }
            u32x2 pk; pk.x = cvt_pk_bf16(yv[0], yv[1]); pk.y = cvt_pk_bf16(yv[2], yv[3]);
            *(u32x2*)(Y + (size_t)(m0 + tok) * DM + 64 * hh + p0) = pk;
        }
    }
#undef SSDB_FETCH
    ssq += __shfl_xor(ssq, 16); ssq += __shfl_xor(ssq, 32);
    const float rstd = 1.0f / sqrtf(ssq * (1.0f / 512.f) + EPS);
    VM_WAIT(); __builtin_amdgcn_fence(__ATOMIC_ACQUIRE, "agent"); VM_WAIT();
    const f32x4 nw0 = *(const f32x4*)(W.norm_w + 512 * g + 8 * lane), nw1 = *(const f32x4*)(W.norm_w + 512 * g + 8 * lane + 4);
    u32x4 yrow[16];
#pragma unroll
    for (int t = 0; t < 16; ++t) yrow[t] = *(const u32x4*)(Y + (size_t)(m0 + 16 * w + t) * DM + 512 * g + 8 * lane);
#pragma unroll
    for (int t = 0; t < 16; ++t) {
        const float rs = __shfl(rstd, t);
        bf16_t* yp = Y + (size_t)(m0 + 16 * w + t) * DM + 512 * g + 8 * lane;
        const u32x4 v = yrow[t];
        float o[8] = {bflo(v.x) * rs * nw0[0], bfhi(v.x) * rs * nw0[1], bflo(v.y) * rs * nw0[2], bfhi(v.y) * rs * nw0[3],
                      bflo(v.z) * rs * nw1[0], bfhi(v.z) * rs * nw1[1], bflo(v.w) * rs * nw1[2], bfhi(v.w) * rs * nw1[3]};
        *(u32x4*)yp = pack8(o);
    }
}

struct CnvW { const float *dw_w, *dw_b, *ln_w, *ln_b; };
__device__ __forceinline__ void cnv_unit(const Ctx& c, const CnvW& W, unsigned char* ws, int unit) {
    const bf16_t* PROJ = (const bf16_t*)(ws + WS_PROJ); bf16_t* Y = (bf16_t*)(ws + WS_Y);
    LAS float* vin = (LAS float*)c.lds;
    LAS float* red = (LAS float*)(c.lds + 62 * 512 * 4);
    const int b = unit >> 8, s0 = (unit & 255) * 32;
    __syncthreads();
    {
        u32x4 ra[8], rg[8];
#pragma unroll
        for (int i = 0; i < 8; ++i) { const int it = c.tid + NTHR * i, r = it >> 6, q = it & 63, s = s0 - 30 + r;
            ra[i] = (u32x4){0u, 0u, 0u, 0u}; rg[i] = (u32x4){0u, 0u, 0u, 0u};
            if (it < 62 * 64 && s >= 0) { const bf16_t* row = PROJ + (size_t)(b * SEQ + s) * NPROJ + PC_GLU + 8 * q; ra[i] = *(const u32x4*)row; rg[i] = *(const u32x4*)(row + 512); } }
#pragma unroll
        for (int i = 0; i < 8; ++i) { const int it = c.tid + NTHR * i, r = it >> 6, q = it & 63;
            if (it < 62 * 64) {
                const u32x4 a = ra[i], gt = rg[i];
                const float av[8] = {bflo(a.x), bfhi(a.x), bflo(a.y), bfhi(a.y), bflo(a.z), bfhi(a.z), bflo(a.w), bfhi(a.w)};
                const float gv[8] = {bflo(gt.x), bfhi(gt.x), bflo(gt.y), bfhi(gt.y), bflo(gt.z), bfhi(gt.z), bflo(gt.w), bfhi(gt.w)};
                float v[8];
#pragma unroll
                for (int e = 0; e < 8; ++e) v[e] = av[e] * __builtin_amdgcn_rcpf(1.0f + __expf(-gv[e]));
                *(LAS f32x4*)(vin + r * 512 + 8 * q) = (f32x4){v[0], v[1], v[2], v[3]}; *(LAS f32x4*)(vin + r * 512 + 8 * q + 4) = (f32x4){v[4], v[5], v[6], v[7]};
            } }
    }
    __syncthreads();
    const int ch = c.tid;
    float acc[32];
    { const float bias = W.dw_b[ch];
#pragma unroll
      for (int t = 0; t < 32; ++t) acc[t] = bias; }
    {
        float xin[62];
#pragma unroll
        for (int r = 0; r < 62; ++r) xin[r] = vin[r * 512 + ch];
#pragma unroll
        for (int k = 0; k < 31; ++k) { const float wk = W.dw_w[k * 512 + ch];
#pragma unroll
            for (int t = 0; t < 32; ++t) acc[t] += wk * xin[t + k]; }
    }
#pragma unroll
    for (int t = 0; t < 32; ++t) { const float s1 = wave_sum(acc[t]), s2 = wave_sum(acc[t] * acc[t]); if (c.lane == 0) { red[(c.wave * 32 + t) * 2] = s1; red[(c.wave * 32 + t) * 2 + 1] = s2; } }
    __syncthreads();
    const float lw = W.ln_w[ch], lb = W.ln_b[ch];
#pragma unroll
    for (int t = 0; t < 32; ++t) {
        float s1 = 0.f, s2 = 0.f;
#pragma unroll
        for (int wv = 0; wv < 8; ++wv) { s1 += red[(wv * 32 + t) * 2]; s2 += red[(wv * 32 + t) * 2 + 1]; }
        const float mu = s1 * (1.0f / 512.f), var = fmaxf(s2 * (1.0f / 512.f) - mu * mu, 0.f);
        const float o = silu_f((acc[t] - mu) * __builtin_amdgcn_rsqf(var + EPS) * lw + lb);
        Y[(size_t)(b * SEQ + s0 + t) * DM + 1536 + ch] = (bf16_t)(cvt_pk_bf16(o, 0.f) & 0xffffu);
    }
}

__device__ __forceinline__ void nsa_cmp2(const Ctx& c, const float* w2, const bf16_t* H1, bf16_t* KC, int pm) {
    LAS unsigned char* W2s = c.lds;
    VM_WAIT(); __syncthreads();
    __builtin_amdgcn_fence(__ATOMIC_ACQUIRE, "agent"); VM_WAIT();
    for (int it = c.tid; it < 256 * 8; it += NTHR) { const int k = it >> 3, q = it & 7;
        const f32x4 a = *(const f32x4*)(w2 + k * 64 + 8 * q), b = *(const f32x4*)(w2 + k * 64 + 8 * q + 4);
        u32x4 o; o.x = cvt_pk_bf16(a[0], a[1]); o.y = cvt_pk_bf16(a[2], a[3]); o.z = cvt_pk_bf16(b[0], b[1]); o.w = cvt_pk_bf16(b[2], b[3]);
        *(LAS u32x4*)(W2s + k * P72 + q * 16) = o; }
    __syncthreads();
    const int lane = c.lane;
#pragma unroll
    for (int rt = 0; rt < 2; ++rt) {
        const int r0 = pm * 256 + c.wave * 32 + rt * 16;
        f32x4 acc[4];
#pragma unroll
        for (int dt = 0; dt < 4; ++dt) acc[dt] = (f32x4){0.f, 0.f, 0.f, 0.f};
        for (int ks = 0; ks < 8; ++ks) {
            const bf16x8 hf = *(const bf16x8*)(H1 + (size_t)(r0 + (lane & 15)) * 256 + 32 * ks + 8 * (lane >> 4));
#pragma unroll
            for (int dt = 0; dt < 4; ++dt) acc[dt] = MFMA16(frag_tr(W2s, P72, 32 * ks, 16 * dt, lane), hf, acc[dt]);
        }
#pragma unroll
        for (int dt = 0; dt < 4; ++dt) { u32x2 pk; pk.x = cvt_pk_bf16(acc[dt][0], acc[dt][1]); pk.y = cvt_pk_bf16(acc[dt][2], acc[dt][3]);
            *(u32x2*)(KC + (size_t)(r0 + (lane & 15)) * 64 + 16 * dt + 4 * (lane >> 4)) = pk; }
    }
}

typedef unsigned long long u64;
__device__ __forceinline__ int next_bit(u64 lo, u64 hi, int from) {
    if (from < 64) { const u64 m = lo & (~0ull << from); if (m) return __builtin_ctzll(m); from = 64; }
    if (from < 128) { const u64 m = hi & (~0ull << (from - 64)); if (m) return 64 + __builtin_ctzll(m); }
    return -1;
}
constexpr int NSA_D = 6, NSA_SLOT = 16384, NSA_RING = 0, NSA_IMP = NSA_D * NSA_SLOT, NSA_SELM = NSA_IMP + 8 * 8 * 132 * 4, NSA_END = NSA_SELM + 64 * 16;
static_assert(NSA_END <= LDS_WORK, "NSA LDS map");
__device__ __forceinline__ bf16x8 frag_row_sw(const LAS unsigned char* base, int row0, int k0, int lane) {
    const int r = row0 + (lane & 15), cc = (k0 >> 3) + (lane >> 4);
    return *(const LAS bf16x8*)(base + r * 128 + ((cc ^ ((r >> 1) & 7)) << 4));
}
__device__ __forceinline__ void vtr_half(bf16x8 (&vf)[2][2], unsigned a00, unsigned a01, unsigned a10, unsigned a11) {
    s16x4 t[2][2][2];
    asm volatile(
        "ds_read_b64_tr_b16 %0, %8\n\tds_read_b64_tr_b16 %1, %9\n\tds_read_b64_tr_b16 %2, %8 offset:4096\n\tds_read_b64_tr_b16 %3, %9 offset:4096\n\t"
        "ds_read_b64_tr_b16 %4, %10\n\tds_read_b64_tr_b16 %5, %11\n\tds_read_b64_tr_b16 %6, %10 offset:4096\n\tds_read_b64_tr_b16 %7, %11 offset:4096\n\t"
        "s_waitcnt lgkmcnt(0)"
        : "=&v"(t[0][0][0]), "=&v"(t[0][0][1]), "=&v"(t[0][1][0]), "=&v"(t[0][1][1]), "=&v"(t[1][0][0]), "=&v"(t[1][0][1]), "=&v"(t[1][1][0]), "=&v"(t[1][1][1])
        : "v"(a00), "v"(a01), "v"(a10), "v"(a11)
        : "memory");
#pragma unroll
    for (int dt = 0; dt < 2; ++dt)
#pragma unroll
        for (int ks = 0; ks < 2; ++ks) vf[dt][ks] = (bf16x8){t[dt][ks][0][0], t[dt][ks][0][1], t[dt][ks][0][2], t[dt][ks][0][3], t[dt][ks][1][0], t[dt][ks][1][1], t[dt][ks][1][2], t[dt][ks][1][3]};
}
__device__ __forceinline__ u64 uni64(u64 x) { return ((u64)(unsigned)__builtin_amdgcn_readfirstlane((int)(x >> 32)) << 32) | (u64)(unsigned)__builtin_amdgcn_readfirstlane((int)x); }
__device__ __forceinline__ void wait_vm_n(int n) {
    if (n >= 4) asm volatile("s_waitcnt vmcnt(4)" ::: "memory"); else if (n == 2) asm volatile("s_waitcnt vmcnt(2)" ::: "memory");
    else if (n == 1) asm volatile("s_waitcnt vmcnt(1)" ::: "memory"); else asm volatile("s_waitcnt vmcnt(0)" ::: "memory");
}
__device__ __forceinline__ bool bit128(u64 lo, u64 hi, int j) { return (j < 64) ? ((lo >> j) & 1ull) : ((hi >> (j - 64)) & 1ull); }
struct NsaRows {
    int ql, hg, kq;
    int t[2];
    int tmin, tmax;
    u64 selLo[2], selHi[2];
};
template <int MODE, int KIND, bool MASKED>
__device__ __forceinline__ void nsa_block(const LAS unsigned char* Ks, unsigned vbase, const unsigned (&voff)[4][2], LAS unsigned char* Ps, LAS float* imp, int j, int lane,
                                          const NsaRows& R, const bf16x8 (&qf)[2][2], float (&lrow)[2], f32x4 (&lacc)[2], const float (&invl)[2], f32x4 (&o)[2][4]) {
    const float NEGINF = -INFINITY;
    f32x4 s[2][4];
#pragma unroll
    for (int T = 0; T < 2; ++T) {
        float sinit = 0.f;
        if (KIND == 1) sinit = bit128(R.selLo[T], R.selHi[T], j) ? 0.f : NEGINF;
#pragma unroll
        for (int kt = 0; kt < 4; ++kt) s[T][kt] = (f32x4){sinit, sinit, sinit, sinit};
    }
#pragma unroll
    for (int kt = 0; kt < 4; ++kt) {
        const bf16x8 k0 = frag_row_sw(Ks, 16 * kt, 0, lane), k1 = frag_row_sw(Ks, 16 * kt, 32, lane);
#pragma unroll
        for (int T = 0; T < 2; ++T) { s[T][kt] = MFMA16(k0, qf[T][0], s[T][kt]); s[T][kt] = MFMA16(k1, qf[T][1], s[T][kt]); }
    }
    float p[2][4][4]; bf16x8 pf[2][2];
#pragma unroll
    for (int T = 0; T < 2; ++T) {
        if (MASKED) {
#pragma unroll
            for (int kt = 0; kt < 4; ++kt)
#pragma unroll
                for (int r = 0; r < 4; ++r) {
                    const int key = 64 * j + 16 * kt + 4 * R.kq + r;
                    bool ok;
                    if (KIND == 0) ok = (16 * key + 31 <= R.t[T]);
                    else if (KIND == 1) ok = (key <= R.t[T]);
                    else ok = (key <= R.t[T]) && (R.t[T] - key < 512);
                    s[T][kt][r] = ok ? s[T][kt][r] : NEGINF;
                }
        }
        float ps = 0.f;
#pragma unroll
        for (int kt = 0; kt < 4; ++kt)
#pragma unroll
            for (int r = 0; r < 4; ++r) { p[T][kt][r] = __builtin_amdgcn_exp2f(s[T][kt][r]); if (MODE == 1) ps += p[T][kt][r]; }
        if (MODE == 1) lrow[T] += ps;
        if (MODE == 2) {
#pragma unroll
            for (int kt = 0; kt < 4; ++kt)
#pragma unroll
                for (int r = 0; r < 4; ++r) p[T][kt][r] *= invl[T];
        }
        if (MODE != 1) {
#pragma unroll
            for (int ks = 0; ks < 2; ++ks) { u32x4 w; w.x = cvt_pk_bf16(p[T][2 * ks][0], p[T][2 * ks][1]); w.y = cvt_pk_bf16(p[T][2 * ks][2], p[T][2 * ks][3]);
                w.z = cvt_pk_bf16(p[T][2 * ks + 1][0], p[T][2 * ks + 1][1]); w.w = cvt_pk_bf16(p[T][2 * ks + 1][2], p[T][2 * ks + 1][3]); pf[T][ks] = __builtin_bit_cast(bf16x8, w); }
            if (MODE == 0) {
                const u32x4 o1 = (u32x4){0x3f803f80u, 0x3f803f80u, 0x3f803f80u, 0x3f803f80u}; const bf16x8 ones = __builtin_bit_cast(bf16x8, o1);
                lacc[T] = MFMA16(ones, pf[T][0], lacc[T]); lacc[T] = MFMA16(ones, pf[T][1], lacc[T]); }
        }
    }
    if (MODE == 2) {
#pragma unroll
        for (int T = 0; T < 2; ++T)
#pragma unroll
            for (int kt = 0; kt < 4; ++kt) {
                float q4[4];
#pragma unroll
                for (int r = 0; r < 4; ++r) { float v = p[T][kt][r]; v += __shfl_xor(v, 1); v += __shfl_xor(v, 2); q4[r] = v; }
                if (R.hg == 0) { LAS float* ip = imp + (4 * T + R.ql) * 132 + 16 * j + 4 * kt + R.kq;
                    ip[0] += 2.f * (q4[0] + q4[1] + q4[2]) + q4[3]; asm volatile("" ::: "memory"); ip[1] += q4[3]; asm volatile("" ::: "memory"); }
            }
    }
    if (MODE != 1) {
#pragma unroll
        for (int dh = 0; dh < 2; ++dh) {
            bf16x8 vf[2][2];
            vtr_half(vf, vbase + voff[2 * dh][0], vbase + voff[2 * dh][1], vbase + voff[2 * dh + 1][0], vbase + voff[2 * dh + 1][1]);
#pragma unroll
            for (int T = 0; T < 2; ++T)
#pragma unroll
                for (int d2 = 0; d2 < 2; ++d2) { o[T][2 * dh + d2] = MFMA16(vf[d2][0], pf[T][0], o[T][2 * dh + d2]); o[T][2 * dh + d2] = MFMA16(vf[d2][1], pf[T][1], o[T][2 * dh + d2]); }
        }
    }
}
template <int MODE, int KIND>
__device__ __forceinline__ void nsa_pass(const Ctx& c, u64 mlo_, u64 mhi_, u64 wlo_, u64 whi_, const bf16_t* Kg, const bf16_t* Vg,
                                         const NsaRows& R, const bf16x8 (&qf)[2][2], float (&lrow)[2], const float (&invl)[2], f32x4 (&o)[2][4]) {
    f32x4 lacc[2] = {(f32x4){0.f, 0.f, 0.f, 0.f}, (f32x4){0.f, 0.f, 0.f, 0.f}};
    const u64 mlo = uni64(mlo_), mhi = uni64(mhi_), wlo = uni64(wlo_), whi = uni64(whi_);
    LAS unsigned char* ring = c.lds + NSA_RING; LAS unsigned char* Ps = nullptr;
    LAS float* imp = (LAS float*)(c.lds + NSA_IMP) + c.wave * 8 * 132;
    int lane = c.lane; asm volatile("" : "+v"(lane));
    constexpr int LPB = (MODE == 1) ? 1 : 2;
    const int drow = 8 * c.wave + (lane >> 3), dch = (lane & 7) ^ ((drow >> 1) & 7);
    const size_t goff = (size_t)drow * 64 + 8 * dch;
    unsigned voff[4][2];
    { const int g = lane >> 4, q = (lane & 15) >> 2, p = lane & 3;
#pragma unroll
      for (int dt = 0; dt < 4; ++dt)
#pragma unroll
          for (int h = 0; h < 2; ++h) { const int r = 4 * g + q + 16 * h, col = 16 * dt + 4 * p; voff[dt][h] = (unsigned)(r * 128 + (((col >> 3) ^ ((r >> 1) & 7)) << 4) + (col & 7) * 2); } }
    const unsigned ring_addr = (unsigned)(uintptr_t)ring;
#define NSA_ISSUE(jb, slot) do { \
        __builtin_amdgcn_global_load_lds((const unsigned*)(Kg + (size_t)(jb) * 4096 + goff), (LAS unsigned*)(ring + (slot) * NSA_SLOT + c.wave * 1024), 16, 0, 0); \
        if (MODE != 1) __builtin_amdgcn_global_load_lds((const unsigned*)(Vg + (size_t)(jb) * 4096 + goff), (LAS unsigned*)(ring + (slot) * NSA_SLOT + 8192 + c.wave * 1024), 16, 0, 0); } while (0)
    VM_WAIT();
    __builtin_amdgcn_s_barrier();
#define NSA_COMPUTE(jb, nth) do { if (bit128(wlo, whi, (jb))) { \
            const LAS unsigned char* Ks = ring + ((nth) % NSA_D) * NSA_SLOT; const unsigned vbase = ring_addr + (unsigned)(((nth) % NSA_D) * NSA_SLOT + 8192); \
            bool full; \
            if (KIND == 0) full = (16 * (64 * (jb) + 63) + 31 <= R.tmin); else if (KIND == 1) full = (64 * (jb) + 63 <= R.tmin); else full = (64 * (jb) + 63 <= R.tmin) && (R.tmax - 64 * (jb) < 512); \
            if (full) nsa_block<MODE, KIND, false>(Ks, vbase, voff, Ps, imp, (jb), lane, R, qf, lrow, lacc, invl, o); \
            else nsa_block<MODE, KIND, true>(Ks, vbase, voff, Ps, imp, (jb), lane, R, qf, lrow, lacc, invl, o); } } while (0)
    int ji = next_bit(mlo, mhi, 0), nissued = 0;
    for (int k = 0; k < 4 && ji >= 0; ++k) { NSA_ISSUE(ji, nissued % NSA_D); ++nissued; ji = next_bit(mlo, mhi, ji + 1); }
    int ja = next_bit(mlo, mhi, 0), ncomp = 0;
    while (ja >= 0) {
        const int jb = next_bit(mlo, mhi, ja + 1);
        const int target = ncomp + (jb >= 0 ? 2 : 1);
        wait_vm_n((nissued - target) * LPB);
        __builtin_amdgcn_s_barrier();
        for (int k = 0; k < 2 && ji >= 0; ++k) { NSA_ISSUE(ji, nissued % NSA_D); ++nissued; ji = next_bit(mlo, mhi, ji + 1); }
        NSA_COMPUTE(ja, ncomp);
        if (jb >= 0) NSA_COMPUTE(jb, ncomp + 1);
        ncomp = target; ja = (jb >= 0) ? next_bit(mlo, mhi, jb + 1) : -1;
    }
#undef NSA_COMPUTE
#undef NSA_ISSUE
    if (MODE == 0) { lrow[0] = lacc[0][0]; lrow[1] = lacc[1][0]; }
}

__device__ __forceinline__ void nsa_unit(const Ctx& c, unsigned char* ws, int b, int g, int qb) {
    const bf16_t* PROJ = (const bf16_t*)(ws + WS_PROJ); const bf16_t* KC = (const bf16_t*)(ws + WS_KC); const bf16_t* KV = (const bf16_t*)(ws + WS_KV); bf16_t* Y = (bf16_t*)(ws + WS_Y);
    const int lane = c.lane, w = c.wave, q0 = 64 * qb;
    NsaRows R; R.ql = (lane & 15) >> 2; R.hg = lane & 3; R.kq = lane >> 4; R.tmin = q0 + 8 * w; R.tmax = R.tmin + 7;
    const int tumax = q0 + 63, hq = 4 * g + R.hg;
    constexpr float QSC = 0.125f * 1.4426950408889634f;
    bf16x8 qf[2][2]; f32x4 o[2][4]; float lrow[2], invl[2]; unsigned glp[2], glq[2];
#pragma unroll
    for (int T = 0; T < 2; ++T) {
        R.t[T] = R.tmin + 4 * T + R.ql; R.selLo[T] = 0ull; R.selHi[T] = 0ull;
        const size_t mrow0 = (size_t)(b * SEQ + R.t[T]) * NPROJ;
#pragma unroll
        for (int ks = 0; ks < 2; ++ks) { const u32x4 v = *(const u32x4*)(PROJ + mrow0 + PC_Q + 64 * hq + 32 * ks + 8 * R.kq);
            u32x4 x; x.x = cvt_pk_bf16(bflo(v.x) * QSC, bfhi(v.x) * QSC); x.y = cvt_pk_bf16(bflo(v.y) * QSC, bfhi(v.y) * QSC);
            x.z = cvt_pk_bf16(bflo(v.z) * QSC, bfhi(v.z) * QSC); x.w = cvt_pk_bf16(bflo(v.w) * QSC, bfhi(v.w) * QSC);
            qf[T][ks] = __builtin_bit_cast(bf16x8, x); }
#pragma unroll
        for (int dt = 0; dt < 4; ++dt) o[T][dt] = (f32x4){0.f, 0.f, 0.f, 0.f};
        lrow[T] = 0.f; invl[T] = 0.f;
        { const bf16_t* gp = PROJ + mrow0 + PC_GL + hq * 3; glp[T] = (unsigned)gp[0] | ((unsigned)gp[1] << 16); glq[T] = (unsigned)gp[2]; }
    }
    LAS float* imp = (LAS float*)(c.lds + NSA_IMP) + w * 8 * 132;
    LAS u64* selm = (LAS u64*)(c.lds + NSA_SELM);
    __syncthreads();
    for (int i = lane; i < 8 * 132; i += 64) imp[i] = 0.f;
    const bf16_t* kc = KC + (size_t)((b * 2 + g) * 512) * 64; const bf16_t* vc = kc + (size_t)2048 * 64;
    const int ncu = (tumax >= 31) ? ((tumax - 31) / 16) / 64 + 1 : 0;
    const int ncw = (R.tmax >= 31) ? ((R.tmax - 31) / 16) / 64 + 1 : 0;
    const u64 cmu = ncu ? (ncu >= 64 ? ~0ull : ((1ull << ncu) - 1ull)) : 0ull, cmw = ncw ? (ncw >= 64 ? ~0ull : ((1ull << ncw) - 1ull)) : 0ull;
    nsa_pass<1, 0>(c, cmu, 0ull, cmw, 0ull, kc, kc, R, qf, lrow, invl, o);
#pragma unroll
    for (int T = 0; T < 2; ++T) { float lt = lrow[T]; lt += __shfl_xor(lt, 16); lt += __shfl_xor(lt, 32); invl[T] = lt > 0.f ? 1.0f / lt : 0.f; }
    nsa_pass<2, 0>(c, cmu, 0ull, cmw, 0ull, kc, vc, R, qf, lrow, invl, o);
#pragma unroll
    for (int T = 0; T < 2; ++T) { const float gt = __builtin_amdgcn_rcpf(1.0f + __expf(-bflo(glp[T])));
        bf16_t* yp = Y + (size_t)(b * SEQ + R.t[T]) * DM + 1024 + 64 * hq + 4 * R.kq;
#pragma unroll
        for (int dt = 0; dt < 4; ++dt) { const f32x4 v = o[T][dt] * gt; u32x2 pk; pk.x = cvt_pk_bf16(v[0], v[1]); pk.y = cvt_pk_bf16(v[2], v[3]); *(u32x2*)(yp + 16 * dt) = pk; o[T][dt] = (f32x4){0.f, 0.f, 0.f, 0.f}; } }
    asm volatile("s_waitcnt lgkmcnt(0)" ::: "memory");
    for (int qi = 0; qi < 2; ++qi) {
        unsigned key[4][2]; bool valid2[4][2];
#pragma unroll
        for (int z = 0; z < 4; ++z) { const int cur = (R.tmin + qi + 2 * z) >> 6;
#pragma unroll
            for (int e = 0; e < 2; ++e) { const int jj = lane + 64 * e; valid2[z][e] = jj <= cur; const bool forced = (jj == 0) || (jj == cur) || (jj == cur - 1);
                const float v = imp[(qi + 2 * z) * 132 + jj] + (forced ? 1000.f : 0.f); key[z][e] = valid2[z][e] ? __float_as_uint(v) + 1u : 0u; } }
        unsigned T[4] = {0u, 0u, 0u, 0u};
        for (int bit = 31; bit >= 0; --bit) {
#pragma unroll
            for (int z = 0; z < 4; ++z) { const unsigned cand = T[z] | (1u << bit);
                const int cnt = __builtin_popcountll(__ballot(key[z][0] >= cand)) + __builtin_popcountll(__ballot(key[z][1] >= cand)); if (cnt >= 16) T[z] = cand; } }
        const u64 below = (1ull << lane) - 1ull;
#pragma unroll
        for (int z = 0; z < 4; ++z) {
            const u64 gt0 = __ballot(key[z][0] > T[z]), gt1 = __ballot(key[z][1] > T[z]), eq0 = __ballot(valid2[z][0] && key[z][0] == T[z]), eq1 = __ballot(valid2[z][1] && key[z][1] == T[z]);
            const int need = 16 - __builtin_popcountll(gt0) - __builtin_popcountll(gt1);
            const int re0 = __builtin_popcountll(eq0 & below), re1 = __builtin_popcountll(eq0) + __builtin_popcountll(eq1 & below);
            const u64 lo = __ballot(valid2[z][0] && (key[z][0] > T[z] || (key[z][0] == T[z] && re0 < need))), hi = __ballot(valid2[z][1] && (key[z][1] > T[z] || (key[z][1] == T[z] && re1 < need)));
            if (lane == 0) { selm[(8 * w + qi + 2 * z) * 2] = lo; selm[(8 * w + qi + 2 * z) * 2 + 1] = hi; } }
    }
    __syncthreads();
    u64 ulo = 0ull, uhi = 0ull, wlo = 0ull, whi = 0ull;
#pragma unroll 8
    for (int q = 0; q < 64; ++q) { const u64 a = selm[2 * q], bb = selm[2 * q + 1]; ulo |= a; uhi |= bb; if ((q >> 3) == w) { wlo |= a; whi |= bb; } }
#pragma unroll
    for (int T = 0; T < 2; ++T) { R.selLo[T] = selm[(8 * w + 4 * T + R.ql) * 2]; R.selHi[T] = selm[(8 * w + 4 * T + R.ql) * 2 + 1]; lrow[T] = 0.f; }
    nsa_pass<0, 1>(c, ulo, uhi, wlo, whi, KV + (size_t)((2 * 2 + b) * 2 + g) * 8192 * 64, KV + (size_t)((3 * 2 + b) * 2 + g) * 8192 * 64, R, qf, lrow, invl, o);
#pragma unroll
    for (int T = 0; T < 2; ++T) { const float lt = lrow[T]; lrow[T] = 0.f;
        const float gt = __builtin_amdgcn_rcpf(1.0f + __expf(-bfhi(glp[T]))); const float sc = lt > 0.f ? gt / lt : 0.f;
        bf16_t* yp = Y + (size_t)(b * SEQ + R.t[T]) * DM + 1024 + 64 * hq + 4 * R.kq;
#pragma unroll
        for (int dt = 0; dt < 4; ++dt) { const f32x4 v = o[T][dt] * sc; const u32x2 y0 = *(const u32x2*)(yp + 16 * dt); u32x2 pk; pk.x = cvt_pk_bf16(bflo(y0.x) + v[0], bfhi(y0.x) + v[1]); pk.y = cvt_pk_bf16(bflo(y0.y) + v[2], bfhi(y0.y) + v[3]);
            *(u32x2*)(yp + 16 * dt) = pk; o[T][dt] = (f32x4){0.f, 0.f, 0.f, 0.f}; } }
    {
        const int jhi = tumax >> 6, jlo = (q0 - 511) > 0 ? ((q0 - 511) >> 6) : 0;
        const int wjhi = R.tmax >> 6, wjlo = (R.tmin - 511) > 0 ? ((R.tmin - 511) >> 6) : 0;
        u64 alo = 0ull, ahi = 0ull, blo = 0ull, bhi = 0ull;
        for (int jj = jlo; jj <= jhi; ++jj) { if (jj < 64) alo |= 1ull << jj; else ahi |= 1ull << (jj - 64); }
        for (int jj = wjlo; jj <= wjhi; ++jj) { if (jj < 64) blo |= 1ull << jj; else bhi |= 1ull << (jj - 64); }
        nsa_pass<0, 2>(c, alo, ahi, blo, bhi, KV + (size_t)((4 * 2 + b) * 2 + g) * 8192 * 64, KV + (size_t)((5 * 2 + b) * 2 + g) * 8192 * 64, R, qf, lrow, invl, o);
#pragma unroll
        for (int T = 0; T < 2; ++T) { const float lt = lrow[T];
            const float gt = __builtin_amdgcn_rcpf(1.0f + __expf(-bflo(glq[T]))); const float sc = lt > 0.f ? gt / lt : 0.f;
            bf16_t* yp = Y + (size_t)(b * SEQ + R.t[T]) * DM + 1024 + 64 * hq + 4 * R.kq;
#pragma unroll
            for (int dt = 0; dt < 4; ++dt) { const f32x4 v = o[T][dt] * sc; const u32x2 y0 = *(const u32x2*)(yp + 16 * dt); u32x2 pk; pk.x = cvt_pk_bf16(bflo(y0.x) + v[0], bfhi(y0.x) + v[1]); pk.y = cvt_pk_bf16(bflo(y0.y) + v[2], bfhi(y0.y) + v[3]);
                *(u32x2*)(yp + 16 * dt) = pk; } }
    }
}

#ifndef PH5_MASK
#define PH5_MASK 31
#endif
#ifndef WGM_IN
#define WGM_IN 4
#endif
#ifndef WGM_GU
#define WGM_GU 4
#endif
#ifndef WGM_N8
#define WGM_N8 2
#endif
#ifndef DUP5A
#define DUP5A 0
#endif
#ifndef DUP5C
#define DUP5C 0
#endif
#ifndef DUP7A
#define DUP7A 0
#endif
#ifndef DUP7B
#define DUP7B 0
#endif
#ifndef DUP_MASK
#define DUP_MASK 0
#endif
#ifndef PH_MASK
#define PH_MASK 0x1fff
#endif
constexpr int NPH = 13;
struct Params { const float* in[31]; float* out; unsigned char* ws; int l_lo, l_hi, p_lo, p_hi; };
enum { I_X = 0, I_F1PRE, I_F1GU, I_F1D, I_F1POST, I_MPRE, I_WIN, I_SCW, I_SCB, I_SDTB, I_SALOG, I_SD, I_SNW, I_KPE, I_KW1, I_KB1, I_KW2, I_VPE, I_VW1, I_VB1, I_VW2,
       I_CW, I_CB, I_CLW, I_CLB, I_WOUT, I_MPOST, I_F2PRE, I_F2GU, I_F2D, I_F2POST };

template <int l>
__device__ __forceinline__ void run_layer(const Ctx& c, const Params& P, const XcdBarrier& bar, unsigned char* ws) {
    bf16_t* U = (bf16_t*)(ws + WS_U); bf16_t* T = (bf16_t*)(ws + WS_T); bf16_t* HID = (bf16_t*)(ws + WS_HID); bf16_t* PROJ = (bf16_t*)(ws + WS_PROJ); bf16_t* Y = (bf16_t*)(ws + WS_Y);
    float* RS = (float*)(ws + WS_RS);
    {
        const int plo = (l == P.l_lo) ? P.p_lo : 0, phi = (l == P.l_hi - 1) ? P.p_hi : NPH;
#define IN(k) (((PH_MASK >> (k)) & 1) && plo <= (k) && (k) < phi)
#define REPS(k) ((((DUP_MASK) >> (k)) & 1) ? 2 : 1)
#define SEAM(k) do { if (!(l == P.l_hi - 1 && (k) == P.p_hi - 1)) xcd_barrier(bar); } while (0)
        if (IN(0) && l == 0) _Pragma("unroll") for (int rep = 0; rep < REPS(0); ++rep) {
            LayerW LW; LW.gu1 = P.in[I_F1GU] + (size_t)l * DM * 2 * DFF; LW.d1 = P.in[I_F1D] + (size_t)l * DFF * DM; LW.gu2 = P.in[I_F2GU] + (size_t)l * DM * 2 * DFF; LW.d2 = P.in[I_F2D] + (size_t)l * DFF * DM;
            LW.win = P.in[I_WIN] + (size_t)l * DM * DIN; LW.wout = P.in[I_WOUT] + (size_t)l * DM * DM; LW.w1k = P.in[I_KW1] + (size_t)l * 2048 * 256; LW.w1v = P.in[I_VW1] + (size_t)l * 2048 * 256;
            LW.kpe = P.in[I_KPE] + (size_t)l * 2048; LW.vpe = P.in[I_VPE] + (size_t)l * 2048; LW.pre1 = P.in[I_F1PRE] + l * DM; LW.prem = P.in[I_MPRE] + l * DM; LW.pre2 = P.in[I_F2PRE] + l * DM;
            phase_convert(c, LW, ws);
            if (l == 0) {
                phase_norm(c, P.in[I_X], nullptr, 0.f, nullptr, U, RS, nullptr);
                for (int i = c.bid * NTHR + c.tid; i < 65536; i += c.G * NTHR) ((u32x4*)(ws + WS_KV + 6 * 4 * 8192 * 64 * 2))[i] = (u32x4){0u, 0u, 0u, 0u};
            }
            SEAM(0);
        }
        if (IN(1)) _Pragma("unroll") for (int rep = 0; rep < REPS(1); ++rep) {
            pg8::Gemm g{U, (const bf16_t*)(ws + WS_WGU1), M, 2 * DFF, DM, DM, 128, 0}; pg8::StaticOrder S; S.init(M, 2 * DFF, c.G, c.bid, WGM_GU);
            pg8::EpiSwiglu E{HID, DFF, RS};
            pg8::gemm_phase<pg8::EpiSwiglu, pg8::StaticOrder, false, true>(c.lds, g, S, E);
            SEAM(1);
        }
        if (IN(2)) _Pragma("unroll") for (int rep = 0; rep < REPS(2); ++rep) {
            pg8::Gemm g{HID, (const bf16_t*)(ws + WS_WD1), M, DM, DFF, DFF, 128, 0}; pg8::StaticOrder S; S.init(M, DM, c.G, c.bid, WGM_N8);
            pg8::EpiStore E{T, DM};
            pg8::gemm_phase<pg8::EpiStore, pg8::StaticOrder, true, true>(c.lds, g, S, E);
            SEAM(2);
        }
        if (IN(3)) { phase_norm(c, nullptr, T, 0.5f, P.in[I_F1POST] + l * DM, U, RS, nullptr); SEAM(3); }
        if (IN(4)) _Pragma("unroll") for (int rep = 0; rep < REPS(4); ++rep) {
            pg8::Gemm g{U, (const bf16_t*)(ws + WS_WIN), M, NPROJ, DM, DM, 128, 0}; pg8::StaticOrder S; S.init(M, NPROJ, c.G, c.bid, WGM_IN);
            pg8::EpiProj E{PROJ, NPROJ, (bf16_t*)(ws + WS_KV), RS};
            pg8::gemm_phase<pg8::EpiProj, pg8::StaticOrder, true, true>(c.lds, g, S, E);
            SEAM(4);
        }
        SsdW SW; SW.conv_w = P.in[I_SCW] + (size_t)l * 4 * 1536; SW.conv_b = P.in[I_SCB] + l * 1536; SW.dt_bias = P.in[I_SDTB] + l * 16; SW.a_log = P.in[I_SALOG] + l * 16; SW.dskip = P.in[I_SD] + l * 16; SW.norm_w = P.in[I_SNW] + l * 1024;
        if (IN(5)) _Pragma("unroll") for (int rep = 0; rep < REPS(5); ++rep) {
            if (PH5_MASK & 1) for (int u = c.bid; u < 256 * (1 + DUP5A); u += c.G) ssd_a_unit(c, SW, ws, u & 255);
            if ((PH5_MASK & 2) && c.bid < 16) { const int cu = c.bid;
                const int kv = cu >> 3, pm = cu & 7;
                __syncthreads();
                pg8::Gemm g{(const bf16_t*)(ws + WS_KV) + (size_t)kv * 4 * 8192 * 64, (const bf16_t*)(ws + WS_W1) + (size_t)kv * 256 * DM, 2048, 256, 2048, 1024, 128, 0};
                pg8::OneUnit S; S.u0.pm = pm; S.u0.pn = 0;
                bf16_t* H1 = (bf16_t*)(ws + WS_H1) + (size_t)kv * 2048 * 256;
                LAS float* biasS = (LAS float*)(c.lds + 131072);
                if (c.tid < 256) { const float* b1 = (kv ? P.in[I_VB1] : P.in[I_KB1]) + l * 256; const float* pep = (const float*)(ws + WS_PEP) + kv * 256 * 256;
                    float sb = b1[c.tid];
#pragma unroll 8
                    for (int q = 0; q < 256; ++q) sb += pep[q * 256 + c.tid];
                    biasS[c.tid] = sb; }
                __syncthreads();
                pg8::EpiBiasSilu E{H1, 256, biasS};
                pg8::gemm_phase<pg8::EpiBiasSilu, pg8::OneUnit, false, true>(c.lds, g, S, E);
                nsa_cmp2(c, (kv ? P.in[I_VW2] : P.in[I_KW2]) + (size_t)l * 256 * 64, H1, (bf16_t*)(ws + WS_KC) + (size_t)kv * 2048 * 64, pm);
            }
            CnvW CW; CW.dw_w = P.in[I_CW] + (size_t)l * 31 * 512; CW.dw_b = P.in[I_CB] + l * 512; CW.ln_w = P.in[I_CLW] + l * 512; CW.ln_b = P.in[I_CLB] + l * 512;
            if (PH5_MASK & 4) { if (c.G > 32) { if (c.bid >= 16) for (int u = c.bid - 16; u < 512 * (1 + DUP5C); u += c.G - 16) cnv_unit(c, CW, ws, u & 511); }
            else for (int u = c.bid; u < 512; u += c.G) cnv_unit(c, CW, ws, u); }
            SEAM(5);
        }
        if (IN(6)) _Pragma("unroll") for (int rep = 0; rep < REPS(6); ++rep) { phase_ssd_scan(c, ws); SEAM(6); }
        if (IN(7)) _Pragma("unroll") for (int rep = 0; rep < REPS(7); ++rep) {
            if (PH5_MASK & 8) for (int u = c.bid; u < 256 * (1 + DUP7A); u += c.G) ssd_b_unit(c, SW, ws, u & 255);
            if (PH5_MASK & 16) for (int v0 = c.bid; v0 < 256 * (1 + DUP7B); v0 += c.G) { const int v = v0 & 255;
                const int bg = v & 3, jq = v >> 2;
                for (int e = 0; e < 2; ++e) { const int qb = (e == 0) ? 127 - jq : jq; nsa_unit(c, ws, bg >> 1, bg & 1, qb); }
            }
            SEAM(7);
        }
        if (IN(8)) _Pragma("unroll") for (int rep = 0; rep < REPS(8); ++rep) {
            pg8::Gemm g{Y, (const bf16_t*)(ws + WS_WOUT), M, DM, DM, DM, 128, 0}; pg8::StaticOrder S; S.init(M, DM, c.G, c.bid, WGM_N8);
            pg8::EpiStore E{T, DM};
            pg8::gemm_phase<pg8::EpiStore, pg8::StaticOrder, true, true>(c.lds, g, S, E);
            SEAM(8);
        }
        if (IN(9)) { phase_norm(c, nullptr, T, 1.0f, P.in[I_MPOST] + l * DM, U, RS, nullptr); SEAM(9); }
        if (IN(10)) _Pragma("unroll") for (int rep = 0; rep < REPS(10); ++rep) {
            pg8::Gemm g{U, (const bf16_t*)(ws + WS_WGU2), M, 2 * DFF, DM, DM, 128, 0}; pg8::StaticOrder S; S.init(M, 2 * DFF, c.G, c.bid, WGM_GU);
            pg8::EpiSwiglu E{HID, DFF, RS};
            pg8::gemm_phase<pg8::EpiSwiglu, pg8::StaticOrder, false, true>(c.lds, g, S, E);
            SEAM(10);
        }
        if (IN(11)) _Pragma("unroll") for (int rep = 0; rep < REPS(11); ++rep) {
            pg8::Gemm g{HID, (const bf16_t*)(ws + WS_WD2), M, DM, DFF, DFF, 128, 0}; pg8::StaticOrder S; S.init(M, DM, c.G, c.bid, WGM_N8);
            pg8::EpiStore E{T, DM};
            pg8::gemm_phase<pg8::EpiStore, pg8::StaticOrder, true, true>(c.lds, g, S, E);
            SEAM(11);
        }
        if (IN(12)) {
            phase_norm(c, nullptr, T, 0.5f, P.in[I_F2POST] + l * DM, U, RS, (l + 1 < DEPTH) ? nullptr : P.out);
            if (l + 1 < DEPTH) {
                const int n = l + 1;
                LayerW LW; LW.gu1 = P.in[I_F1GU] + (size_t)n * DM * 2 * DFF; LW.d1 = P.in[I_F1D] + (size_t)n * DFF * DM; LW.gu2 = P.in[I_F2GU] + (size_t)n * DM * 2 * DFF; LW.d2 = P.in[I_F2D] + (size_t)n * DFF * DM;
                LW.win = P.in[I_WIN] + (size_t)n * DM * DIN; LW.wout = P.in[I_WOUT] + (size_t)n * DM * DM; LW.w1k = P.in[I_KW1] + (size_t)n * 2048 * 256; LW.w1v = P.in[I_VW1] + (size_t)n * 2048 * 256;
                LW.kpe = P.in[I_KPE] + (size_t)n * 2048; LW.vpe = P.in[I_VPE] + (size_t)n * 2048; LW.pre1 = P.in[I_F1PRE] + n * DM; LW.prem = P.in[I_MPRE] + n * DM; LW.pre2 = P.in[I_F2PRE] + n * DM;
                phase_convert(c, LW, ws);
            }
            SEAM(12);
        }
#undef IN
#undef SEAM
    }
}

__global__ void __launch_bounds__(NTHR, 2) mega_fwd(Params P) {
    extern __shared__ __attribute__((aligned(16))) unsigned char lds_raw[];
    Ctx c; c.lds = (LAS unsigned char*)lds_raw; c.tid = threadIdx.x; c.lane = c.tid & 63; c.wave = __builtin_amdgcn_readfirstlane(c.tid >> 6); c.G = gridDim.x; c.bid = blockIdx.x;
    unsigned char* ws = P.ws;
    volatile LAS unsigned* MISC = (volatile LAS unsigned*)(c.lds + LDS_CTL_OFF);
    if (c.tid < 32) MISC[c.tid] = 0u;
    __syncthreads();
    const bool multi = !((P.l_hi - P.l_lo) == 1 && (P.p_hi - P.p_lo) == 1);
    XcdBarrier bar; bar.bar = (unsigned*)(ws + WS_CTL) + 4096; bar.x = 0; bar.st = MISC + 8;
    if (multi) bar = xcd_barrier_post((unsigned*)(ws + WS_CTL) + 4096, MISC + 8);

    if (0 >= P.l_lo && 0 < P.l_hi) run_layer<0>(c, P, bar, ws);
    if (1 >= P.l_lo && 1 < P.l_hi) run_layer<1>(c, P, bar, ws);
    if (2 >= P.l_lo && 2 < P.l_hi) run_layer<2>(c, P, bar, ws);
    if (3 >= P.l_lo && 3 < P.l_hi) run_layer<3>(c, P, bar, ws);
}

extern "C" void kernel_launch(void* const* d_in, const int* in_sizes, int n_in, void* d_out, int out_size, void* d_ws, size_t ws_size, hipStream_t stream) {
    static int grid = 0;
    if (grid == 0) {
        if (n_in != 31 || in_sizes[0] != M * DM || out_size != M * DM || ws_size < WS_END) { fprintf(stderr, "kernel_launch: unexpected shapes (n_in %d, in0 %d, out %d, ws %zu); nothing launched\n", n_in, n_in > 0 ? in_sizes[0] : -1, out_size, ws_size); grid = -1; return; }
        int dev = 0, cus = 0, per_cu = 0;
        if (hipGetDevice(&dev) != hipSuccess || hipDeviceGetAttribute(&cus, hipDeviceAttributeMultiprocessorCount, dev) != hipSuccess) { grid = -1; return; }
        if (hipFuncSetAttribute((const void*)mega_fwd, hipFuncAttributeMaxDynamicSharedMemorySize, LDS_BYTES) != hipSuccess) { fprintf(stderr, "kernel_launch: hipFuncSetAttribute failed\n"); grid = -1; return; }
        if (hipOccupancyMaxActiveBlocksPerMultiprocessor(&per_cu, (const void*)mega_fwd, NTHR, LDS_BYTES) != hipSuccess || per_cu < 1) { fprintf(stderr, "kernel_launch: occupancy query says %d\n", per_cu); per_cu = 1; }
        (void)hipGetLastError();
        grid = cus;
    }
    if (grid < 0) return;
    if (hipMemsetAsync((char*)d_ws + WS_CTL, 0, CTL_ZERO_BYTES, stream) != hipSuccess) return;
    Params p{};
    for (int i = 0; i < 31; ++i) p.in[i] = (const float*)d_in[i];
    p.out = (float*)d_out; p.ws = (unsigned char*)d_ws;
#if MK_PER_PHASE
    for (int l = 0; l < DEPTH; ++l)
        for (int k = 0; k < NPH; ++k) { p.l_lo = l; p.l_hi = l + 1; p.p_lo = k; p.p_hi = k + 1; hipLaunchKernelGGL(mega_fwd, dim3(grid), dim3(NTHR), LDS_BYTES, stream, p); }
#else
    p.l_lo = 0; p.l_hi = DEPTH; p.p_lo = 0; p.p_hi = NPH;
    hipLaunchKernelGGL(mega_fwd, dim3(grid), dim3(NTHR), LDS_BYTES, stream, p);
#endif
}
```

```cpp
#include <hip/hip_runtime.h>
#include <cstdio>
#include <cstdint>
#include <cmath>

#ifndef MK_PER_PHASE
#define MK_PER_PHASE 0
#endif

#define LAS __attribute__((address_space(3)))
#define GAS __attribute__((address_space(1)))

namespace pg8 {
#define PG8_LAS __attribute__((address_space(3)))
typedef unsigned short bf16_t;
typedef short bf16x8 __attribute__((ext_vector_type(8)));
typedef float f32x4 __attribute__((ext_vector_type(4)));
typedef unsigned u32x4 __attribute__((ext_vector_type(4)));
constexpr int BM = 256, BK = 64, HALF = 128, HTB = HALF * BK * 2  , STAGE_BYTES = 8 * HTB, NXCD = 8, WGM = 4;

__host__ __device__ __forceinline__ int lds_byte(int r, int c) { const int st = (r >> 4) * 2 + (c >> 5), rr = r & 15, cc = c & 31, ob = rr * 64 + cc * 2; return st * 1024 + (ob ^ (((ob >> 9) & 1) << 5)); }
__host__ __device__ __forceinline__ void stage_rc(int b, int& R, int& C) { const int st = b / 1024, sb = b % 1024, swz = sb ^ (((sb >> 9) & 1) << 5); R = (st >> 1) * 16 + swz / 64; C = (st & 1) * 32 + (swz % 64) / 2; }
__host__ __device__ __forceinline__ int perm32(int rho) { const int n = rho >> 4, i = rho & 15; return 8 * (i >> 2) + 4 * n + (i & 3); }

struct Unit { int pm, pn; };

struct StaticOrder {
    int nM, nN, nwg, G, c, wgm;
    __host__ __device__ void init(int M, int N, int G_, int c_, int wgm_ = WGM) { nM = M / BM; nN = N / BM; nwg = nM * nN; G = G_; c = c_; wgm = wgm_; }
    __host__ __device__ bool next(int i, Unit& u) const {
        const long L = (long)i * G + c; if (L >= nwg) return false;
        int wgid = (int)L; { const int q = nwg / NXCD, r = nwg % NXCD, xcd = wgid % NXCD, off = wgid / NXCD; wgid = (xcd < r ? xcd * (q + 1) : r * (q + 1) + (xcd - r) * q) + off; }
        const int nig = wgm * nN, gid = wgid / nig, fm = gid * wgm, gsz = (nM - fm) < wgm ? (nM - fm) : wgm;
        u.pm = fm + ((wgid % nig) % gsz); u.pn = (wgid % nig) / gsz; return true;
    }
    __device__ __forceinline__ void a_ready(const Unit&) const {}
    __device__ __forceinline__ void done(const Unit&) const {}
};


struct Gemm { const bf16_t* A; const bf16_t* Bt; int M, N, K; int lda; int kstepA; int amode;
    __device__ __forceinline__ size_t abase(int pm) const {
        if (amode == 0) return (size_t)pm * BM * (size_t)lda * 2;
        return ((size_t)((pm >> 2) * 8192 + (pm & 1) * 4096) * 5120 + (size_t)((pm >> 1) & 1) * 64) * 2;
    }
};
struct OneUnit {
    Unit u0;
    __device__ __forceinline__ bool next(int i, Unit& u) const { if (i != 0) return false; u = u0; return true; }
    __device__ __forceinline__ void a_ready(const Unit&) const {}
    __device__ __forceinline__ void done(const Unit&) const {}
};

typedef float f32x2_t __attribute__((ext_vector_type(2))); typedef __bf16 bf16x2_t __attribute__((ext_vector_type(2)));
__device__ __forceinline__ unsigned cvt_pk_bf16(float lo, float hi) { const f32x2_t v = {lo, hi}; const bf16x2_t b = __builtin_convertvector(v, bf16x2_t); return __builtin_bit_cast(unsigned, b); }
__device__ __forceinline__ float silu_f(float x) { return x * __builtin_amdgcn_rcpf(1.0f + __expf(-x)); }

struct EpiStore {
    static constexpr bool PERM = true, AFTER_DRAIN = false, ROWSCALE = false;
    bf16_t* O; int ldc;
    __device__ __forceinline__ void operator()(const f32x4 (&acc)[2][2][4][2], const Unit& u, int wr, int wc, int fr, int fq, const PG8_LAS float* rsl) const {
        const int row0 = u.pm * BM + wr * 64 + fr, col0 = u.pn * BM + wc * 32 + 8 * fq;
#pragma unroll
        for (int ai = 0; ai < 2; ++ai)
#pragma unroll
            for (int m = 0; m < 4; ++m) { bf16_t* rowp = O + (size_t)(row0 + ai * HALF + m * 16) * ldc + col0;
#pragma unroll
                for (int bj = 0; bj < 2; ++bj) { const f32x4 v0 = acc[ai][bj][m][0], v1 = acc[ai][bj][m][1];
                    u32x4 w; w.x = cvt_pk_bf16(v0[0], v0[1]); w.y = cvt_pk_bf16(v0[2], v0[3]); w.z = cvt_pk_bf16(v1[0], v1[1]); w.w = cvt_pk_bf16(v1[2], v1[3]);
                    *(u32x4*)(rowp + bj * HALF) = w; } }
    }
};
struct EpiProj {
    static constexpr bool PERM = true, AFTER_DRAIN = false, ROWSCALE = true;
    bf16_t* O; int ldc; bf16_t* KV; const float* rs;
    __device__ __forceinline__ void operator()(const f32x4 (&acc)[2][2][4][2], const Unit& u, int wr, int wc, int fr, int fq, const PG8_LAS float* rsl) const {
        const bool kvt = (u.pn >= 16 && u.pn <= 18);
        const int pitch = kvt ? 64 : ldc;
        const int rloc = (kvt ? ((u.pm * BM) & 8191) : u.pm * BM) + wr * 64 + fr;
        bf16_t* base[2];
#pragma unroll
        for (int bj = 0; bj < 2; ++bj)
            base[bj] = kvt ? KV + (size_t)((((u.pn - 16) * 2 + bj) * 2 + ((u.pm * BM) >> 13)) * 2 + (wc >> 1)) * 8192 * 64 + (wc & 1) * 32 + 8 * fq
                           : O + u.pn * BM + bj * HALF + wc * 32 + 8 * fq;
#pragma unroll
        for (int ai = 0; ai < 2; ++ai)
#pragma unroll
            for (int m = 0; m < 4; ++m) { const size_t roff = (size_t)(rloc + ai * HALF + m * 16) * pitch; const float r = rsl[wr * 64 + fr + ai * HALF + m * 16];
#pragma unroll
                for (int bj = 0; bj < 2; ++bj) { const f32x4 v0 = acc[ai][bj][m][0] * r, v1 = acc[ai][bj][m][1] * r;
                    u32x4 w; w.x = cvt_pk_bf16(v0[0], v0[1]); w.y = cvt_pk_bf16(v0[2], v0[3]); w.z = cvt_pk_bf16(v1[0], v1[1]); w.w = cvt_pk_bf16(v1[2], v1[3]);
                    *(u32x4*)(base[bj] + roff) = w; } }
    }
};
struct EpiSwiglu {
    static constexpr bool PERM = true, AFTER_DRAIN = false, ROWSCALE = true;
    bf16_t* O; int ldc; const float* rs;
    __device__ __forceinline__ void operator()(const f32x4 (&acc)[2][2][4][2], const Unit& u, int wr, int wc, int fr, int fq, const PG8_LAS float* rsl) const {
        const int row0 = u.pm * BM + wr * 64 + fr, col0 = u.pn * HALF + wc * 32 + 8 * fq;
#pragma unroll
        for (int ai = 0; ai < 2; ++ai)
#pragma unroll
            for (int m = 0; m < 4; ++m) { bf16_t* rowp = O + (size_t)(row0 + ai * HALF + m * 16) * ldc + col0; const float r = rsl[wr * 64 + fr + ai * HALF + m * 16];
                const f32x4 g0 = acc[ai][0][m][0] * r, g1 = acc[ai][0][m][1] * r, v0 = acc[ai][1][m][0] * r, v1 = acc[ai][1][m][1] * r;
                u32x4 w;
                w.x = cvt_pk_bf16(silu_f(g0[0]) * v0[0], silu_f(g0[1]) * v0[1]); w.y = cvt_pk_bf16(silu_f(g0[2]) * v0[2], silu_f(g0[3]) * v0[3]);
                w.z = cvt_pk_bf16(silu_f(g1[0]) * v1[0], silu_f(g1[1]) * v1[1]); w.w = cvt_pk_bf16(silu_f(g1[2]) * v1[2], silu_f(g1[3]) * v1[3]);
                *(u32x4*)rowp = w; }
    }
};
struct EpiBiasSilu {
    static constexpr bool PERM = true, AFTER_DRAIN = false, ROWSCALE = false;
    bf16_t* O; int ldc; const PG8_LAS float* bias;
    __device__ __forceinline__ void operator()(const f32x4 (&acc)[2][2][4][2], const Unit& u, int wr, int wc, int fr, int fq, const PG8_LAS float* rsl) const {
        const int row0 = u.pm * BM + wr * 64 + fr, col0 = u.pn * BM + wc * 32 + 8 * fq;
#pragma unroll
        for (int bj = 0; bj < 2; ++bj) {
            const f32x4 b0 = *(const PG8_LAS f32x4*)(bias + col0 + bj * HALF), b1 = *(const PG8_LAS f32x4*)(bias + col0 + bj * HALF + 4);
#pragma unroll
            for (int ai = 0; ai < 2; ++ai)
#pragma unroll
                for (int m = 0; m < 4; ++m) { bf16_t* rowp = O + (size_t)(row0 + ai * HALF + m * 16) * ldc + col0 + bj * HALF;
                    const f32x4 v0 = acc[ai][bj][m][0] + b0, v1 = acc[ai][bj][m][1] + b1;
                    u32x4 w; w.x = cvt_pk_bf16(silu_f(v0[0]), silu_f(v0[1])); w.y = cvt_pk_bf16(silu_f(v0[2]), silu_f(v0[3]));
                    w.z = cvt_pk_bf16(silu_f(v1[0]), silu_f(v1[1])); w.w = cvt_pk_bf16(silu_f(v1[2]), silu_f(v1[3]));
                    *(u32x4*)rowp = w; }
        }
    }
};

template <class Epi, class Sched, bool ALIGN_EPI = false, bool SP2 = false>
__device__ __forceinline__ void gemm_phase(PG8_LAS unsigned char* lds, const Gemm g, const Sched& S, const Epi& E) {
    const int tid = threadIdx.x, wid = __builtin_amdgcn_readfirstlane(tid >> 6), lane = tid & 63, wr = wid >> 2, wc = wid & 3, fr = lane & 15, fq = lane >> 4;
    const int K = g.K, nt = K / BK;
    unsigned voffA[2], voffB[2];
#pragma unroll
    for (int i = 0; i < 2; ++i) { int R, C; stage_rc(tid * 16 + i * 8192, R, C); const int Rb = Epi::PERM ? ((R & ~31) + perm32(R & 31)) : R;
        voffA[i] = (unsigned)(R * g.lda + C) * 2u; voffB[i] = (unsigned)(Rb * K + C) * 2u; }
    const size_t kstepB = (size_t)(BK * 2), kstepA = (size_t)g.kstepA;
    const size_t hstepB = (size_t)HALF * K * 2, hstepA = (size_t)HALF * g.lda * 2;
    const size_t tstepB = 2 * hstepB;
    const unsigned ldsw = (unsigned)wid * 1024u;
    const int aoff = lds_byte(wr * 64 + fr, fq * 8), boff = lds_byte(wc * 32 + fr, fq * 8);
#define PG8_SA(b, h) (((b) * 2 + (h)) * HTB)
#define PG8_RSL (8 * HTB + 1024)
#define PG8_SB(b, h) ((4 + (b) * 2 + (h)) * HTB)
#define PG8_STAGE(bufoff, gbase, voff) do { _Pragma("unroll") for (int _i = 0; _i < 2; ++_i) \
        __builtin_amdgcn_global_load_lds((const unsigned*)((const char*)(gbase) + (voff)[_i]), (PG8_LAS unsigned*)(lds + (bufoff) + ldsw + _i * 8192), 16, 0, 0); } while (0)
#define PG8_LDA(dst, b, h) do { _Pragma("unroll") for (int m = 0; m < 4; ++m) _Pragma("unroll") for (int k = 0; k < 2; ++k) dst[m][k] = *(const PG8_LAS bf16x8*)(lds + PG8_SA(b, h) + aoff + m * 2048 + k * 1024); } while (0)
#define PG8_LDB(dst, b, h) do { _Pragma("unroll") for (int n = 0; n < 2; ++n) _Pragma("unroll") for (int k = 0; k < 2; ++k) dst[n][k] = *(const PG8_LAS bf16x8*)(lds + PG8_SB(b, h) + boff + n * 2048 + k * 1024); } while (0)
#define PG8_MMA(ai, bj, At, Bt) do { __builtin_amdgcn_s_setprio(1); _Pragma("unroll") for (int m = 0; m < 4; ++m) _Pragma("unroll") for (int n = 0; n < 2; ++n) _Pragma("unroll") for (int k = 0; k < 2; ++k) \
        acc[ai][bj][m][n] = __builtin_amdgcn_mfma_f32_16x16x32_bf16(Bt[n][k], At[m][k], acc[ai][bj][m][n], 0, 0, 0); __builtin_amdgcn_s_setprio(0); } while (0)
#define PG8_WAIT_V(n) asm volatile("s_waitcnt vmcnt(" #n ")" ::: "memory")
#define PG8_WAIT_L(n) asm volatile("s_waitcnt lgkmcnt(" #n ")" ::: "memory")
#define PG8_BAR __builtin_amdgcn_s_barrier()
#define PG8_SCHED __builtin_amdgcn_sched_barrier(0)
    Unit cur, nxt; int ui = 0;
    if (!S.next(0, cur)) return;
    f32x4 acc[2][2][4][2];
#pragma unroll
    for (int a = 0; a < 2; ++a)
#pragma unroll
        for (int b = 0; b < 2; ++b)
#pragma unroll
            for (int m = 0; m < 4; ++m)
#pragma unroll
                for (int n = 0; n < 2; ++n) acc[a][b][m][n] = (f32x4){0.f, 0.f, 0.f, 0.f};
    bf16x8 At[4][2], B0[2][2], B1[2][2];
    const char* cA = (const char*)g.A + g.abase(cur.pm); const char* cB = (const char*)g.Bt + (size_t)cur.pn * tstepB;
    S.a_ready(cur);
    if constexpr (SP2) {
        PG8_STAGE(PG8_SB(0, 0), cB, voffB); PG8_STAGE(PG8_SB(0, 1), cB + hstepB, voffB); PG8_STAGE(PG8_SA(0, 0), cA, voffA); PG8_STAGE(PG8_SA(0, 1), cA + hstepA, voffA);
        if (wr == 1) PG8_BAR;
        PG8_WAIT_V(2); PG8_BAR;
        PG8_STAGE(PG8_SB(1, 0), cB + kstepB, voffB); PG8_STAGE(PG8_SA(1, 0), cA + kstepA, voffA); PG8_STAGE(PG8_SB(1, 1), cB + hstepB + kstepB, voffB);
        PG8_WAIT_V(6); PG8_BAR;
    } else {
        PG8_STAGE(PG8_SB(0, 0), cB, voffB); PG8_STAGE(PG8_SA(0, 0), cA, voffA); PG8_STAGE(PG8_SB(0, 1), cB + hstepB, voffB); PG8_STAGE(PG8_SA(0, 1), cA + hstepA, voffA);
        if (wr == 1) PG8_BAR;
        PG8_WAIT_V(4); PG8_BAR;
        PG8_STAGE(PG8_SB(1, 0), cB + kstepB, voffB); PG8_STAGE(PG8_SA(1, 0), cA + kstepA, voffA); PG8_STAGE(PG8_SB(1, 1), cB + hstepB + kstepB, voffB);
        PG8_WAIT_V(6); PG8_BAR;
    }
    for (;;) {
        const bool has_next = S.next(ui + 1, nxt);
        const char* nA = has_next ? (const char*)g.A + g.abase(nxt.pm) : cA + (size_t)(nt - 2) * kstepA; const char* nB = has_next ? (const char*)g.Bt + (size_t)nxt.pn * tstepB : cB + (size_t)(nt - 2) * kstepB;
        if constexpr (Epi::ROWSCALE) { if (wid < 4) __builtin_amdgcn_global_load_lds((const unsigned*)(E.rs + cur.pm * BM + wid * 64 + lane), (PG8_LAS unsigned*)(lds + PG8_RSL + (ui & 1) * 1024 + wid * 256), 4, 0, 0); }
        for (int t = 0; t < nt; t += 2) {
            const bool last = (t == nt - 2);
            const char* a1 = cA + (size_t)(t + 1) * kstepA;
            const char* a2 = last ? nA : cA + (size_t)(t + 2) * kstepA; const char* b2 = last ? nB : cB + (size_t)(t + 2) * kstepB;
            const char* a3 = a2 + kstepA; const char* b3 = b2 + kstepB;
            if (last && has_next) S.a_ready(nxt);
            if constexpr (SP2) {
            PG8_LDB(B0, 0, 0); PG8_LDB(B1, 0, 1); PG8_SCHED; PG8_LDA(At, 0, 0); PG8_STAGE(PG8_SA(1, 1), a1 + hstepA, voffA);
            PG8_WAIT_V(8); PG8_WAIT_L(0); PG8_BAR; PG8_MMA(0, 0, At, B0); PG8_MMA(0, 1, At, B1); PG8_BAR; PG8_SCHED;
            PG8_LDA(At, 0, 1); PG8_STAGE(PG8_SB(0, 0), b2, voffB); PG8_STAGE(PG8_SB(0, 1), b2 + hstepB, voffB); PG8_STAGE(PG8_SA(0, 0), a2, voffA);
            PG8_WAIT_V(8); PG8_WAIT_L(0); PG8_BAR; PG8_MMA(1, 0, At, B0); PG8_MMA(1, 1, At, B1); PG8_BAR; PG8_SCHED;
            PG8_LDB(B0, 1, 0); PG8_LDB(B1, 1, 1); PG8_SCHED; PG8_LDA(At, 1, 0); PG8_STAGE(PG8_SA(0, 1), a2 + hstepA, voffA);
            PG8_WAIT_V(8); PG8_WAIT_L(0); PG8_BAR; PG8_MMA(0, 0, At, B0); PG8_MMA(0, 1, At, B1); PG8_BAR; PG8_SCHED;
            PG8_LDA(At, 1, 1); PG8_STAGE(PG8_SB(1, 0), b3, voffB); PG8_STAGE(PG8_SB(1, 1), b3 + hstepB, voffB); PG8_STAGE(PG8_SA(1, 0), a3, voffA);
            PG8_WAIT_V(8); PG8_WAIT_L(0); PG8_BAR; PG8_MMA(1, 0, At, B0); PG8_MMA(1, 1, At, B1); PG8_BAR; PG8_SCHED;
            } else {
            PG8_LDB(B0, 0, 0); PG8_SCHED; PG8_LDA(At, 0, 0); PG8_STAGE(PG8_SA(1, 1), a1 + hstepA, voffA);
            PG8_WAIT_L(8); PG8_BAR; PG8_WAIT_L(0); PG8_MMA(0, 0, At, B0); PG8_BAR; PG8_SCHED;
            PG8_LDB(B1, 0, 1); PG8_STAGE(PG8_SB(0, 0), b2, voffB);
            PG8_BAR; PG8_WAIT_L(0); PG8_MMA(0, 1, At, B1); PG8_BAR;
            PG8_LDA(At, 0, 1); PG8_STAGE(PG8_SA(0, 0), a2, voffA);
            PG8_BAR; PG8_WAIT_L(0); PG8_MMA(1, 0, At, B0); PG8_BAR; PG8_SCHED;
            PG8_STAGE(PG8_SB(0, 1), b2 + hstepB, voffB);
            PG8_WAIT_V(6); PG8_BAR; PG8_MMA(1, 1, At, B1); PG8_BAR;
            PG8_LDB(B0, 1, 0); PG8_SCHED; PG8_LDA(At, 1, 0); PG8_STAGE(PG8_SA(0, 1), a2 + hstepA, voffA);
            PG8_WAIT_L(8); PG8_BAR; PG8_WAIT_L(0); PG8_MMA(0, 0, At, B0); PG8_BAR; PG8_SCHED;
            PG8_LDB(B1, 1, 1); PG8_STAGE(PG8_SB(1, 0), b3, voffB);
            PG8_BAR; PG8_WAIT_L(0); PG8_MMA(0, 1, At, B1); PG8_BAR;
            PG8_LDA(At, 1, 1); PG8_STAGE(PG8_SA(1, 0), a3, voffA);
            PG8_BAR; PG8_WAIT_L(0); PG8_MMA(1, 0, At, B0); PG8_BAR; PG8_SCHED;
            PG8_STAGE(PG8_SB(1, 1), b3 + hstepB, voffB);
            PG8_WAIT_V(6); PG8_BAR; PG8_MMA(1, 1, At, B1); PG8_BAR;
            }
        }
        if constexpr (ALIGN_EPI) { if (wr == 0) PG8_BAR; }
        if constexpr (!Epi::AFTER_DRAIN) { E(acc, cur, wr, wc, fr, fq, (const PG8_LAS float*)(lds + PG8_RSL + (ui & 1) * 1024)); S.done(cur); }
        if constexpr (!Epi::AFTER_DRAIN) {
#pragma unroll
        for (int a = 0; a < 2; ++a)
#pragma unroll
            for (int b = 0; b < 2; ++b)
#pragma unroll
                for (int m = 0; m < 4; ++m)
#pragma unroll
                    for (int n = 0; n < 2; ++n) acc[a][b][m][n] = (f32x4){0.f, 0.f, 0.f, 0.f};
        }
        if (!has_next) break;
        cur = nxt; cA = nA; cB = nB; ++ui;
        if constexpr (ALIGN_EPI) { if (wr == 1) PG8_BAR; }
    }
    PG8_WAIT_V(0);
    if constexpr (!ALIGN_EPI) { if (wr == 0) PG8_BAR; }
    PG8_BAR;
    if constexpr (Epi::AFTER_DRAIN) { E.fused(acc, cur, wr, wc, fr, fq, lds, wid, lane); S.done(cur); }
#undef PG8_SA
#undef PG8_RSL
#undef PG8_SB
#undef PG8_STAGE
#undef PG8_LDA
#undef PG8_LDB
#undef PG8_MMA
#undef PG8_WAIT_V
#undef PG8_WAIT_L
#undef PG8_BAR
#undef PG8_SCHED
}
}


using pg8::bf16_t; using pg8::bf16x8; using pg8::f32x4; using pg8::u32x4; using pg8::cvt_pk_bf16; using pg8::silu_f;
typedef short s16x4 __attribute__((ext_vector_type(4)));
typedef float f32x2 __attribute__((ext_vector_type(2)));
typedef unsigned u32x2 __attribute__((ext_vector_type(2)));

constexpr int DM = 2048, NB = 2, SEQ = 8192, M = NB * SEQ, DEPTH = 4, DFF = 5632, DIN = 4904, NPROJ = 5120;
constexpr int NWAVES = 8, NTHR = 512;
constexpr float EPS = 1e-6f;
constexpr int PC_Z = 0, PC_XBC = 1024, PC_GLU = 2560, PC_Q = 3584, PC_KC = 4096, PC_VC = 4224, PC_KS = 4352, PC_VS = 4480, PC_KW = 4608, PC_VW = 4736, PC_DT = 4864, PC_GL = 4880;
__device__ __forceinline__ int win_src_col(int j) {
    if (j < 2560) return j;
    if (j < 3584) return 3880 + (j - 2560);
    if (j < 4096) return 2576 + (j - 3584);
    if (j < 4864) return 3088 + (j - 4096);
    if (j < 4880) return 2560 + (j - 4864);
    if (j < 4904) return 3856 + (j - 4880);
    return -1;
}
__device__ __forceinline__ int gu_src_col(int R) { const int pn = R >> 8, rr = R & 255; return rr < 128 ? 128 * pn + rr : DFF + 128 * pn + (rr - 128); }

constexpr size_t MiB = 1u << 20;
constexpr size_t WS_CTL = 0, CTL_ZERO_BYTES = 1 * MiB;
constexpr size_t WS_WGU1 = 2 * MiB;
constexpr size_t WS_WGU2 = WS_WGU1 + 44 * MiB;
constexpr size_t WS_WD1 = WS_WGU2 + 44 * MiB;
constexpr size_t WS_WD2 = WS_WD1 + 22 * MiB;
constexpr size_t WS_WIN = WS_WD2 + 22 * MiB;
constexpr size_t WS_WOUT = WS_WIN + 20 * MiB;
constexpr size_t WS_W1 = WS_WOUT + 8 * MiB;
constexpr size_t WS_U = 180 * MiB;
constexpr size_t WS_T = 244 * MiB;
constexpr size_t WS_HID = 308 * MiB;
constexpr size_t WS_PROJ = 486 * MiB;
constexpr size_t WS_Y = 648 * MiB;
constexpr size_t WS_XACT = 712 * MiB;
constexpr size_t WS_STATES = 760 * MiB;
constexpr size_t WS_HP = 824 * MiB;
constexpr size_t WS_DT = 856 * MiB;
constexpr size_t WS_CS = 857 * MiB;
constexpr size_t WS_CDEC = 858 * MiB;
constexpr size_t WS_PEP = WS_CDEC + 64 * 1024;
constexpr size_t WS_KC = 859 * MiB;
constexpr size_t WS_H1 = 860 * MiB;
constexpr size_t WS_RS = 863 * MiB;
constexpr size_t WS_KV = 864 * MiB;
constexpr size_t WS_END = 890 * MiB;
static_assert(WS_W1 + 2 * MiB <= WS_U, "weights fit below U");
static_assert(WS_HID + (size_t)M * DFF * 2 <= WS_PROJ && WS_PROJ + (size_t)(M + 64) * NPROJ * 2 <= WS_Y, "ws map");

constexpr int LDS_WORK = 150 * 1024;
constexpr int LDS_CTL_OFF = LDS_WORK;
constexpr int LDS_BYTES = 152 * 1024;

typedef GAS unsigned gu32;
#define RLX_AGENT __ATOMIC_RELAXED, __HIP_MEMORY_SCOPE_AGENT
#define LDS_WAIT() asm volatile("s_waitcnt lgkmcnt(0)" ::: "memory")
#define VM_WAIT() asm volatile("s_waitcnt vmcnt(0)" ::: "memory")
__device__ __forceinline__ float bf2f(unsigned v) { return __uint_as_float(v << 16); }
__device__ __forceinline__ float bflo(unsigned u) { return __uint_as_float(u << 16); }
__device__ __forceinline__ float bfhi(unsigned u) { return __uint_as_float(u & 0xffff0000u); }
__device__ __forceinline__ float wave_sum(float v) {
#pragma unroll
    for (int o = 1; o < 64; o <<= 1) v += __shfl_xor(v, o);
    return v;
}
struct Ctx { LAS unsigned char* lds; int tid, lane, wave, G, bid; };

__device__ __forceinline__ bf16x8 frag_row(const LAS unsigned char* base, int pitch, int row0, int k0, int lane) {
    return *(const LAS bf16x8*)(base + (row0 + (lane & 15)) * pitch + (k0 + 8 * (lane >> 4)) * 2);
}
__device__ __forceinline__ s16x4 tr16(const LAS unsigned char* p) { return __builtin_bit_cast(s16x4, __builtin_amdgcn_ds_read_tr16_b64_v4i16((LAS s16x4*)p)); }
__device__ __forceinline__ bf16x8 frag_tr(const LAS unsigned char* base, int pitch, int k0, int n0, int lane) {
    const int g = lane >> 4, q = (lane & 15) >> 2, p = lane & 3;
    const LAS unsigned char* a = base + (k0 + 8 * g + q) * pitch + (n0 + 4 * p) * 2;
    const s16x4 lo = tr16(a), hi = tr16(a + 4 * pitch);
    return (bf16x8){lo[0], lo[1], lo[2], lo[3], hi[0], hi[1], hi[2], hi[3]};
}
#define MFMA16(a, b, c) __builtin_amdgcn_mfma_f32_16x16x32_bf16((a), (b), (c), 0, 0, 0)

#define XB_TMO      128
#define XB_XCNT(j)  (256  + 64 * (j))
#define XB_XSUB(j)  (1280 + 64 * (j))
#define XB_XGEN(j)  (2304 + 64 * (j))
#define XB_TOP      3328
#define XB_TOPGEN   3392
#define XCD_BAR_WORDS 3456
#define XB_SPIN_CAP (1u << 18)

__device__ __forceinline__ unsigned xb_ld(unsigned* p)              { return __hip_atomic_load(p, __ATOMIC_RELAXED, __HIP_MEMORY_SCOPE_AGENT); }
__device__ __forceinline__ unsigned xb_add(unsigned* p, unsigned v) { return __hip_atomic_fetch_add(p, v, __ATOMIC_RELAXED, __HIP_MEMORY_SCOPE_AGENT); }
__device__ __forceinline__ unsigned xb_xcc_id() { return (unsigned)__builtin_amdgcn_s_getreg((3 << 11) | 20) & 0xFu; }
#define XB_SPIN(cond, bar) do { unsigned _sp = 0; while (cond) { __builtin_amdgcn_s_sleep(1); \
    if ((++_sp & 255u) == 0u) { if (xb_ld(&(bar)[XB_TMO])) break; if (_sp > XB_SPIN_CAP) { atomicAdd(&(bar)[XB_TMO], 1u); break; } } } } while (0)

struct XcdBarrier {
    unsigned* bar; unsigned x;
    volatile LAS unsigned* st;
};

__device__ __forceinline__ XcdBarrier xcd_barrier_post(unsigned* bar, volatile LAS unsigned* st) {
    XcdBarrier b; b.bar = bar; b.x = xb_xcc_id(); b.st = st;
    if (threadIdx.x == 0) (void)xb_add(&bar[XB_XCNT(b.x)], 1u);
    return b;
}
__device__ __forceinline__ void xcd_barrier_complete(unsigned* bar, unsigned x, unsigned& nloc, unsigned& nx) {
    const unsigned G = gridDim.x * gridDim.y * gridDim.z;
    unsigned sum, cnt, mine, sp = 0u;
    for (;;) {
        sum = 0u; cnt = 0u; mine = 0u;
#pragma unroll
        for (unsigned j = 0; j < 16; ++j) { const unsigned c = xb_ld(&bar[XB_XCNT(j)]); sum += c; cnt += (c > 0u) ? 1u : 0u; mine = (j == x) ? c : mine; }
        if (sum == G) break;
        __builtin_amdgcn_s_sleep(1);
        if ((++sp & 255u) == 0u) { if (xb_ld(&bar[XB_TMO])) break; if (sp > XB_SPIN_CAP) { atomicAdd(&bar[XB_TMO], 1u); break; } }
    }
    nloc = mine > 0u ? mine : 1u; nx = cnt > 0u ? cnt : 1u;
}

__device__ __forceinline__ void xcd_barrier(const XcdBarrier& b) {
    asm volatile("s_waitcnt vmcnt(0)" ::: "memory");
    __syncthreads();
    if (threadIdx.x == 0) {
        unsigned* bar = b.bar;
        __builtin_amdgcn_s_waitcnt(0);
        unsigned nloc = b.st[0], nx = b.st[1];
        if (nloc == 0u) { xcd_barrier_complete(bar, b.x, nloc, nx); b.st[0] = nloc; b.st[1] = nx; }
        const unsigned old = xb_add(&bar[XB_XSUB(b.x)], 1u);
        const unsigned gen = old / nloc;
        if (old + 1u == (gen + 1u) * nloc) {
            __builtin_amdgcn_fence(__ATOMIC_RELEASE, "agent");
            asm volatile("s_waitcnt vmcnt(0)" ::: "memory");
            const unsigned og = xb_add(&bar[XB_TOP], 1u);
            const unsigned tg = og / nx;
            if (og + 1u == (tg + 1u) * nx) xb_add(&bar[XB_TOPGEN], 1u);
            else XB_SPIN(xb_ld(&bar[XB_TOPGEN]) == tg, bar);
            __builtin_amdgcn_fence(__ATOMIC_ACQUIRE, "agent");
            xb_add(&bar[XB_XGEN(b.x)], 1u);
            asm volatile("s_waitcnt vmcnt(0)" ::: "memory");
        } else {
            XB_SPIN(xb_ld(&bar[XB_XGEN(b.x)]) == gen, bar);
            __builtin_amdgcn_fence(__ATOMIC_ACQUIRE, "agent");
            asm volatile("s_waitcnt vmcnt(0)" ::: "memory");
        }
    }
    __syncthreads();
}


struct MapId { __device__ __forceinline__ int operator()(int r) const { return r; } };
struct MapGu { __device__ __forceinline__ int operator()(int r) const { return gu_src_col(r); } };
struct MapIn { __device__ __forceinline__ int operator()(int r) const { return win_src_col(r); } };
template <class Map>
__device__ __forceinline__ void tr_item(const float* W, int K, int ldw, bf16_t* WT, LAS float* scr, int item, int nblk, int lane, Map map, const float* kscale = nullptr) {
    const int kb = item / nblk, nb = item % nblk, k0 = 64 * kb, n0 = 64 * nb;
    const int r4 = lane >> 4, c4 = lane & 15;
    const int src = map(n0 + 4 * c4);
    f32x4 v[16];
    const float* wp = W + (size_t)(k0 + r4) * ldw + (src >= 0 ? src : 0);
#pragma unroll
    for (int i = 0; i < 16; ++i) v[i] = *(const f32x4*)(wp + (size_t)(4 * i) * ldw);
    if (src < 0) {
#pragma unroll
        for (int i = 0; i < 16; ++i) v[i] = (f32x4){0.f, 0.f, 0.f, 0.f};
    }
    if (kscale) {
#pragma unroll
        for (int i = 0; i < 16; ++i) v[i] = v[i] * kscale[k0 + 4 * i + r4];
    }
#pragma unroll
    for (int i = 0; i < 16; ++i) { LAS float* d = scr + (4 * i + r4) * 65 + 4 * c4; d[0] = v[i][0]; d[1] = v[i][1]; d[2] = v[i][2]; d[3] = v[i][3]; }
    LDS_WAIT(); asm volatile("" ::: "memory");
    const int c = lane & 7;
#pragma unroll
    for (int j = 0; j < 8; ++j) { const int n = (lane >> 3) + 8 * j; const LAS float* sp = scr + (8 * c) * 65 + n;
        u32x4 o; o.x = cvt_pk_bf16(sp[0 * 65], sp[1 * 65]); o.y = cvt_pk_bf16(sp[2 * 65], sp[3 * 65]); o.z = cvt_pk_bf16(sp[4 * 65], sp[5 * 65]); o.w = cvt_pk_bf16(sp[6 * 65], sp[7 * 65]);
        *(u32x4*)(WT + (size_t)(n0 + n) * K + k0 + 8 * c) = o; }
    LDS_WAIT(); asm volatile("" ::: "memory");
}
struct LayerW {
    const float *gu1, *d1, *gu2, *d2, *win, *wout, *w1k, *w1v, *kpe, *vpe, *pre1, *prem, *pre2;
};
__device__ __forceinline__ void phase_convert(const Ctx& c, const LayerW& L, unsigned char* ws) {
    LAS float* scr = (LAS float*)(c.lds + c.wave * 16640);
    constexpr int B_GU = (DM / 256) * (2 * DFF / 128), B_D = (DFF / 256) * (DM / 128), B_IN = (DM / 256) * (NPROJ / 128), B_O = (DM / 256) * (DM / 128), B_1 = (DM / 256) * (256 / 128);
    constexpr int NBI = 2 * B_GU + 2 * B_D + B_IN + B_O + 2 * B_1;
    const int wk = c.wave >> 1, wn = c.wave & 1;
#define TR_CALL(W_, K_, LDW_, WT_, N_, MAP_, KS_) do { const int nb2n = (N_) / 128, kb = 4 * (r / nb2n) + wk, nb = 2 * (r % nb2n) + wn; tr_item(W_, K_, LDW_, WT_, scr, kb * ((N_) / 64) + nb, (N_) / 64, c.lane, MAP_, KS_); } while (0)
    for (int it = c.bid; it < NBI; it += c.G) {
        int r = it;
        if (r < B_GU) { TR_CALL(L.gu1, DM, 2 * DFF, (bf16_t*)(ws + WS_WGU1), 2 * DFF, MapGu(), L.pre1); continue; } r -= B_GU;
        if (r < B_GU) { TR_CALL(L.gu2, DM, 2 * DFF, (bf16_t*)(ws + WS_WGU2), 2 * DFF, MapGu(), L.pre2); continue; } r -= B_GU;
        if (r < B_D) { TR_CALL(L.d1, DFF, DM, (bf16_t*)(ws + WS_WD1), DM, MapId(), nullptr); continue; } r -= B_D;
        if (r < B_D) { TR_CALL(L.d2, DFF, DM, (bf16_t*)(ws + WS_WD2), DM, MapId(), nullptr); continue; } r -= B_D;
        if (r < B_IN) { TR_CALL(L.win, DM, DIN, (bf16_t*)(ws + WS_WIN), NPROJ, MapIn(), L.prem); continue; } r -= B_IN;
        if (r < B_O) { TR_CALL(L.wout, DM, DM, (bf16_t*)(ws + WS_WOUT), DM, MapId(), nullptr); continue; } r -= B_O;
        if (r < B_1) { TR_CALL(L.w1k, DM, 256, (bf16_t*)(ws + WS_W1), 256, MapId(), nullptr); continue; } r -= B_1;
        TR_CALL(L.w1v, DM, 256, (bf16_t*)(ws + WS_W1) + 256 * DM, 256, MapId(), nullptr);
    }
#undef TR_CALL
    for (int seg = c.bid; seg < 256; seg += c.G) {
        const int kv = c.tid >> 8, col = c.tid & 255;
        const float* pe = kv ? L.vpe : L.kpe; const float* w1 = kv ? L.w1v : L.w1k;
        float s = 0.f;
#pragma unroll
        for (int k = 0; k < 8; ++k) s += pe[8 * seg + k] * w1[(size_t)(8 * seg + k) * 256 + col];
        ((float*)(ws + WS_PEP))[(kv * 256 + seg) * 256 + col] = s;
    }
}

__device__ __forceinline__ void phase_norm(const Ctx& c, const float* xin, const bf16_t* T, float alpha, const float* wpost, bf16_t* HB, float* RS, float* outf) {
    const int gw = c.bid * NWAVES + c.wave, NGW = c.G * NWAVES;
    if (xin) {
        for (int row = gw; row < M; row += NGW) {
            const size_t i0 = (size_t)row * 512 + c.lane; float ss = 0.f;
#pragma unroll
            for (int j = 0; j < 8; ++j) { const f32x4 hv = ((const f32x4*)xin)[i0 + 64 * j]; ss += (hv[0] * hv[0] + hv[1] * hv[1]) + (hv[2] * hv[2] + hv[3] * hv[3]);
                u32x2 pk; pk.x = cvt_pk_bf16(hv[0], hv[1]); pk.y = cvt_pk_bf16(hv[2], hv[3]); ((u32x2*)HB)[i0 + 64 * j] = pk; }
            const float rs = 1.0f / sqrtf(wave_sum(ss) * (1.0f / DM) + EPS);
            if (c.lane == 0) RS[row] = rs;
        }
        return;
    }
    for (int row = gw; row < M; row += 2 * NGW) {
        const bool two = row + NGW < M;
        const size_t i0 = (size_t)row * 512 + c.lane, i1 = (size_t)(two ? row + NGW : row) * 512 + c.lane;
        u32x2 tw[2][8], hw[2][8];
#pragma unroll
        for (int j = 0; j < 8; ++j) { tw[0][j] = ((const u32x2*)T)[i0 + 64 * j]; tw[1][j] = ((const u32x2*)T)[i1 + 64 * j]; }
#pragma unroll
        for (int j = 0; j < 8; ++j) { hw[0][j] = ((const u32x2*)HB)[i0 + 64 * j]; hw[1][j] = ((const u32x2*)HB)[i1 + 64 * j]; }
        f32x4 wp[8];
#pragma unroll
        for (int j = 0; j < 8; ++j) wp[j] = ((const f32x4*)wpost)[c.lane + 64 * j];
#pragma unroll
        for (int q = 0; q < 2; ++q) {
            if (q == 1 && !two) break;
            const size_t iq = q ? i1 : i0; const int rq = q ? row + NGW : row;
            f32x4 tv[8]; float ss = 0.f;
#pragma unroll
            for (int j = 0; j < 8; ++j) { tv[j] = (f32x4){bflo(tw[q][j].x), bfhi(tw[q][j].x), bflo(tw[q][j].y), bfhi(tw[q][j].y)};
                ss += (tv[j][0] * tv[j][0] + tv[j][1] * tv[j][1]) + (tv[j][2] * tv[j][2] + tv[j][3] * tv[j][3]); }
            const float rs = alpha / sqrtf(wave_sum(ss) * (1.0f / DM) + EPS);
            float s2 = 0.f;
#pragma unroll
            for (int j = 0; j < 8; ++j) { const f32x4 hv = (f32x4){bflo(hw[q][j].x), bfhi(hw[q][j].x), bflo(hw[q][j].y), bfhi(hw[q][j].y)} + tv[j] * rs * wp[j];
                if (outf) ((f32x4*)outf)[iq + 64 * j] = hv;
                else { s2 += (hv[0] * hv[0] + hv[1] * hv[1]) + (hv[2] * hv[2] + hv[3] * hv[3]);
                    u32x2 pk; pk.x = cvt_pk_bf16(hv[0], hv[1]); pk.y = cvt_pk_bf16(hv[2], hv[3]); ((u32x2*)HB)[iq + 64 * j] = pk; } }
            if (!outf) { const float r2 = 1.0f / sqrtf(wave_sum(s2) * (1.0f / DM) + EPS); if (c.lane == 0) RS[rq] = r2; }
        }
    }
}

struct SsdW { const float *conv_w, *conv_b, *dt_bias, *a_log, *dskip, *norm_w; };
__device__ __forceinline__ float softplus_f(float x) { return x > 20.f ? x : log1pf(__expf(x)); }

__device__ __forceinline__ void ssd_conv8(const bf16_t* PROJ, const SsdW& W, int b, int s, int ch0, float (&out)[8]) {
    const f32x4 b0 = *(const f32x4*)(W.conv_b + ch0), b1 = *(const f32x4*)(W.conv_b + ch0 + 4);
    float acc[8] = {b0[0], b0[1], b0[2], b0[3], b1[0], b1[1], b1[2], b1[3]};
#pragma unroll
    for (int k = 0; k < 4; ++k) {
        const int sr = s - 3 + k;
        if (sr >= 0) {
            const u32x4 x = *(const u32x4*)(PROJ + (size_t)(b * SEQ + sr) * NPROJ + PC_XBC + ch0);
            const f32x4 w0 = *(const f32x4*)(W.conv_w + k * 1536 + ch0), w1 = *(const f32x4*)(W.conv_w + k * 1536 + ch0 + 4);
            acc[0] += w0[0] * bflo(x.x); acc[1] += w0[1] * bfhi(x.x); acc[2] += w0[2] * bflo(x.y); acc[3] += w0[3] * bfhi(x.y);
            acc[4] += w1[0] * bflo(x.z); acc[5] += w1[1] * bfhi(x.z); acc[6] += w1[2] * bflo(x.w); acc[7] += w1[3] * bfhi(x.w);
        }
    }
#pragma unroll
    for (int e = 0; e < 8; ++e) out[e] = silu_f(acc[e]);
}
struct Conv8W { f32x4 w[4][2]; f32x4 b[2]; };
__device__ __forceinline__ Conv8W conv8_load_w(const SsdW& W, int ch0) { Conv8W r;
#pragma unroll
    for (int k = 0; k < 4; ++k) { r.w[k][0] = *(const f32x4*)(W.conv_w + k * 1536 + ch0); r.w[k][1] = *(const f32x4*)(W.conv_w + k * 1536 + ch0 + 4); }
    r.b[0] = *(const f32x4*)(W.conv_b + ch0); r.b[1] = *(const f32x4*)(W.conv_b + ch0 + 4); return r; }
__device__ __forceinline__ void conv8_load_x(const bf16_t* PROJ, int b, int s, int ch0, u32x4 (&x)[4]) {
#pragma unroll
    for (int k = 0; k < 4; ++k) { const int sr = s - 3 + k; x[k] = (u32x4){0u, 0u, 0u, 0u}; if (sr >= 0) x[k] = *(const u32x4*)(PROJ + (size_t)(b * SEQ + sr) * NPROJ + PC_XBC + ch0); } }
__device__ __forceinline__ void conv8_apply(const Conv8W& cw, const u32x4 (&x)[4], float (&out)[8]) {
    float acc[8] = {cw.b[0][0], cw.b[0][1], cw.b[0][2], cw.b[0][3], cw.b[1][0], cw.b[1][1], cw.b[1][2], cw.b[1][3]};
#pragma unroll
    for (int k = 0; k < 4; ++k) {
        acc[0] += cw.w[k][0][0] * bflo(x[k].x); acc[1] += cw.w[k][0][1] * bfhi(x[k].x); acc[2] += cw.w[k][0][2] * bflo(x[k].y); acc[3] += cw.w[k][0][3] * bfhi(x[k].y);
        acc[4] += cw.w[k][1][0] * bflo(x[k].z); acc[5] += cw.w[k][1][1] * bfhi(x[k].z); acc[6] += cw.w[k][1][2] * bflo(x[k].w); acc[7] += cw.w[k][1][3] * bfhi(x[k].w); }
#pragma unroll
    for (int e = 0; e < 8; ++e) out[e] = silu_f(acc[e]);
}
__device__ __forceinline__ u32x4 pack8(const float (&v)[8]) { u32x4 w; w.x = cvt_pk_bf16(v[0], v[1]); w.y = cvt_pk_bf16(v[2], v[3]); w.z = cvt_pk_bf16(v[4], v[5]); w.w = cvt_pk_bf16(v[6], v[7]); return w; }

constexpr int P136 = 272, P72 = 144;
__device__ __forceinline__ void ssd_a_unit(const Ctx& c, const SsdW& W, unsigned char* ws, int unit) {
    const int g = unit & 1, ch = (unit >> 1) & 63, b = unit >> 7;
    const bf16_t* PROJ = (const bf16_t*)(ws + WS_PROJ); bf16_t* XACT = (bf16_t*)(ws + WS_XACT);
    float* DT = (float*)(ws + WS_DT); float* CS = (float*)(ws + WS_CS); float* CDEC = (float*)(ws + WS_CDEC); bf16_t* ST = (bf16_t*)(ws + WS_STATES);
    LAS float* sclS = (LAS float*)(c.lds + 8192);
    LAS unsigned char* Bs = c.lds + 12288;
    LAS unsigned char* Xs = c.lds + 12288 + 128 * P136;
    const int m0 = b * SEQ + ch * 128;
    const int q8 = c.tid & 7, xs = c.tid >> 3;
    Conv8W hw = conv8_load_w(W, 64 * (8 * g) + 8 * q8);
    u32x4 hx[2][4];
#pragma unroll
    for (int i = 0; i < 2; ++i) conv8_load_x(PROJ, b, ch * 128 + xs + 64 * i, 64 * (8 * g) + 8 * q8, hx[i]);
    __syncthreads();
    {
        const int hh = 8 * g + c.wave; const float bias = W.dt_bias[hh], a = -__expf(W.a_log[hh]);
        const int s0 = 2 * c.lane;
        const float r0 = bf2f(PROJ[(size_t)(m0 + s0) * NPROJ + PC_DT + hh]), r1 = bf2f(PROJ[(size_t)(m0 + s0 + 1) * NPROJ + PC_DT + hh]);
        const float dt0 = softplus_f(r0 + bias), dt1 = softplus_f(r1 + bias);
        const float v0 = a * dt0, pair = v0 + a * dt1;
        float x = pair;
#pragma unroll
        for (int o = 1; o < 64; o <<= 1) { const float y = __shfl_up(x, o); if (c.lane >= o) x += y; }
        const float cs0 = (x - pair) + v0, cs1 = x, tot = __shfl(x, 63);
        sclS[c.wave * 128 + s0] = __expf(tot - cs0) * dt0; sclS[c.wave * 128 + s0 + 1] = __expf(tot - cs1) * dt1;
        DT[(size_t)(m0 + s0) * 16 + hh] = dt0; DT[(size_t)(m0 + s0 + 1) * 16 + hh] = dt1;
        CS[(size_t)(m0 + s0) * 16 + hh] = cs0; CS[(size_t)(m0 + s0 + 1) * 16 + hh] = cs1;
        if (c.lane == 63) CDEC[(b * 64 + ch) * 16 + hh] = __expf(tot);
    }
    {
        const int q = c.tid & 31, ch0 = (q < 16) ? 1024 + 128 * g + 8 * q : 1280 + 128 * g + 8 * (q - 16);
        const Conv8W cw = conv8_load_w(W, ch0);
#pragma unroll
        for (int k0 = 0; k0 < 8; k0 += 4) {
            u32x4 x[4][4];
#pragma unroll
            for (int i = 0; i < 4; ++i) conv8_load_x(PROJ, b, ch * 128 + (c.tid >> 5) + 16 * (k0 + i), ch0, x[i]);
#pragma unroll
            for (int i = 0; i < 4; ++i) { const int s = (c.tid >> 5) + 16 * (k0 + i);
                float v[8]; conv8_apply(cw, x[i], v);
                const u32x4 pk = pack8(v);
                *(u32x4*)(XACT + (size_t)(m0 + s) * 1536 + ch0) = pk;
                if (q < 16) *(LAS u32x4*)(Bs + s * P136 + q * 16) = pk; }
        }
    }
    for (int h8 = 0; h8 < 8; ++h8) {
        const int hh = 8 * g + h8;
        __syncthreads();
        {
            const int ch0 = 64 * hh + 8 * q8;
            float v[2][8];
#pragma unroll
            for (int i = 0; i < 2; ++i) conv8_apply(hw, hx[i], v[i]);
            if (h8 < 7) { hw = conv8_load_w(W, ch0 + 64);
#pragma unroll
                for (int i = 0; i < 2; ++i) conv8_load_x(PROJ, b, ch * 128 + xs + 64 * i, ch0 + 64, hx[i]); }
#pragma unroll
            for (int i = 0; i < 2; ++i) { const int s = xs + 64 * i;
                *(u32x4*)(XACT + (size_t)(m0 + s) * 1536 + ch0) = pack8(v[i]);
                const float sc = sclS[h8 * 128 + s];
#pragma unroll
                for (int e = 0; e < 8; ++e) v[i][e] *= sc;
                *(LAS u32x4*)(Xs + s * P72 + q8 * 16) = pack8(v[i]); }
        }
        __syncthreads();
        const int pt = c.wave & 3, ntg = c.wave >> 2;
        f32x4 acc[4];
#pragma unroll
        for (int nt = 0; nt < 4; ++nt) acc[nt] = (f32x4){0.f, 0.f, 0.f, 0.f};
#pragma unroll
        for (int ks = 0; ks < 4; ++ks) {
            const bf16x8 xf = frag_tr(Xs, P72, 32 * ks, 16 * pt, c.lane);
#pragma unroll
            for (int nt = 0; nt < 4; ++nt) { const bf16x8 bf = frag_tr(Bs, P136, 32 * ks, 16 * (4 * ntg + nt), c.lane); acc[nt] = MFMA16(bf, xf, acc[nt]); }
        }
        bf16_t* stp = ST + ((size_t)((b * 64 + ch) * 16 + hh) * 64 + 16 * pt + (c.lane & 15)) * 128 + 4 * (c.lane >> 4);
#pragma unroll
        for (int nt = 0; nt < 4; ++nt) { u32x2 pk; pk.x = cvt_pk_bf16(acc[nt][0], acc[nt][1]); pk.y = cvt_pk_bf16(acc[nt][2], acc[nt][3]); *(u32x2*)(stp + 16 * (4 * ntg + nt)) = pk; }
    }
}

__device__ __forceinline__ void phase_ssd_scan(const Ctx& c, unsigned char* ws) {
    const unsigned* ST = (const unsigned*)(ws + WS_STATES); const float* CDEC = (const float*)(ws + WS_CDEC); unsigned* HP = (unsigned*)(ws + WS_HP);
    for (int chain = c.bid * NTHR + c.tid; chain < NB * 16 * 64 * 64; chain += c.G * NTHR) {
        const int n2 = chain & 63, p = (chain >> 6) & 63, hh = (chain >> 12) & 15, b = chain >> 16;
        f32x2 run = (f32x2){0.f, 0.f};
#pragma unroll 16
        for (int ch = 0; ch < 64; ++ch) {
            const size_t idx = ((size_t)((b * 64 + ch) * 16 + hh) * 64 + p) * 64 + n2;
            const unsigned sp = ST[idx]; const f32x2 s = (f32x2){bflo(sp), bfhi(sp)}; const float dec = CDEC[(b * 64 + ch) * 16 + hh];
            HP[idx] = cvt_pk_bf16(run[0], run[1]);
            run = run * dec + s;
        }
    }
}

__device__ __forceinline__ void ssd_b_unit(const Ctx& c, const SsdW& W, unsigned char* ws, int unit) {
    const int g = unit & 1, ch = (unit >> 1) & 63, b = unit >> 7;
    const bf16_t* PROJ = (const bf16_t*)(ws + WS_PROJ); const bf16_t* XACT = (const bf16_t*)(ws + WS_XACT); const bf16_t* HP = (const bf16_t*)(ws + WS_HP);
    const float* DT = (const float*)(ws + WS_DT); const float* CS = (const float*)(ws + WS_CS); bf16_t* Y = (bf16_t*)(ws + WS_Y);
    LAS float* csS = (LAS float*)(c.lds);
    LAS float* dtS = (LAS float*)(c.lds + 4096);
    LAS unsigned char* Cs = c.lds + 8192;
    LAS unsigned char* Ws = Cs + 128 * P136;
    LAS unsigned char* CBs = Ws + 128 * P136;
    LAS unsigned char* Xs = CBs + 128 * P136;
    LAS unsigned char* Hs = Xs + 128 * P72;
    const int m0 = b * SEQ + ch * 128, lane = c.lane, w = c.wave;
    __syncthreads();
    {
        u32x4 sv[8]; float cv[2], dv[2];
#pragma unroll
        for (int i = 0; i < 8; ++i) { const int it = c.tid + NTHR * i, s = it >> 5, q = it & 31;
            sv[i] = *(const u32x4*)(XACT + (size_t)(m0 + s) * 1536 + ((q < 16) ? 1280 + 128 * g + 8 * q : 1024 + 128 * g + 8 * (q - 16))); }
#pragma unroll
        for (int i = 0; i < 2; ++i) { const int it = c.tid + NTHR * i, s = it >> 3, h8 = it & 7; cv[i] = CS[(size_t)(m0 + s) * 16 + 8 * g + h8]; dv[i] = DT[(size_t)(m0 + s) * 16 + 8 * g + h8]; }
#pragma unroll
        for (int i = 0; i < 8; ++i) { const int it = c.tid + NTHR * i, s = it >> 5, q = it & 31; *(LAS u32x4*)(((q < 16) ? Cs : Ws) + s * P136 + (q & 15) * 16) = sv[i]; }
#pragma unroll
        for (int i = 0; i < 2; ++i) { const int it = c.tid + NTHR * i, s = it >> 3, h8 = it & 7; csS[h8 * 128 + s] = cv[i]; dtS[h8 * 128 + s] = dv[i]; }
    }
    __syncthreads();
    bf16x8 cfr[4];
#pragma unroll
    for (int ks = 0; ks < 4; ++ks) cfr[ks] = frag_row(Cs, P136, 16 * w, 32 * ks, lane);
    for (int st = 0; st <= w; ++st) {
        f32x4 a = (f32x4){0.f, 0.f, 0.f, 0.f};
#pragma unroll
        for (int ks = 0; ks < 4; ++ks) a = MFMA16(frag_row(Ws, P136, 16 * st, 32 * ks, lane), cfr[ks], a);
        u32x2 pk; pk.x = cvt_pk_bf16(a[0], a[1]); pk.y = cvt_pk_bf16(a[2], a[3]);
        *(LAS u32x2*)(CBs + (16 * w + (lane & 15)) * P136 + (16 * st + 4 * (lane >> 4)) * 2) = pk;
    }
    float ssq = 0.f;
    const int tok = 16 * w + (lane & 15);
    const int xs0 = c.tid >> 3, xq = c.tid & 7, hp0 = c.tid >> 4, hq = c.tid & 15;
    u32x4 xr[2], hr[2];
#define SSDB_FETCH(hh_) do { \
        xr[0] = *(const u32x4*)(XACT + (size_t)(m0 + xs0) * 1536 + 64 * (hh_) + 8 * xq); xr[1] = *(const u32x4*)(XACT + (size_t)(m0 + xs0 + 64) * 1536 + 64 * (hh_) + 8 * xq); \
        hr[0] = *(const u32x4*)(HP + ((size_t)((b * 64 + ch) * 16 + (hh_)) * 64 + hp0) * 128 + 8 * hq); hr[1] = *(const u32x4*)(HP + ((size_t)((b * 64 + ch) * 16 + (hh_)) * 64 + hp0 + 32) * 128 + 8 * hq); } while (0)
    SSDB_FETCH(8 * g);
    for (int h8 = 0; h8 < 8; ++h8) {
        const int hh = 8 * g + h8;
        u32x2 zv[4];
#pragma unroll
        for (int pt = 0; pt < 4; ++pt) zv[pt] = *(const u32x2*)(PROJ + (size_t)(m0 + tok) * NPROJ + PC_Z + 64 * hh + 16 * pt + 4 * (lane >> 4));
        __syncthreads();
        *(LAS u32x4*)(Xs + xs0 * P72 + xq * 16) = xr[0]; *(LAS u32x4*)(Xs + (xs0 + 64) * P72 + xq * 16) = xr[1];
        *(LAS u32x4*)(Hs + hp0 * P136 + hq * 16) = hr[0]; *(LAS u32x4*)(Hs + (hp0 + 32) * P136 + hq * 16) = hr[1];
        if (h8 < 7) SSDB_FETCH(hh + 1);
        for (int it = c.tid; it < 128 * 16; it += NTHR) {
            const int l = it >> 4, q = it & 15, s0 = 8 * q;
            u32x4 o = (u32x4){0u, 0u, 0u, 0u};
            if (s0 <= l) {
                const u32x4 cb = *(const LAS u32x4*)(CBs + l * P136 + q * 16); const float cl = csS[h8 * 128 + l];
                float v[8] = {bflo(cb.x), bfhi(cb.x), bflo(cb.y), bfhi(cb.y), bflo(cb.z), bfhi(cb.z), bflo(cb.w), bfhi(cb.w)};
                const f32x4 c0 = *(const LAS f32x4*)(csS + h8 * 128 + s0), c1 = *(const LAS f32x4*)(csS + h8 * 128 + s0 + 4), d0 = *(const LAS f32x4*)(dtS + h8 * 128 + s0), d1 = *(const LAS f32x4*)(dtS + h8 * 128 + s0 + 4);
                const float csv[8] = {c0[0], c0[1], c0[2], c0[3], c1[0], c1[1], c1[2], c1[3]}, dtv[8] = {d0[0], d0[1], d0[2], d0[3], d1[0], d1[1], d1[2], d1[3]};
#pragma unroll
                for (int e = 0; e < 8; ++e) { const int s = s0 + e; v[e] = (s <= l) ? v[e] * __expf(cl - csv[e]) * dtv[e] : 0.f; }
                o = pack8(v);
            }
            *(LAS u32x4*)(Ws + l * P136 + q * 16) = o;
        }
        __syncthreads();
        const int nks = (w >> 1) + 1;
        const float ecs = __expf(csS[h8 * 128 + tok]), dsk = W.dskip[hh];
#pragma unroll
        for (int pt = 0; pt < 4; ++pt) {
            f32x4 yd = (f32x4){0.f, 0.f, 0.f, 0.f}, yo = (f32x4){0.f, 0.f, 0.f, 0.f};
            for (int ks = 0; ks < nks; ++ks) yd = MFMA16(frag_tr(Xs, P72, 32 * ks, 16 * pt, lane), frag_row(Ws, P136, 16 * w, 32 * ks, lane), yd);
#pragma unroll
            for (int ks = 0; ks < 4; ++ks) yo = MFMA16(frag_row(Hs, P136, 16 * pt, 32 * ks, lane), cfr[ks], yo);
            const int p0 = 16 * pt + 4 * (lane >> 4);
            const u32x2 xv = *(const LAS u32x2*)(Xs + tok * P72 + p0 * 2);
            const float xx[4] = {bflo(xv.x), bfhi(xv.x), bflo(xv.y), bfhi(xv.y)}, zz[4] = {bflo(zv[pt].x), bfhi(zv[pt].x), bflo(zv[pt].y), bfhi(zv[pt].y)};
            float yv[4];
#pragma unroll
            for (int r = 0; r < 4; ++r) { yv[r] = (yd[r] + ecs * yo[r] + dsk * xx[r]) * silu_f(zz[r]); ssq += yv[r] * yv[r]; }
            u32x2 pk; pk.x = cvt_pk_bf16(yv[0], yv[1]); pk.y = cvt_pk_bf16(yv[2], yv[3]);
            *(u32x2*)(Y + (size_t)(m0 + tok) * DM + 64 * hh + p0) = pk;
        }
    }
#undef SSDB_FETCH
    ssq += __shfl_xor(ssq, 16); ssq += __shfl_xor(ssq, 32);
    const float rstd = 1.0f / sqrtf(ssq * (1.0f / 512.f) + EPS);
    VM_WAIT(); __builtin_amdgcn_fence(__ATOMIC_ACQUIRE, "agent"); VM_WAIT();
    const f32x4 nw0 = *(const f32x4*)(W.norm_w + 512 * g + 8 * lane), nw1 = *(const f32x4*)(W.norm_w + 512 * g + 8 * lane + 4);
    u32x4 yrow[16];
#pragma unroll
    for (int t = 0; t < 16; ++t) yrow[t] = *(const u32x4*)(Y + (size_t)(m0 + 16 * w + t) * DM + 512 * g + 8 * lane);
#pragma unroll
    for (int t = 0; t < 16; ++t) {
        const float rs = __shfl(rstd, t);
        bf16_t* yp = Y + (size_t)(m0 + 16 * w + t) * DM + 512 * g + 8 * lane;
        const u32x4 v = yrow[t];
        float o[8] = {bflo(v.x) * rs * nw0[0], bfhi(v.x) * rs * nw0[1], bflo(v.y) * rs * nw0[2], bfhi(v.y) * rs * nw0[3],
                      bflo(v.z) * rs * nw1[0], bfhi(v.z) * rs * nw1[1], bflo(v.w) * rs * nw1[2], bfhi(v.w) * rs * nw1[3]};
        *(u32x4*)yp = pack8(o);
    }
}

struct CnvW { const float *dw_w, *dw_b, *ln_w, *ln_b; };
__device__ __forceinline__ void cnv_unit(const Ctx& c, const CnvW& W, unsigned char* ws, int unit) {
    const bf16_t* PROJ = (const bf16_t*)(ws + WS_PROJ); bf16_t* Y = (bf16_t*)(ws + WS_Y);
    LAS float* vin = (LAS float*)c.lds;
    LAS float* red = (LAS float*)(c.lds + 62 * 512 * 4);
    const int b = unit >> 8, s0 = (unit & 255) * 32;
    __syncthreads();
    {
        u32x4 ra[8], rg[8];
#pragma unroll
        for (int i = 0; i < 8; ++i) { const int it = c.tid + NTHR * i, r = it >> 6, q = it & 63, s = s0 - 30 + r;
            ra[i] = (u32x4){0u, 0u, 0u, 0u}; rg[i] = (u32x4){0u, 0u, 0u, 0u};
            if (it < 62 * 64 && s >= 0) { const bf16_t* row = PROJ + (size_t)(b * SEQ + s) * NPROJ + PC_GLU + 8 * q; ra[i] = *(const u32x4*)row; rg[i] = *(const u32x4*)(row + 512); } }
#pragma unroll
        for (int i = 0; i < 8; ++i) { const int it = c.tid + NTHR * i, r = it >> 6, q = it & 63;
            if (it < 62 * 64) {
                const u32x4 a = ra[i], gt = rg[i];
                const float av[8] = {bflo(a.x), bfhi(a.x), bflo(a.y), bfhi(a.y), bflo(a.z), bfhi(a.z), bflo(a.w), bfhi(a.w)};
                const float gv[8] = {bflo(gt.x), bfhi(gt.x), bflo(gt.y), bfhi(gt.y), bflo(gt.z), bfhi(gt.z), bflo(gt.w), bfhi(gt.w)};
                float v[8];
#pragma unroll
                for (int e = 0; e < 8; ++e) v[e] = av[e] * __builtin_amdgcn_rcpf(1.0f + __expf(-gv[e]));
                *(LAS f32x4*)(vin + r * 512 + 8 * q) = (f32x4){v[0], v[1], v[2], v[3]}; *(LAS f32x4*)(vin + r * 512 + 8 * q + 4) = (f32x4){v[4], v[5], v[6], v[7]};
            } }
    }
    __syncthreads();
    const int ch = c.tid;
    float acc[32];
    { const float bias = W.dw_b[ch];
#pragma unroll
      for (int t = 0; t < 32; ++t) acc[t] = bias; }
    {
        float xin[62];
#pragma unroll
        for (int r = 0; r < 62; ++r) xin[r] = vin[r * 512 + ch];
#pragma unroll
        for (int k = 0; k < 31; ++k) { const float wk = W.dw_w[k * 512 + ch];
#pragma unroll
            for (int t = 0; t < 32; ++t) acc[t] += wk * xin[t + k]; }
    }
#pragma unroll
    for (int t = 0; t < 32; ++t) { const float s1 = wave_sum(acc[t]), s2 = wave_sum(acc[t] * acc[t]); if (c.lane == 0) { red[(c.wave * 32 + t) * 2] = s1; red[(c.wave * 32 + t) * 2 + 1] = s2; } }
    __syncthreads();
    const float lw = W.ln_w[ch], lb = W.ln_b[ch];
#pragma unroll
    for (int t = 0; t < 32; ++t) {
        float s1 = 0.f, s2 = 0.f;
#pragma unroll
        for (int wv = 0; wv < 8; ++wv) { s1 += red[(wv * 32 + t) * 2]; s2 += red[(wv * 32 + t) * 2 + 1]; }
        const float mu = s1 * (1.0f / 512.f), var = fmaxf(s2 * (1.0f / 512.f) - mu * mu, 0.f);
        const float o = silu_f((acc[t] - mu) * __builtin_amdgcn_rsqf(var + EPS) * lw + lb);
        Y[(size_t)(b * SEQ + s0 + t) * DM + 1536 + ch] = (bf16_t)(cvt_pk_bf16(o, 0.f) & 0xffffu);
    }
}

__device__ __forceinline__ void nsa_cmp2(const Ctx& c, const float* w2, const bf16_t* H1, bf16_t* KC, int pm) {
    LAS unsigned char* W2s = c.lds;
    VM_WAIT(); __syncthreads();
    __builtin_amdgcn_fence(__ATOMIC_ACQUIRE, "agent"); VM_WAIT();
    for (int it = c.tid; it < 256 * 8; it += NTHR) { const int k = it >> 3, q = it & 7;
        const f32x4 a = *(const f32x4*)(w2 + k * 64 + 8 * q), b = *(const f32x4*)(w2 + k * 64 + 8 * q + 4);
        u32x4 o; o.x = cvt_pk_bf16(a[0], a[1]); o.y = cvt_pk_bf16(a[2], a[3]); o.z = cvt_pk_bf16(b[0], b[1]); o.w = cvt_pk_bf16(b[2], b[3]);
        *(LAS u32x4*)(W2s + k * P72 + q * 16) = o; }
    __syncthreads();
    const int lane = c.lane;
#pragma unroll
    for (int rt = 0; rt < 2; ++rt) {
        const int r0 = pm * 256 + c.wave * 32 + rt * 16;
        f32x4 acc[4];
#pragma unroll
        for (int dt = 0; dt < 4; ++dt) acc[dt] = (f32x4){0.f, 0.f, 0.f, 0.f};
        for (int ks = 0; ks < 8; ++ks) {
            const bf16x8 hf = *(const bf16x8*)(H1 + (size_t)(r0 + (lane & 15)) * 256 + 32 * ks + 8 * (lane >> 4));
#pragma unroll
            for (int dt = 0; dt < 4; ++dt) acc[dt] = MFMA16(frag_tr(W2s, P72, 32 * ks, 16 * dt, lane), hf, acc[dt]);
        }
#pragma unroll
        for (int dt = 0; dt < 4; ++dt) { u32x2 pk; pk.x = cvt_pk_bf16(acc[dt][0], acc[dt][1]); pk.y = cvt_pk_bf16(acc[dt][2], acc[dt][3]);
            *(u32x2*)(KC + (size_t)(r0 + (lane & 15)) * 64 + 16 * dt + 4 * (lane >> 4)) = pk; }
    }
}

typedef unsigned long long u64;
__device__ __forceinline__ int next_bit(u64 lo, u64 hi, int from) {
    if (from < 64) { const u64 m = lo & (~0ull << from); if (m) return __builtin_ctzll(m); from = 64; }
    if (from < 128) { const u64 m = hi & (~0ull << (from - 64)); if (m) return 64 + __builtin_ctzll(m); }
    return -1;
}
constexpr int NSA_D = 6, NSA_SLOT = 16384, NSA_RING = 0, NSA_IMP = NSA_D * NSA_SLOT, NSA_SELM = NSA_IMP + 8 * 8 * 132 * 4, NSA_END = NSA_SELM + 64 * 16;
static_assert(NSA_END <= LDS_WORK, "NSA LDS map");
__device__ __forceinline__ bf16x8 frag_row_sw(const LAS unsigned char* base, int row0, int k0, int lane) {
    const int r = row0 + (lane & 15), cc = (k0 >> 3) + (lane >> 4);
    return *(const LAS bf16x8*)(base + r * 128 + ((cc ^ ((r >> 1) & 7)) << 4));
}
__device__ __forceinline__ void vtr_half(bf16x8 (&vf)[2][2], unsigned a00, unsigned a01, unsigned a10, unsigned a11) {
    s16x4 t[2][2][2];
    asm volatile(
        "ds_read_b64_tr_b16 %0, %8\n\tds_read_b64_tr_b16 %1, %9\n\tds_read_b64_tr_b16 %2, %8 offset:4096\n\tds_read_b64_tr_b16 %3, %9 offset:4096\n\t"
        "ds_read_b64_tr_b16 %4, %10\n\tds_read_b64_tr_b16 %5, %11\n\tds_read_b64_tr_b16 %6, %10 offset:4096\n\tds_read_b64_tr_b16 %7, %11 offset:4096\n\t"
        "s_waitcnt lgkmcnt(0)"
        : "=&v"(t[0][0][0]), "=&v"(t[0][0][1]), "=&v"(t[0][1][0]), "=&v"(t[0][1][1]), "=&v"(t[1][0][0]), "=&v"(t[1][0][1]), "=&v"(t[1][1][0]), "=&v"(t[1][1][1])
        : "v"(a00), "v"(a01), "v"(a10), "v"(a11)
        : "memory");
#pragma unroll
    for (int dt = 0; dt < 2; ++dt)
#pragma unroll
        for (int ks = 0; ks < 2; ++ks) vf[dt][ks] = (bf16x8){t[dt][ks][0][0], t[dt][ks][0][1], t[dt][ks][0][2], t[dt][ks][0][3], t[dt][ks][1][0], t[dt][ks][1][1], t[dt][ks][1][2], t[dt][ks][1][3]};
}
__device__ __forceinline__ u64 uni64(u64 x) { return ((u64)(unsigned)__builtin_amdgcn_readfirstlane((int)(x >> 32)) << 32) | (u64)(unsigned)__builtin_amdgcn_readfirstlane((int)x); }
__device__ __forceinline__ void wait_vm_n(int n) {
    if (n >= 4) asm volatile("s_waitcnt vmcnt(4)" ::: "memory"); else if (n == 2) asm volatile("s_waitcnt vmcnt(2)" ::: "memory");
    else if (n == 1) asm volatile("s_waitcnt vmcnt(1)" ::: "memory"); else asm volatile("s_waitcnt vmcnt(0)" ::: "memory");
}
__device__ __forceinline__ bool bit128(u64 lo, u64 hi, int j) { return (j < 64) ? ((lo >> j) & 1ull) : ((hi >> (j - 64)) & 1ull); }
struct NsaRows {
    int ql, hg, kq;
    int t[2];
    int tmin, tmax;
    u64 selLo[2], selHi[2];
};
template <int MODE, int KIND, bool MASKED>
__device__ __forceinline__ void nsa_block(const LAS unsigned char* Ks, unsigned vbase, const unsigned (&voff)[4][2], LAS unsigned char* Ps, LAS float* imp, int j, int lane,
                                          const NsaRows& R, const bf16x8 (&qf)[2][2], float (&lrow)[2], f32x4 (&lacc)[2], const float (&invl)[2], f32x4 (&o)[2][4]) {
    const float NEGINF = -INFINITY;
    f32x4 s[2][4];
#pragma unroll
    for (int T = 0; T < 2; ++T) {
        float sinit = 0.f;
        if (KIND == 1) sinit = bit128(R.selLo[T], R.selHi[T], j) ? 0.f : NEGINF;
#pragma unroll
        for (int kt = 0; kt < 4; ++kt) s[T][kt] = (f32x4){sinit, sinit, sinit, sinit};
    }
#pragma unroll
    for (int kt = 0; kt < 4; ++kt) {
        const bf16x8 k0 = frag_row_sw(Ks, 16 * kt, 0, lane), k1 = frag_row_sw(Ks, 16 * kt, 32, lane);
#pragma unroll
        for (int T = 0; T < 2; ++T) { s[T][kt] = MFMA16(k0, qf[T][0], s[T][kt]); s[T][kt] = MFMA16(k1, qf[T][1], s[T][kt]); }
    }
    float p[2][4][4]; bf16x8 pf[2][2];
#pragma unroll
    for (int T = 0; T < 2; ++T) {
        if (MASKED) {
#pragma unroll
            for (int kt = 0; kt < 4; ++kt)
#pragma unroll
                for (int r = 0; r < 4; ++r) {
                    const int key = 64 * j + 16 * kt + 4 * R.kq + r;
                    bool ok;
                    if (KIND == 0) ok = (16 * key + 31 <= R.t[T]);
                    else if (KIND == 1) ok = (key <= R.t[T]);
                    else ok = (key <= R.t[T]) && (R.t[T] - key < 512);
                    s[T][kt][r] = ok ? s[T][kt][r] : NEGINF;
                }
        }
        float ps = 0.f;
#pragma unroll
        for (int kt = 0; kt < 4; ++kt)
#pragma unroll
            for (int r = 0; r < 4; ++r) { p[T][kt][r] = __builtin_amdgcn_exp2f(s[T][kt][r]); if (MODE == 1) ps += p[T][kt][r]; }
        if (MODE == 1) lrow[T] += ps;
        if (MODE == 2) {
#pragma unroll
            for (int kt = 0; kt < 4; ++kt)
#pragma unroll
                for (int r = 0; r < 4; ++r) p[T][kt][r] *= invl[T];
        }
        if (MODE != 1) {
#pragma unroll
            for (int ks = 0; ks < 2; ++ks) { u32x4 w; w.x = cvt_pk_bf16(p[T][2 * ks][0], p[T][2 * ks][1]); w.y = cvt_pk_bf16(p[T][2 * ks][2], p[T][2 * ks][3]);
                w.z = cvt_pk_bf16(p[T][2 * ks + 1][0], p[T][2 * ks + 1][1]); w.w = cvt_pk_bf16(p[T][2 * ks + 1][2], p[T][2 * ks + 1][3]); pf[T][ks] = __builtin_bit_cast(bf16x8, w); }
            if (MODE == 0) {
                const u32x4 o1 = (u32x4){0x3f803f80u, 0x3f803f80u, 0x3f803f80u, 0x3f803f80u}; const bf16x8 ones = __builtin_bit_cast(bf16x8, o1);
                lacc[T] = MFMA16(ones, pf[T][0], lacc[T]); lacc[T] = MFMA16(ones, pf[T][1], lacc[T]); }
        }
    }
    if (MODE == 2) {
#pragma unroll
        for (int T = 0; T < 2; ++T)
#pragma unroll
            for (int kt = 0; kt < 4; ++kt) {
                float q4[4];
#pragma unroll
                for (int r = 0; r < 4; ++r) { float v = p[T][kt][r]; v += __shfl_xor(v, 1); v += __shfl_xor(v, 2); q4[r] = v; }
                if (R.hg == 0) { LAS float* ip = imp + (4 * T + R.ql) * 132 + 16 * j + 4 * kt + R.kq;
                    ip[0] += 2.f * (q4[0] + q4[1] + q4[2]) + q4[3]; asm volatile("" ::: "memory"); ip[1] += q4[3]; asm volatile("" ::: "memory"); }
            }
    }
    if (MODE != 1) {
#pragma unroll
        for (int dh = 0; dh < 2; ++dh) {
            bf16x8 vf[2][2];
            vtr_half(vf, vbase + voff[2 * dh][0], vbase + voff[2 * dh][1], vbase + voff[2 * dh + 1][0], vbase + voff[2 * dh + 1][1]);
#pragma unroll
            for (int T = 0; T < 2; ++T)
#pragma unroll
                for (int d2 = 0; d2 < 2; ++d2) { o[T][2 * dh + d2] = MFMA16(vf[d2][0], pf[T][0], o[T][2 * dh + d2]); o[T][2 * dh + d2] = MFMA16(vf[d2][1], pf[T][1], o[T][2 * dh + d2]); }
        }
    }
}
template <int MODE, int KIND>
__device__ __forceinline__ void nsa_pass(const Ctx& c, u64 mlo_, u64 mhi_, u64 wlo_, u64 whi_, const bf16_t* Kg, const bf16_t* Vg,
                                         const NsaRows& R, const bf16x8 (&qf)[2][2], float (&lrow)[2], const float (&invl)[2], f32x4 (&o)[2][4]) {
    f32x4 lacc[2] = {(f32x4){0.f, 0.f, 0.f, 0.f}, (f32x4){0.f, 0.f, 0.f, 0.f}};
    const u64 mlo = uni64(mlo_), mhi = uni64(mhi_), wlo = uni64(wlo_), whi = uni64(whi_);
    LAS unsigned char* ring = c.lds + NSA_RING; LAS unsigned char* Ps = nullptr;
    LAS float* imp = (LAS float*)(c.lds + NSA_IMP) + c.wave * 8 * 132;
    int lane = c.lane; asm volatile("" : "+v"(lane));
    constexpr int LPB = (MODE == 1) ? 1 : 2;
    const int drow = 8 * c.wave + (lane >> 3), dch = (lane & 7) ^ ((drow >> 1) & 7);
    const size_t goff = (size_t)drow * 64 + 8 * dch;
    unsigned voff[4][2];
    { const int g = lane >> 4, q = (lane & 15) >> 2, p = lane & 3;
#pragma unroll
      for (int dt = 0; dt < 4; ++dt)
#pragma unroll
          for (int h = 0; h < 2; ++h) { const int r = 4 * g + q + 16 * h, col = 16 * dt + 4 * p; voff[dt][h] = (unsigned)(r * 128 + (((col >> 3) ^ ((r >> 1) & 7)) << 4) + (col & 7) * 2); } }
    const unsigned ring_addr = (unsigned)(uintptr_t)ring;
#define NSA_ISSUE(jb, slot) do { \
        __builtin_amdgcn_global_load_lds((const unsigned*)(Kg + (size_t)(jb) * 4096 + goff), (LAS unsigned*)(ring + (slot) * NSA_SLOT + c.wave * 1024), 16, 0, 0); \
        if (MODE != 1) __builtin_amdgcn_global_load_lds((const unsigned*)(Vg + (size_t)(jb) * 4096 + goff), (LAS unsigned*)(ring + (slot) * NSA_SLOT + 8192 + c.wave * 1024), 16, 0, 0); } while (0)
    VM_WAIT();
    __builtin_amdgcn_s_barrier();
#define NSA_COMPUTE(jb, nth) do { if (bit128(wlo, whi, (jb))) { \
            const LAS unsigned char* Ks = ring + ((nth) % NSA_D) * NSA_SLOT; const unsigned vbase = ring_addr + (unsigned)(((nth) % NSA_D) * NSA_SLOT + 8192); \
            bool full; \
            if (KIND == 0) full = (16 * (64 * (jb) + 63) + 31 <= R.tmin); else if (KIND == 1) full = (64 * (jb) + 63 <= R.tmin); else full = (64 * (jb) + 63 <= R.tmin) && (R.tmax - 64 * (jb) < 512); \
            if (full) nsa_block<MODE, KIND, false>(Ks, vbase, voff, Ps, imp, (jb), lane, R, qf, lrow, lacc, invl, o); \
            else nsa_block<MODE, KIND, true>(Ks, vbase, voff, Ps, imp, (jb), lane, R, qf, lrow, lacc, invl, o); } } while (0)
    int ji = next_bit(mlo, mhi, 0), nissued = 0;
    for (int k = 0; k < 4 && ji >= 0; ++k) { NSA_ISSUE(ji, nissued % NSA_D); ++nissued; ji = next_bit(mlo, mhi, ji + 1); }
    int ja = next_bit(mlo, mhi, 0), ncomp = 0;
    while (ja >= 0) {
        const int jb = next_bit(mlo, mhi, ja + 1);
        const int target = ncomp + (jb >= 0 ? 2 : 1);
        wait_vm_n((nissued - target) * LPB);
        __builtin_amdgcn_s_barrier();
        for (int k = 0; k < 2 && ji >= 0; ++k) { NSA_ISSUE(ji, nissued % NSA_D); ++nissued; ji = next_bit(mlo, mhi, ji + 1); }
        NSA_COMPUTE(ja, ncomp);
        if (jb >= 0) NSA_COMPUTE(jb, ncomp + 1);
        ncomp = target; ja = (jb >= 0) ? next_bit(mlo, mhi, jb + 1) : -1;
    }
#undef NSA_COMPUTE
#undef NSA_ISSUE
    if (MODE == 0) { lrow[0] = lacc[0][0]; lrow[1] = lacc[1][0]; }
}

__device__ __forceinline__ void nsa_unit(const Ctx& c, unsigned char* ws, int b, int g, int qb) {
    const bf16_t* PROJ = (const bf16_t*)(ws + WS_PROJ); const bf16_t* KC = (const bf16_t*)(ws + WS_KC); const bf16_t* KV = (const bf16_t*)(ws + WS_KV); bf16_t* Y = (bf16_t*)(ws + WS_Y);
    const int lane = c.lane, w = c.wave, q0 = 64 * qb;
    NsaRows R; R.ql = (lane & 15) >> 2; R.hg = lane & 3; R.kq = lane >> 4; R.tmin = q0 + 8 * w; R.tmax = R.tmin + 7;
    const int tumax = q0 + 63, hq = 4 * g + R.hg;
    constexpr float QSC = 0.125f * 1.4426950408889634f;
    bf16x8 qf[2][2]; f32x4 o[2][4]; float lrow[2], invl[2]; unsigned glp[2], glq[2];
#pragma unroll
    for (int T = 0; T < 2; ++T) {
        R.t[T] = R.tmin + 4 * T + R.ql; R.selLo[T] = 0ull; R.selHi[T] = 0ull;
        const size_t mrow0 = (size_t)(b * SEQ + R.t[T]) * NPROJ;
#pragma unroll
        for (int ks = 0; ks < 2; ++ks) { const u32x4 v = *(const u32x4*)(PROJ + mrow0 + PC_Q + 64 * hq + 32 * ks + 8 * R.kq);
            u32x4 x; x.x = cvt_pk_bf16(bflo(v.x) * QSC, bfhi(v.x) * QSC); x.y = cvt_pk_bf16(bflo(v.y) * QSC, bfhi(v.y) * QSC);
            x.z = cvt_pk_bf16(bflo(v.z) * QSC, bfhi(v.z) * QSC); x.w = cvt_pk_bf16(bflo(v.w) * QSC, bfhi(v.w) * QSC);
            qf[T][ks] = __builtin_bit_cast(bf16x8, x); }
#pragma unroll
        for (int dt = 0; dt < 4; ++dt) o[T][dt] = (f32x4){0.f, 0.f, 0.f, 0.f};
        lrow[T] = 0.f; invl[T] = 0.f;
        { const bf16_t* gp = PROJ + mrow0 + PC_GL + hq * 3; glp[T] = (unsigned)gp[0] | ((unsigned)gp[1] << 16); glq[T] = (unsigned)gp[2]; }
    }
    LAS float* imp = (LAS float*)(c.lds + NSA_IMP) + w * 8 * 132;
    LAS u64* selm = (LAS u64*)(c.lds + NSA_SELM);
    __syncthreads();
    for (int i = lane; i < 8 * 132; i += 64) imp[i] = 0.f;
    const bf16_t* kc = KC + (size_t)((b * 2 + g) * 512) * 64; const bf16_t* vc = kc + (size_t)2048 * 64;
    const int ncu = (tumax >= 31) ? ((tumax - 31) / 16) / 64 + 1 : 0;
    const int ncw = (R.tmax >= 31) ? ((R.tmax - 31) / 16) / 64 + 1 : 0;
    const u64 cmu = ncu ? (ncu >= 64 ? ~0ull : ((1ull << ncu) - 1ull)) : 0ull, cmw = ncw ? (ncw >= 64 ? ~0ull : ((1ull << ncw) - 1ull)) : 0ull;
    nsa_pass<1, 0>(c, cmu, 0ull, cmw, 0ull, kc, kc, R, qf, lrow, invl, o);
#pragma unroll
    for (int T = 0; T < 2; ++T) { float lt = lrow[T]; lt += __shfl_xor(lt, 16); lt += __shfl_xor(lt, 32); invl[T] = lt > 0.f ? 1.0f / lt : 0.f; }
    nsa_pass<2, 0>(c, cmu, 0ull, cmw, 0ull, kc, vc, R, qf, lrow, invl, o);
#pragma unroll
    for (int T = 0; T < 2; ++T) { const float gt = __builtin_amdgcn_rcpf(1.0f + __expf(-bflo(glp[T])));
        bf16_t* yp = Y + (size_t)(b * SEQ + R.t[T]) * DM + 1024 + 64 * hq + 4 * R.kq;
#pragma unroll
        for (int dt = 0; dt < 4; ++dt) { const f32x4 v = o[T][dt] * gt; u32x2 pk; pk.x = cvt_pk_bf16(v[0], v[1]); pk.y = cvt_pk_bf16(v[2], v[3]); *(u32x2*)(yp + 16 * dt) = pk; o[T][dt] = (f32x4){0.f, 0.f, 0.f, 0.f}; } }
    asm volatile("s_waitcnt lgkmcnt(0)" ::: "memory");
    for (int qi = 0; qi < 2; ++qi) {
        unsigned key[4][2]; bool valid2[4][2];
#pragma unroll
        for (int z = 0; z < 4; ++z) { const int cur = (R.tmin + qi + 2 * z) >> 6;
#pragma unroll
            for (int e = 0; e < 2; ++e) { const int jj = lane + 64 * e; valid2[z][e] = jj <= cur; const bool forced = (jj == 0) || (jj == cur) || (jj == cur - 1);
                const float v = imp[(qi + 2 * z) * 132 + jj] + (forced ? 1000.f : 0.f); key[z][e] = valid2[z][e] ? __float_as_uint(v) + 1u : 0u; } }
        unsigned T[4] = {0u, 0u, 0u, 0u};
        for (int bit = 31; bit >= 0; --bit) {
#pragma unroll
            for (int z = 0; z < 4; ++z) { const unsigned cand = T[z] | (1u << bit);
                const int cnt = __builtin_popcountll(__ballot(key[z][0] >= cand)) + __builtin_popcountll(__ballot(key[z][1] >= cand)); if (cnt >= 16) T[z] = cand; } }
        const u64 below = (1ull << lane) - 1ull;
#pragma unroll
        for (int z = 0; z < 4; ++z) {
            const u64 gt0 = __ballot(key[z][0] > T[z]), gt1 = __ballot(key[z][1] > T[z]), eq0 = __ballot(valid2[z][0] && key[z][0] == T[z]), eq1 = __ballot(valid2[z][1] && key[z][1] == T[z]);
            const int need = 16 - __builtin_popcountll(gt0) - __builtin_popcountll(gt1);
            const int re0 = __builtin_popcountll(eq0 & below), re1 = __builtin_popcountll(eq0) + __builtin_popcountll(eq1 & below);
            const u64 lo = __ballot(valid2[z][0] && (key[z][0] > T[z] || (key[z][0] == T[z] && re0 < need))), hi = __ballot(valid2[z][1] && (key[z][1] > T[z] || (key[z][1] == T[z] && re1 < need)));
            if (lane == 0) { selm[(8 * w + qi + 2 * z) * 2] = lo; selm[(8 * w + qi + 2 * z) * 2 + 1] = hi; } }
    }
    __syncthreads();
    u64 ulo = 0ull, uhi = 0ull, wlo = 0ull, whi = 0ull;
#pragma unroll 8
    for (int q = 0; q < 64; ++q) { const u64 a = selm[2 * q], bb = selm[2 * q + 1]; ulo |= a; uhi |= bb; if ((q >> 3) == w) { wlo |= a; whi |= bb; } }
#pragma unroll
    for (int T = 0; T < 2; ++T) { R.selLo[T] = selm[(8 * w + 4 * T + R.ql) * 2]; R.selHi[T] = selm[(8 * w + 4 * T + R.ql) * 2 + 1]; lrow[T] = 0.f; }
    nsa_pass<0, 1>(c, ulo, uhi, wlo, whi, KV + (size_t)((2 * 2 + b) * 2 + g) * 8192 * 64, KV + (size_t)((3 * 2 + b) * 2 + g) * 8192 * 64, R, qf, lrow, invl, o);
#pragma unroll
    for (int T = 0; T < 2; ++T) { const float lt = lrow[T]; lrow[T] = 0.f;
        const float gt = __builtin_amdgcn_rcpf(1.0f + __expf(-bfhi(glp[T]))); const float sc = lt > 0.f ? gt / lt : 0.f;
        bf16_t* yp = Y + (size_t)(b * SEQ + R.t[T]) * DM + 1024 + 64 * hq + 4 * R.kq;
#pragma unroll
        for (int dt = 0; dt < 4; ++dt) { const f32x4 v = o[T][dt] * sc; const u32x2 y0 = *(const u32x2*)(yp + 16 * dt); u32x2 pk; pk.x = cvt_pk_bf16(bflo(y0.x) + v[0], bfhi(y0.x) + v[1]); pk.y = cvt_pk_bf16(bflo(y0.y) + v[2], bfhi(y0.y) + v[3]);
            *(u32x2*)(yp + 16 * dt) = pk; o[T][dt] = (f32x4){0.f, 0.f, 0.f, 0.f}; } }
    {
        const int jhi = tumax >> 6, jlo = (q0 - 511) > 0 ? ((q0 - 511) >> 6) : 0;
        const int wjhi = R.tmax >> 6, wjlo = (R.tmin - 511) > 0 ? ((R.tmin - 511) >> 6) : 0;
        u64 alo = 0ull, ahi = 0ull, blo = 0ull, bhi = 0ull;
        for (int jj = jlo; jj <= jhi; ++jj) { if (jj < 64) alo |= 1ull << jj; else ahi |= 1ull << (jj - 64); }
        for (int jj = wjlo; jj <= wjhi; ++jj) { if (jj < 64) blo |= 1ull << jj; else bhi |= 1ull << (jj - 64); }
        nsa_pass<0, 2>(c, alo, ahi, blo, bhi, KV + (size_t)((4 * 2 + b) * 2 + g) * 8192 * 64, KV + (size_t)((5 * 2 + b) * 2 + g) * 8192 * 64, R, qf, lrow, invl, o);
#pragma unroll
        for (int T = 0; T < 2; ++T) { const float lt = lrow[T];
            const float gt = __builtin_amdgcn_rcpf(1.0f + __expf(-bflo(glq[T]))); const float sc = lt > 0.f ? gt / lt : 0.f;
            bf16_t* yp = Y + (size_t)(b * SEQ + R.t[T]) * DM + 1024 + 64 * hq + 4 * R.kq;
#pragma unroll
            for (int dt = 0; dt < 4; ++dt) { const f32x4 v = o[T][dt] * sc; const u32x2 y0 = *(const u32x2*)(yp + 16 * dt); u32x2 pk; pk.x = cvt_pk_bf16(bflo(y0.x) + v[0], bfhi(y0.x) + v[1]); pk.y = cvt_pk_bf16(bflo(y0.y) + v[2], bfhi(y0.y) + v[3]);
                *(u32x2*)(yp + 16 * dt) = pk; } }
    }
}

#ifndef PH5_MASK
#define PH5_MASK 31
#endif
#ifndef WGM_IN
#define WGM_IN 4
#endif
#ifndef WGM_GU
#define WGM_GU 4
#endif
#ifndef WGM_N8
#define WGM_N8 2
#endif
#ifndef DUP5A
#define DUP5A 0
#endif
#ifndef DUP5C
#define DUP5C 0
#endif
#ifndef DUP7A
#define DUP7A 0
#endif
#ifndef DUP7B
#define DUP7B 0
#endif
#ifndef DUP_MASK
#define DUP_MASK 0
#endif
#ifndef PH_MASK
#define PH_MASK 0x1fff
#endif
constexpr int NPH = 13;
struct Params { const float* in[31]; float* out; unsigned char* ws; int l_lo, l_hi, p_lo, p_hi; };
enum { I_X = 0, I_F1PRE, I_F1GU, I_F1D, I_F1POST, I_MPRE, I_WIN, I_SCW, I_SCB, I_SDTB, I_SALOG, I_SD, I_SNW, I_KPE, I_KW1, I_KB1, I_KW2, I_VPE, I_VW1, I_VB1, I_VW2,
       I_CW, I_CB, I_CLW, I_CLB, I_WOUT, I_MPOST, I_F2PRE, I_F2GU, I_F2D, I_F2POST };

template <int l>
__device__ __forceinline__ void run_layer(const Ctx& c, const Params& P, const XcdBarrier& bar, unsigned char* ws) {
    bf16_t* U = (bf16_t*)(ws + WS_U); bf16_t* T = (bf16_t*)(ws + WS_T); bf16_t* HID = (bf16_t*)(ws + WS_HID); bf16_t* PROJ = (bf16_t*)(ws + WS_PROJ); bf16_t* Y = (bf16_t*)(ws + WS_Y);
    float* RS = (float*)(ws + WS_RS);
    {
        const int plo = (l == P.l_lo) ? P.p_lo : 0, phi = (l == P.l_hi - 1) ? P.p_hi : NPH;
#define IN(k) (((PH_MASK >> (k)) & 1) && plo <= (k) && (k) < phi)
#define REPS(k) ((((DUP_MASK) >> (k)) & 1) ? 2 : 1)
#define SEAM(k) do { if (!(l == P.l_hi - 1 && (k) == P.p_hi - 1)) xcd_barrier(bar); } while (0)
        if (IN(0) && l == 0) _Pragma("unroll") for (int rep = 0; rep < REPS(0); ++rep) {
            LayerW LW; LW.gu1 = P.in[I_F1GU] + (size_t)l * DM * 2 * DFF; LW.d1 = P.in[I_F1D] + (size_t)l * DFF * DM; LW.gu2 = P.in[I_F2GU] + (size_t)l * DM * 2 * DFF; LW.d2 = P.in[I_F2D] + (size_t)l * DFF * DM;
            LW.win = P.in[I_WIN] + (size_t)l * DM * DIN; LW.wout = P.in[I_WOUT] + (size_t)l * DM * DM; LW.w1k = P.in[I_KW1] + (size_t)l * 2048 * 256; LW.w1v = P.in[I_VW1] + (size_t)l * 2048 * 256;
            LW.kpe = P.in[I_KPE] + (size_t)l * 2048; LW.vpe = P.in[I_VPE] + (size_t)l * 2048; LW.pre1 = P.in[I_F1PRE] + l * DM; LW.prem = P.in[I_MPRE] + l * DM; LW.pre2 = P.in[I_F2PRE] + l * DM;
            phase_convert(c, LW, ws);
            if (l == 0) {
                phase_norm(c, P.in[I_X], nullptr, 0.f, nullptr, U, RS, nullptr);
                for (int i = c.bid * NTHR + c.tid; i < 65536; i += c.G * NTHR) ((u32x4*)(ws + WS_KV + 6 * 4 * 8192 * 64 * 2))[i] = (u32x4){0u, 0u, 0u, 0u};
            }
            SEAM(0);
        }
        if (IN(1)) _Pragma("unroll") for (int rep = 0; rep < REPS(1); ++rep) {
            pg8::Gemm g{U, (const bf16_t*)(ws + WS_WGU1), M, 2 * DFF, DM, DM, 128, 0}; pg8::StaticOrder S; S.init(M, 2 * DFF, c.G, c.bid, WGM_GU);
            pg8::EpiSwiglu E{HID, DFF, RS};
            pg8::gemm_phase<pg8::EpiSwiglu, pg8::StaticOrder, true, true>(c.lds, g, S, E);
            SEAM(1);
        }
        if (IN(2)) _Pragma("unroll") for (int rep = 0; rep < REPS(2); ++rep) {
            pg8::Gemm g{HID, (const bf16_t*)(ws + WS_WD1), M, DM, DFF, DFF, 128, 0}; pg8::StaticOrder S; S.init(M, DM, c.G, c.bid, WGM_N8);
            pg8::EpiStore E{T, DM};
            pg8::gemm_phase<pg8::EpiStore, pg8::StaticOrder, true, true>(c.lds, g, S, E);
            SEAM(2);
        }
        if (IN(3)) { phase_norm(c, nullptr, T, 0.5f, P.in[I_F1POST] + l * DM, U, RS, nullptr); SEAM(3); }
        if (IN(4)) _Pragma("unroll") for (int rep = 0; rep < REPS(4); ++rep) {
            pg8::Gemm g{U, (const bf16_t*)(ws + WS_WIN), M, NPROJ, DM, DM, 128, 0}; pg8::StaticOrder S; S.init(M, NPROJ, c.G, c.bid, WGM_IN);
            pg8::EpiProj E{PROJ, NPROJ, (bf16_t*)(ws + WS_KV), RS};
            pg8::gemm_phase<pg8::EpiProj, pg8::StaticOrder, true, true>(c.lds, g, S, E);
            SEAM(4);
        }
        SsdW SW; SW.conv_w = P.in[I_SCW] + (size_t)l * 4 * 1536; SW.conv_b = P.in[I_SCB] + l * 1536; SW.dt_bias = P.in[I_SDTB] + l * 16; SW.a_log = P.in[I_SALOG] + l * 16; SW.dskip = P.in[I_SD] + l * 16; SW.norm_w = P.in[I_SNW] + l * 1024;
        if (IN(5)) _Pragma("unroll") for (int rep = 0; rep < REPS(5); ++rep) {
            if (PH5_MASK & 1) for (int u = c.bid; u < 256 * (1 + DUP5A); u += c.G) ssd_a_unit(c, SW, ws, u & 255);
            if ((PH5_MASK & 2) && c.bid < 16) { const int cu = c.bid;
                const int kv = cu >> 3, pm = cu & 7;
                __syncthreads();
                pg8::Gemm g{(const bf16_t*)(ws + WS_KV) + (size_t)kv * 4 * 8192 * 64, (const bf16_t*)(ws + WS_W1) + (size_t)kv * 256 * DM, 2048, 256, 2048, 1024, 128, 0};
                pg8::OneUnit S; S.u0.pm = pm; S.u0.pn = 0;
                bf16_t* H1 = (bf16_t*)(ws + WS_H1) + (size_t)kv * 2048 * 256;
                LAS float* biasS = (LAS float*)(c.lds + 131072);
                if (c.tid < 256) { const float* b1 = (kv ? P.in[I_VB1] : P.in[I_KB1]) + l * 256; const float* pep = (const float*)(ws + WS_PEP) + kv * 256 * 256;
                    float sb = b1[c.tid];
#pragma unroll 8
                    for (int q = 0; q < 256; ++q) sb += pep[q * 256 + c.tid];
                    biasS[c.tid] = sb; }
                __syncthreads();
                pg8::EpiBiasSilu E{H1, 256, biasS};
                pg8::gemm_phase<pg8::EpiBiasSilu, pg8::OneUnit, false, true>(c.lds, g, S, E);
                nsa_cmp2(c, (kv ? P.in[I_VW2] : P.in[I_KW2]) + (size_t)l * 256 * 64, H1, (bf16_t*)(ws + WS_KC) + (size_t)kv * 2048 * 64, pm);
            }
            CnvW CW; CW.dw_w = P.in[I_CW] + (size_t)l * 31 * 512; CW.dw_b = P.in[I_CB] + l * 512; CW.ln_w = P.in[I_CLW] + l * 512; CW.ln_b = P.in[I_CLB] + l * 512;
            if (PH5_MASK & 4) { if (c.G > 32) { if (c.bid >= 16) for (int u = c.bid - 16; u < 512 * (1 + DUP5C); u += c.G - 16) cnv_unit(c, CW, ws, u & 511); }
            else for (int u = c.bid; u < 512; u += c.G) cnv_unit(c, CW, ws, u); }
            SEAM(5);
        }
        if (IN(6)) _Pragma("unroll") for (int rep = 0; rep < REPS(6); ++rep) { phase_ssd_scan(c, ws); SEAM(6); }
        if (IN(7)) _Pragma("unroll") for (int rep = 0; rep < REPS(7); ++rep) {
            if (PH5_MASK & 8) for (int u = c.bid; u < 256 * (1 + DUP7A); u += c.G) ssd_b_unit(c, SW, ws, u & 255);
            if (PH5_MASK & 16) for (int v0 = c.bid; v0 < 256 * (1 + DUP7B); v0 += c.G) { const int v = v0 & 255;
                const int bg = v & 3, jq = v >> 2;
                for (int e = 0; e < 2; ++e) { const int qb = (e == 0) ? 127 - jq : jq; nsa_unit(c, ws, bg >> 1, bg & 1, qb); }
            }
            SEAM(7);
        }
        if (IN(8)) _Pragma("unroll") for (int rep = 0; rep < REPS(8); ++rep) {
            pg8::Gemm g{Y, (const bf16_t*)(ws + WS_WOUT), M, DM, DM, DM, 128, 0}; pg8::StaticOrder S; S.init(M, DM, c.G, c.bid, WGM_N8);
            pg8::EpiStore E{T, DM};
            pg8::gemm_phase<pg8::EpiStore, pg8::StaticOrder, true, true>(c.lds, g, S, E);
            SEAM(8);
        }
        if (IN(9)) { phase_norm(c, nullptr, T, 1.0f, P.in[I_MPOST] + l * DM, U, RS, nullptr); SEAM(9); }
        if (IN(10)) _Pragma("unroll") for (int rep = 0; rep < REPS(10); ++rep) {
            pg8::Gemm g{U, (const bf16_t*)(ws + WS_WGU2), M, 2 * DFF, DM, DM, 128, 0}; pg8::StaticOrder S; S.init(M, 2 * DFF, c.G, c.bid, WGM_GU);
            pg8::EpiSwiglu E{HID, DFF, RS};
            pg8::gemm_phase<pg8::EpiSwiglu, pg8::StaticOrder, true, true>(c.lds, g, S, E);
            SEAM(10);
        }
        if (IN(11)) _Pragma("unroll") for (int rep = 0; rep < REPS(11); ++rep) {
            pg8::Gemm g{HID, (const bf16_t*)(ws + WS_WD2), M, DM, DFF, DFF, 128, 0}; pg8::StaticOrder S; S.init(M, DM, c.G, c.bid, WGM_N8);
            pg8::EpiStore E{T, DM};
            pg8::gemm_phase<pg8::EpiStore, pg8::StaticOrder, true, true>(c.lds, g, S, E);
            SEAM(11);
        }
        if (IN(12)) {
            phase_norm(c, nullptr, T, 0.5f, P.in[I_F2POST] + l * DM, U, RS, (l + 1 < DEPTH) ? nullptr : P.out);
            if (l + 1 < DEPTH) {
                const int n = l + 1;
                LayerW LW; LW.gu1 = P.in[I_F1GU] + (size_t)n * DM * 2 * DFF; LW.d1 = P.in[I_F1D] + (size_t)n * DFF * DM; LW.gu2 = P.in[I_F2GU] + (size_t)n * DM * 2 * DFF; LW.d2 = P.in[I_F2D] + (size_t)n * DFF * DM;
                LW.win = P.in[I_WIN] + (size_t)n * DM * DIN; LW.wout = P.in[I_WOUT] + (size_t)n * DM * DM; LW.w1k = P.in[I_KW1] + (size_t)n * 2048 * 256; LW.w1v = P.in[I_VW1] + (size_t)n * 2048 * 256;
                LW.kpe = P.in[I_KPE] + (size_t)n * 2048; LW.vpe = P.in[I_VPE] + (size_t)n * 2048; LW.pre1 = P.in[I_F1PRE] + n * DM; LW.prem = P.in[I_MPRE] + n * DM; LW.pre2 = P.in[I_F2PRE] + n * DM;
                phase_convert(c, LW, ws);
            }
            SEAM(12);
        }
#undef IN
#undef SEAM
    }
}

__global__ void __launch_bounds__(NTHR, 2) mega_fwd(Params P) {
    extern __shared__ __attribute__((aligned(16))) unsigned char lds_raw[];
    Ctx c; c.lds = (LAS unsigned char*)lds_raw; c.tid = threadIdx.x; c.lane = c.tid & 63; c.wave = __builtin_amdgcn_readfirstlane(c.tid >> 6); c.G = gridDim.x; c.bid = blockIdx.x;
    unsigned char* ws = P.ws;
    volatile LAS unsigned* MISC = (volatile LAS unsigned*)(c.lds + LDS_CTL_OFF);
    if (c.tid < 32) MISC[c.tid] = 0u;
    __syncthreads();
    const bool multi = !((P.l_hi - P.l_lo) == 1 && (P.p_hi - P.p_lo) == 1);
    XcdBarrier bar; bar.bar = (unsigned*)(ws + WS_CTL) + 4096; bar.x = 0; bar.st = MISC + 8;
    if (multi) bar = xcd_barrier_post((unsigned*)(ws + WS_CTL) + 4096, MISC + 8);

    if (0 >= P.l_lo && 0 < P.l_hi) run_layer<0>(c, P, bar, ws);
    if (1 >= P.l_lo && 1 < P.l_hi) run_layer<1>(c, P, bar, ws);
    if (2 >= P.l_lo && 2 < P.l_hi) run_layer<2>(c, P, bar, ws);
    if (3 >= P.l_lo && 3 < P.l_hi) run_layer<3>(c, P, bar, ws);
}

extern "C" void kernel_launch(void* const* d_in, const int* in_sizes, int n_in, void* d_out, int out_size, void* d_ws, size_t ws_size, hipStream_t stream) {
    static int grid = 0;
    if (grid == 0) {
        if (n_in != 31 || in_sizes[0] != M * DM || out_size != M * DM || ws_size < WS_END) { fprintf(stderr, "kernel_launch: unexpected shapes (n_in %d, in0 %d, out %d, ws %zu); nothing launched\n", n_in, n_in > 0 ? in_sizes[0] : -1, out_size, ws_size); grid = -1; return; }
        int dev = 0, cus = 0, per_cu = 0;
        if (hipGetDevice(&dev) != hipSuccess || hipDeviceGetAttribute(&cus, hipDeviceAttributeMultiprocessorCount, dev) != hipSuccess) { grid = -1; return; }
        if (hipFuncSetAttribute((const void*)mega_fwd, hipFuncAttributeMaxDynamicSharedMemorySize, LDS_BYTES) != hipSuccess) { fprintf(stderr, "kernel_launch: hipFuncSetAttribute failed\n"); grid = -1; return; }
        if (hipOccupancyMaxActiveBlocksPerMultiprocessor(&per_cu, (const void*)mega_fwd, NTHR, LDS_BYTES) != hipSuccess || per_cu < 1) { fprintf(stderr, "kernel_launch: occupancy query says %d\n", per_cu); per_cu = 1; }
        (void)hipGetLastError();
        grid = cus;
    }
    if (grid < 0) return;
    if (hipMemsetAsync((char*)d_ws + WS_CTL, 0, CTL_ZERO_BYTES, stream) != hipSuccess) return;
    Params p{};
    for (int i = 0; i < 31; ++i) p.in[i] = (const float*)d_in[i];
    p.out = (float*)d_out; p.ws = (unsigned char*)d_ws;
#if MK_PER_PHASE
    for (int l = 0; l < DEPTH; ++l)
        for (int k = 0; k < NPH; ++k) { p.l_lo = l; p.l_hi = l + 1; p.p_lo = k; p.p_hi = k + 1; hipLaunchKernelGGL(mega_fwd, dim3(grid), dim3(NTHR), LDS_BYTES, stream, p); }
#else
    p.l_lo = 0; p.l_hi = DEPTH; p.p_lo = 0; p.p_hi = NPH;
    hipLaunchKernelGGL(mega_fwd, dim3(grid), dim3(NTHR), LDS_BYTES, stream, p);
#endif
}
```

```cpp
#include <hip/hip_runtime.h>
#include <cstdio>
#include <cstdint>
#include <cmath>

#ifndef MK_PER_PHASE
#define MK_PER_PHASE 0
#endif

#define LAS __attribute__((address_space(3)))
#define GAS __attribute__((address_space(1)))

namespace pg8 {
#define PG8_LAS __attribute__((address_space(3)))
typedef unsigned short bf16_t;
typedef short bf16x8 __attribute__((ext_vector_type(8)));
typedef float f32x4 __attribute__((ext_vector_type(4)));
typedef unsigned u32x4 __attribute__((ext_vector_type(4)));
constexpr int BM = 256, BK = 64, HALF = 128, HTB = HALF * BK * 2  , STAGE_BYTES = 8 * HTB, NXCD = 8, WGM = 4;

__host__ __device__ __forceinline__ int lds_byte(int r, int c) { const int st = (r >> 4) * 2 + (c >> 5), rr = r & 15, cc = c & 31, ob = rr * 64 + cc * 2; return st * 1024 + (ob ^ (((ob >> 9) & 1) << 5)); }
__host__ __device__ __forceinline__ void stage_rc(int b, int& R, int& C) { const int st = b / 1024, sb = b % 1024, swz = sb ^ (((sb >> 9) & 1) << 5); R = (st >> 1) * 16 + swz / 64; C = (st & 1) * 32 + (swz % 64) / 2; }
__host__ __device__ __forceinline__ int perm32(int rho) { const int n = rho >> 4, i = rho & 15; return 8 * (i >> 2) + 4 * n + (i & 3); }

struct Unit { int pm, pn; };

struct StaticOrder {
    int nM, nN, nwg, G, c, wgm;
    __host__ __device__ void init(int M, int N, int G_, int c_, int wgm_ = WGM) { nM = M / BM; nN = N / BM; nwg = nM * nN; G = G_; c = c_; wgm = wgm_; }
    __host__ __device__ bool next(int i, Unit& u) const {
        const long L = (long)i * G + c; if (L >= nwg) return false;
        int wgid = (int)L; { const int q = nwg / NXCD, r = nwg % NXCD, xcd = wgid % NXCD, off = wgid / NXCD; wgid = (xcd < r ? xcd * (q + 1) : r * (q + 1) + (xcd - r) * q) + off; }
        const int nig = wgm * nN, gid = wgid / nig, fm = gid * wgm, gsz = (nM - fm) < wgm ? (nM - fm) : wgm;
        u.pm = fm + ((wgid % nig) % gsz); u.pn = (wgid % nig) / gsz; return true;
    }
    __device__ __forceinline__ void a_ready(const Unit&) const {}
    __device__ __forceinline__ void done(const Unit&) const {}
};


struct Gemm { const bf16_t* A; const bf16_t* Bt; int M, N, K; int lda; int kstepA; int amode;
    __device__ __forceinline__ size_t abase(int pm) const {
        if (amode == 0) return (size_t)pm * BM * (size_t)lda * 2;
        return ((size_t)((pm >> 2) * 8192 + (pm & 1) * 4096) * 5120 + (size_t)((pm >> 1) & 1) * 64) * 2;
    }
};
struct OneUnit {
    Unit u0;
    __device__ __forceinline__ bool next(int i, Unit& u) const { if (i != 0) return false; u = u0; return true; }
    __device__ __forceinline__ void a_ready(const Unit&) const {}
    __device__ __forceinline__ void done(const Unit&) const {}
};

typedef float f32x2_t __attribute__((ext_vector_type(2))); typedef __bf16 bf16x2_t __attribute__((ext_vector_type(2)));
__device__ __forceinline__ unsigned cvt_pk_bf16(float lo, float hi) { const f32x2_t v = {lo, hi}; const bf16x2_t b = __builtin_convertvector(v, bf16x2_t); return __builtin_bit_cast(unsigned, b); }
__device__ __forceinline__ float silu_f(float x) { return x * __builtin_amdgcn_rcpf(1.0f + __expf(-x)); }

struct EpiStore {
    static constexpr bool PERM = true, AFTER_DRAIN = false, ROWSCALE = false;
    bf16_t* O; int ldc;
    __device__ __forceinline__ void operator()(const f32x4 (&acc)[2][2][4][2], const Unit& u, int wr, int wc, int fr, int fq, const PG8_LAS float* rsl) const {
        const int row0 = u.pm * BM + wr * 64 + fr, col0 = u.pn * BM + wc * 32 + 8 * fq;
#pragma unroll
        for (int ai = 0; ai < 2; ++ai)
#pragma unroll
            for (int m = 0; m < 4; ++m) { bf16_t* rowp = O + (size_t)(row0 + ai * HALF + m * 16) * ldc + col0;
#pragma unroll
                for (int bj = 0; bj < 2; ++bj) { const f32x4 v0 = acc[ai][bj][m][0], v1 = acc[ai][bj][m][1];
                    u32x4 w; w.x = cvt_pk_bf16(v0[0], v0[1]); w.y = cvt_pk_bf16(v0[2], v0[3]); w.z = cvt_pk_bf16(v1[0], v1[1]); w.w = cvt_pk_bf16(v1[2], v1[3]);
                    *(u32x4*)(rowp + bj * HALF) = w; } }
    }
};
struct EpiProj {
    static constexpr bool PERM = true, AFTER_DRAIN = false, ROWSCALE = true;
    bf16_t* O; int ldc; bf16_t* KV; const float* rs;
    __device__ __forceinline__ void operator()(const f32x4 (&acc)[2][2][4][2], const Unit& u, int wr, int wc, int fr, int fq, const PG8_LAS float* rsl) const {
        const bool kvt = (u.pn >= 16 && u.pn <= 18);
        const int pitch = kvt ? 64 : ldc;
        const int rloc = (kvt ? ((u.pm * BM) & 8191) : u.pm * BM) + wr * 64 + fr;
        bf16_t* base[2];
#pragma unroll
        for (int bj = 0; bj < 2; ++bj)
            base[bj] = kvt ? KV + (size_t)((((u.pn - 16) * 2 + bj) * 2 + ((u.pm * BM) >> 13)) * 2 + (wc >> 1)) * 8192 * 64 + (wc & 1) * 32 + 8 * fq
                           : O + u.pn * BM + bj * HALF + wc * 32 + 8 * fq;
#pragma unroll
        for (int ai = 0; ai < 2; ++ai)
#pragma unroll
            for (int m = 0; m < 4; ++m) { const size_t roff = (size_t)(rloc + ai * HALF + m * 16) * pitch; const float r = rsl[wr * 64 + fr + ai * HALF + m * 16];
#pragma unroll
                for (int bj = 0; bj < 2; ++bj) { const f32x4 v0 = acc[ai][bj][m][0] * r, v1 = acc[ai][bj][m][1] * r;
                    u32x4 w; w.x = cvt_pk_bf16(v0[0], v0[1]); w.y = cvt_pk_bf16(v0[2], v0[3]); w.z = cvt_pk_bf16(v1[0], v1[1]); w.w = cvt_pk_bf16(v1[2], v1[3]);
                    *(u32x4*)(base[bj] + roff) = w; } }
    }
};
struct EpiSwiglu {
    static constexpr bool PERM = true, AFTER_DRAIN = false, ROWSCALE = true;
    bf16_t* O; int ldc; const float* rs;
    __device__ __forceinline__ void operator()(const f32x4 (&acc)[2][2][4][2], const Unit& u, int wr, int wc, int fr, int fq, const PG8_LAS float* rsl) const {
        const int row0 = u.pm * BM + wr * 64 + fr, col0 = u.pn * HALF + wc * 32 + 8 * fq;
#pragma unroll
        for (int ai = 0; ai < 2; ++ai)
#pragma unroll
            for (int m = 0; m < 4; ++m) { bf16_t* rowp = O + (size_t)(row0 + ai * HALF + m * 16) * ldc + col0; const float r = rsl[wr * 64 + fr + ai * HALF + m * 16];
                const f32x4 g0 = acc[ai][0][m][0] * r, g1 = acc[ai][0][m][1] * r, v0 = acc[ai][1][m][0] * r, v1 = acc[ai][1][m][1] * r;
                u32x4 w;
                w.x = cvt_pk_bf16(silu_f(g0[0]) * v0[0], silu_f(g0[1]) * v0[1]); w.y = cvt_pk_bf16(silu_f(g0[2]) * v0[2], silu_f(g0[3]) * v0[3]);
                w.z = cvt_pk_bf16(silu_f(g1[0]) * v1[0], silu_f(g1[1]) * v1[1]); w.w = cvt_pk_bf16(silu_f(g1[2]) * v1[2], silu_f(g1[3]) * v1[3]);
                *(u32x4*)rowp = w; }
    }
};
struct EpiBiasSilu {
    static constexpr bool PERM = true, AFTER_DRAIN = false, ROWSCALE = false;
    bf16_t* O; int ldc; const PG8_LAS float* bias;
    __device__ __forceinline__ void operator()(const f32x4 (&acc)[2][2][4][2], const Unit& u, int wr, int wc, int fr, int fq, const PG8_LAS float* rsl) const {
        const int row0 = u.pm * BM + wr * 64 + fr, col0 = u.pn * BM + wc * 32 + 8 * fq;
#pragma unroll
        for (int bj = 0; bj < 2; ++bj) {
            const f32x4 b0 = *(const PG8_LAS f32x4*)(bias + col0 + bj * HALF), b1 = *(const PG8_LAS f32x4*)(bias + col0 + bj * HALF + 4);
#pragma unroll
            for (int ai = 0; ai < 2; ++ai)
#pragma unroll
                for (int m = 0; m < 4; ++m) { bf16_t* rowp = O + (size_t)(row0 + ai * HALF + m * 16) * ldc + col0 + bj * HALF;
                    const f32x4 v0 = acc[ai][bj][m][0] + b0, v1 = acc[ai][bj][m][1] + b1;
                    u32x4 w; w.x = cvt_pk_bf16(silu_f(v0[0]), silu_f(v0[1])); w.y = cvt_pk_bf16(silu_f(v0[2]), silu_f(v0[3]));
                    w.z = cvt_pk_bf16(silu_f(v1[0]), silu_f(v1[1])); w.w = cvt_pk_bf16(silu_f(v1[2]), silu_f(v1[3]));
                    *(u32x4*)rowp = w; }
        }
    }
};

template <class Epi, class Sched, bool ALIGN_EPI = false, bool SP2 = false>
__device__ __forceinline__ void gemm_phase(PG8_LAS unsigned char* lds, const Gemm g, const Sched& S, const Epi& E) {
    const int tid = threadIdx.x, wid = __builtin_amdgcn_readfirstlane(tid >> 6), lane = tid & 63, wr = wid >> 2, wc = wid & 3, fr = lane & 15, fq = lane >> 4;
    const int K = g.K, nt = K / BK;
    unsigned voffA[2], voffB[2];
#pragma unroll
    for (int i = 0; i < 2; ++i) { int R, C; stage_rc(tid * 16 + i * 8192, R, C); const int Rb = Epi::PERM ? ((R & ~31) + perm32(R & 31)) : R;
        voffA[i] = (unsigned)(R * g.lda + C) * 2u; voffB[i] = (unsigned)(Rb * K + C) * 2u; }
    const size_t kstepB = (size_t)(BK * 2), kstepA = (size_t)g.kstepA;
    const size_t hstepB = (size_t)HALF * K * 2, hstepA = (size_t)HALF * g.lda * 2;
    const size_t tstepB = 2 * hstepB;
    const unsigned ldsw = (unsigned)wid * 1024u;
    const int aoff = lds_byte(wr * 64 + fr, fq * 8), boff = lds_byte(wc * 32 + fr, fq * 8);
#define PG8_SA(b, h) (((b) * 2 + (h)) * HTB)
#define PG8_RSL (8 * HTB + 1024)
#define PG8_SB(b, h) ((4 + (b) * 2 + (h)) * HTB)
#define PG8_STAGE(bufoff, gbase, voff) do { _Pragma("unroll") for (int _i = 0; _i < 2; ++_i) \
        __builtin_amdgcn_global_load_lds((const unsigned*)((const char*)(gbase) + (voff)[_i]), (PG8_LAS unsigned*)(lds + (bufoff) + ldsw + _i * 8192), 16, 0, 0); } while (0)
#define PG8_LDA(dst, b, h) do { _Pragma("unroll") for (int m = 0; m < 4; ++m) _Pragma("unroll") for (int k = 0; k < 2; ++k) dst[m][k] = *(const PG8_LAS bf16x8*)(lds + PG8_SA(b, h) + aoff + m * 2048 + k * 1024); } while (0)
#define PG8_LDB(dst, b, h) do { _Pragma("unroll") for (int n = 0; n < 2; ++n) _Pragma("unroll") for (int k = 0; k < 2; ++k) dst[n][k] = *(const PG8_LAS bf16x8*)(lds + PG8_SB(b, h) + boff + n * 2048 + k * 1024); } while (0)
#define PG8_MMA(ai, bj, At, Bt) do { __builtin_amdgcn_s_setprio(1); _Pragma("unroll") for (int m = 0; m < 4; ++m) _Pragma("unroll") for (int n = 0; n < 2; ++n) _Pragma("unroll") for (int k = 0; k < 2; ++k) \
        acc[ai][bj][m][n] = __builtin_amdgcn_mfma_f32_16x16x32_bf16(Bt[n][k], At[m][k], acc[ai][bj][m][n], 0, 0, 0); __builtin_amdgcn_s_setprio(0); } while (0)
#define PG8_WAIT_V(n) asm volatile("s_waitcnt vmcnt(" #n ")" ::: "memory")
#define PG8_WAIT_L(n) asm volatile("s_waitcnt lgkmcnt(" #n ")" ::: "memory")
#define PG8_BAR __builtin_amdgcn_s_barrier()
#define PG8_SCHED __builtin_amdgcn_sched_barrier(0)
    Unit cur, nxt; int ui = 0;
    if (!S.next(0, cur)) return;
    f32x4 acc[2][2][4][2];
#pragma unroll
    for (int a = 0; a < 2; ++a)
#pragma unroll
        for (int b = 0; b < 2; ++b)
#pragma unroll
            for (int m = 0; m < 4; ++m)
#pragma unroll
                for (int n = 0; n < 2; ++n) acc[a][b][m][n] = (f32x4){0.f, 0.f, 0.f, 0.f};
    bf16x8 At[4][2], B0[2][2], B1[2][2];
    const char* cA = (const char*)g.A + g.abase(cur.pm); const char* cB = (const char*)g.Bt + (size_t)cur.pn * tstepB;
    S.a_ready(cur);
    if constexpr (SP2) {
        PG8_STAGE(PG8_SB(0, 0), cB, voffB); PG8_STAGE(PG8_SB(0, 1), cB + hstepB, voffB); PG8_STAGE(PG8_SA(0, 0), cA, voffA); PG8_STAGE(PG8_SA(0, 1), cA + hstepA, voffA);
        if (wr == 1) PG8_BAR;
        PG8_WAIT_V(2); PG8_BAR;
        PG8_STAGE(PG8_SB(1, 0), cB + kstepB, voffB); PG8_STAGE(PG8_SA(1, 0), cA + kstepA, voffA); PG8_STAGE(PG8_SB(1, 1), cB + hstepB + kstepB, voffB);
        PG8_WAIT_V(6); PG8_BAR;
    } else {
        PG8_STAGE(PG8_SB(0, 0), cB, voffB); PG8_STAGE(PG8_SA(0, 0), cA, voffA); PG8_STAGE(PG8_SB(0, 1), cB + hstepB, voffB); PG8_STAGE(PG8_SA(0, 1), cA + hstepA, voffA);
        if (wr == 1) PG8_BAR;
        PG8_WAIT_V(4); PG8_BAR;
        PG8_STAGE(PG8_SB(1, 0), cB + kstepB, voffB); PG8_STAGE(PG8_SA(1, 0), cA + kstepA, voffA); PG8_STAGE(PG8_SB(1, 1), cB + hstepB + kstepB, voffB);
        PG8_WAIT_V(6); PG8_BAR;
    }
    for (;;) {
        const bool has_next = S.next(ui + 1, nxt);
        const char* nA = has_next ? (const char*)g.A + g.abase(nxt.pm) : cA + (size_t)(nt - 2) * kstepA; const char* nB = has_next ? (const char*)g.Bt + (size_t)nxt.pn * tstepB : cB + (size_t)(nt - 2) * kstepB;
        if constexpr (Epi::ROWSCALE) { if (wid < 4) __builtin_amdgcn_global_load_lds((const unsigned*)(E.rs + cur.pm * BM + wid * 64 + lane), (PG8_LAS unsigned*)(lds + PG8_RSL + (ui & 1) * 1024 + wid * 256), 4, 0, 0); }
        for (int t = 0; t < nt; t += 2) {
            const bool last = (t == nt - 2);
            const char* a1 = cA + (size_t)(t + 1) * kstepA;
            const char* a2 = last ? nA : cA + (size_t)(t + 2) * kstepA; const char* b2 = last ? nB : cB + (size_t)(t + 2) * kstepB;
            const char* a3 = a2 + kstepA; const char* b3 = b2 + kstepB;
            if (last && has_next) S.a_ready(nxt);
            if constexpr (SP2) {
            PG8_LDB(B0, 0, 0); PG8_LDB(B1, 0, 1); PG8_SCHED; PG8_LDA(At, 0, 0); PG8_STAGE(PG8_SA(1, 1), a1 + hstepA, voffA);
            PG8_WAIT_V(8); PG8_WAIT_L(0); PG8_BAR; PG8_MMA(0, 0, At, B0); PG8_MMA(0, 1, At, B1); PG8_BAR; PG8_SCHED;
            PG8_LDA(At, 0, 1); PG8_STAGE(PG8_SB(0, 0), b2, voffB); PG8_STAGE(PG8_SB(0, 1), b2 + hstepB, voffB); PG8_STAGE(PG8_SA(0, 0), a2, voffA);
            PG8_WAIT_V(8); PG8_WAIT_L(0); PG8_BAR; PG8_MMA(1, 0, At, B0); PG8_MMA(1, 1, At, B1); PG8_BAR; PG8_SCHED;
            PG8_LDB(B0, 1, 0); PG8_LDB(B1, 1, 1); PG8_SCHED; PG8_LDA(At, 1, 0); PG8_STAGE(PG8_SA(0, 1), a2 + hstepA, voffA);
            PG8_WAIT_V(8); PG8_WAIT_L(0); PG8_BAR; PG8_MMA(0, 0, At, B0); PG8_MMA(0, 1, At, B1); PG8_BAR; PG8_SCHED;
            PG8_LDA(At, 1, 1); PG8_STAGE(PG8_SB(1, 0), b3, voffB); PG8_STAGE(PG8_SB(1, 1), b3 + hstepB, voffB); PG8_STAGE(PG8_SA(1, 0), a3, voffA);
            PG8_WAIT_V(8); PG8_WAIT_L(0); PG8_BAR; PG8_MMA(1, 0, At, B0); PG8_MMA(1, 1, At, B1); PG8_BAR; PG8_SCHED;
            } else {
            PG8_LDB(B0, 0, 0); PG8_SCHED; PG8_LDA(At, 0, 0); PG8_STAGE(PG8_SA(1, 1), a1 + hstepA, voffA);
            PG8_WAIT_L(8); PG8_BAR; PG8_WAIT_L(0); PG8_MMA(0, 0, At, B0); PG8_BAR; PG8_SCHED;
            PG8_LDB(B1, 0, 1); PG8_STAGE(PG8_SB(0, 0), b2, voffB);
            PG8_BAR; PG8_WAIT_L(0); PG8_MMA(0, 1, At, B1); PG8_BAR;
            PG8_LDA(At, 0, 1); PG8_STAGE(PG8_SA(0, 0), a2, voffA);
            PG8_BAR; PG8_WAIT_L(0); PG8_MMA(1, 0, At, B0); PG8_BAR; PG8_SCHED;
            PG8_STAGE(PG8_SB(0, 1), b2 + hstepB, voffB);
            PG8_WAIT_V(6); PG8_BAR; PG8_MMA(1, 1, At, B1); PG8_BAR;
            PG8_LDB(B0, 1, 0); PG8_SCHED; PG8_LDA(At, 1, 0); PG8_STAGE(PG8_SA(0, 1), a2 + hstepA, voffA);
            PG8_WAIT_L(8); PG8_BAR; PG8_WAIT_L(0); PG8_MMA(0, 0, At, B0); PG8_BAR; PG8_SCHED;
            PG8_LDB(B1, 1, 1); PG8_STAGE(PG8_SB(1, 0), b3, voffB);
            PG8_BAR; PG8_WAIT_L(0); PG8_MMA(0, 1, At, B1); PG8_BAR;
            PG8_LDA(At, 1, 1); PG8_STAGE(PG8_SA(1, 0), a3, voffA);
            PG8_BAR; PG8_WAIT_L(0); PG8_MMA(1, 0, At, B0); PG8_BAR; PG8_SCHED;
            PG8_STAGE(PG8_SB(1, 1), b3 + hstepB, voffB);
            PG8_WAIT_V(6); PG8_BAR; PG8_MMA(1, 1, At, B1); PG8_BAR;
            }
        }
        if constexpr (ALIGN_EPI) { if (wr == 0) PG8_BAR; }
        if constexpr (!Epi::AFTER_DRAIN) { E(acc, cur, wr, wc, fr, fq, (const PG8_LAS float*)(lds + PG8_RSL + (ui & 1) * 1024)); S.done(cur); }
        if (!has_next) break;
#pragma unroll
        for (int a = 0; a < 2; ++a)
#pragma unroll
            for (int b = 0; b < 2; ++b)
#pragma unroll
                for (int m = 0; m < 4; ++m)
#pragma unroll
                    for (int n = 0; n < 2; ++n) acc[a][b][m][n] = (f32x4){0.f, 0.f, 0.f, 0.f};
        cur = nxt; cA = nA; cB = nB; ++ui;
        if constexpr (ALIGN_EPI) { if (wr == 1) PG8_BAR; }
    }
    PG8_WAIT_V(0);
    if constexpr (!ALIGN_EPI) { if (wr == 0) PG8_BAR; }
    PG8_BAR;
    if constexpr (Epi::AFTER_DRAIN) { E.fused(acc, cur, wr, wc, fr, fq, lds, wid, lane); S.done(cur); }
#undef PG8_SA
#undef PG8_RSL
#undef PG8_SB
#undef PG8_STAGE
#undef PG8_LDA
#undef PG8_LDB
#undef PG8_MMA
#undef PG8_WAIT_V
#undef PG8_WAIT_L
#undef PG8_BAR
#undef PG8_SCHED
}
}


using pg8::bf16_t; using pg8::bf16x8; using pg8::f32x4; using pg8::u32x4; using pg8::cvt_pk_bf16; using pg8::silu_f;
typedef short s16x4 __attribute__((ext_vector_type(4)));
typedef float f32x2 __attribute__((ext_vector_type(2)));
typedef unsigned u32x2 __attribute__((ext_vector_type(2)));

constexpr int DM = 2048, NB = 2, SEQ = 8192, M = NB * SEQ, DEPTH = 4, DFF = 5632, DIN = 4904, NPROJ = 5120;
constexpr int NWAVES = 8, NTHR = 512;
constexpr float EPS = 1e-6f;
constexpr int PC_Z = 0, PC_XBC = 1024, PC_GLU = 2560, PC_Q = 3584, PC_KC = 4096, PC_VC = 4224, PC_KS = 4352, PC_VS = 4480, PC_KW = 4608, PC_VW = 4736, PC_DT = 4864, PC_GL = 4880;
__device__ __forceinline__ int win_src_col(int j) {
    if (j < 2560) return j;
    if (j < 3584) return 3880 + (j - 2560);
    if (j < 4096) return 2576 + (j - 3584);
    if (j < 4864) return 3088 + (j - 4096);
    if (j < 4880) return 2560 + (j - 4864);
    if (j < 4904) return 3856 + (j - 4880);
    return -1;
}
__device__ __forceinline__ int gu_src_col(int R) { const int pn = R >> 8, rr = R & 255; return rr < 128 ? 128 * pn + rr : DFF + 128 * pn + (rr - 128); }

constexpr size_t MiB = 1u << 20;
constexpr size_t WS_CTL = 0, CTL_ZERO_BYTES = 1 * MiB;
constexpr size_t WS_WGU1 = 2 * MiB;
constexpr size_t WS_WGU2 = WS_WGU1 + 44 * MiB;
constexpr size_t WS_WD1 = WS_WGU2 + 44 * MiB;
constexpr size_t WS_WD2 = WS_WD1 + 22 * MiB;
constexpr size_t WS_WIN = WS_WD2 + 22 * MiB;
constexpr size_t WS_WOUT = WS_WIN + 20 * MiB;
constexpr size_t WS_W1 = WS_WOUT + 8 * MiB;
constexpr size_t WS_U = 180 * MiB;
constexpr size_t WS_T = 244 * MiB;
constexpr size_t WS_HID = 308 * MiB;
constexpr size_t WS_PROJ = 486 * MiB;
constexpr size_t WS_Y = 648 * MiB;
constexpr size_t WS_XACT = 712 * MiB;
constexpr size_t WS_STATES = 760 * MiB;
constexpr size_t WS_HP = 824 * MiB;
constexpr size_t WS_DT = 856 * MiB;
constexpr size_t WS_CS = 857 * MiB;
constexpr size_t WS_CDEC = 858 * MiB;
constexpr size_t WS_PEP = WS_CDEC + 64 * 1024;
constexpr size_t WS_KC = 859 * MiB;
constexpr size_t WS_H1 = 860 * MiB;
constexpr size_t WS_RS = 863 * MiB;
constexpr size_t WS_KV = 864 * MiB;
constexpr size_t WS_END = 890 * MiB;
static_assert(WS_W1 + 2 * MiB <= WS_U, "weights fit below U");
static_assert(WS_HID + (size_t)M * DFF * 2 <= WS_PROJ && WS_PROJ + (size_t)(M + 64) * NPROJ * 2 <= WS_Y, "ws map");

constexpr int LDS_WORK = 150 * 1024;
constexpr int LDS_CTL_OFF = LDS_WORK;
constexpr int LDS_BYTES = 152 * 1024;

typedef GAS unsigned gu32;
#define RLX_AGENT __ATOMIC_RELAXED, __HIP_MEMORY_SCOPE_AGENT
#define LDS_WAIT() asm volatile("s_waitcnt lgkmcnt(0)" ::: "memory")
#define VM_WAIT() asm volatile("s_waitcnt vmcnt(0)" ::: "memory")
__device__ __forceinline__ float bf2f(unsigned v) { return __uint_as_float(v << 16); }
__device__ __forceinline__ float bflo(unsigned u) { return __uint_as_float(u << 16); }
__device__ __forceinline__ float bfhi(unsigned u) { return __uint_as_float(u & 0xffff0000u); }
__device__ __forceinline__ float wave_sum(float v) {
#pragma unroll
    for (int o = 1; o < 64; o <<= 1) v += __shfl_xor(v, o);
    return v;
}
struct Ctx { LAS unsigned char* lds; int tid, lane, wave, G, bid; };

__device__ __forceinline__ bf16x8 frag_row(const LAS unsigned char* base, int pitch, int row0, int k0, int lane) {
    return *(const LAS bf16x8*)(base + (row0 + (lane & 15)) * pitch + (k0 + 8 * (lane >> 4)) * 2);
}
__device__ __forceinline__ s16x4 tr16(const LAS unsigned char* p) { return __builtin_bit_cast(s16x4, __builtin_amdgcn_ds_read_tr16_b64_v4i16((LAS s16x4*)p)); }
__device__ __forceinline__ bf16x8 frag_tr(const LAS unsigned char* base, int pitch, int k0, int n0, int lane) {
    const int g = lane >> 4, q = (lane & 15) >> 2, p = lane & 3;
    const LAS unsigned char* a = base + (k0 + 8 * g + q) * pitch + (n0 + 4 * p) * 2;
    const s16x4 lo = tr16(a), hi = tr16(a + 4 * pitch);
    return (bf16x8){lo[0], lo[1], lo[2], lo[3], hi[0], hi[1], hi[2], hi[3]};
}
#define MFMA16(a, b, c) __builtin_amdgcn_mfma_f32_16x16x32_bf16((a), (b), (c), 0, 0, 0)

#define XB_TMO      128
#define XB_XCNT(j)  (256  + 64 * (j))
#define XB_XSUB(j)  (1280 + 64 * (j))
#define XB_XGEN(j)  (2304 + 64 * (j))
#define XB_TOP      3328
#define XB_TOPGEN   3392
#define XCD_BAR_WORDS 3456
#define XB_SPIN_CAP (1u << 18)

__device__ __forceinline__ unsigned xb_ld(unsigned* p)              { return __hip_atomic_load(p, __ATOMIC_RELAXED, __HIP_MEMORY_SCOPE_AGENT); }
__device__ __forceinline__ unsigned xb_add(unsigned* p, unsigned v) { return __hip_atomic_fetch_add(p, v, __ATOMIC_RELAXED, __HIP_MEMORY_SCOPE_AGENT); }
__device__ __forceinline__ unsigned xb_xcc_id() { return (unsigned)__builtin_amdgcn_s_getreg((3 << 11) | 20) & 0xFu; }
#define XB_SPIN(cond, bar) do { unsigned _sp = 0; while (cond) { __builtin_amdgcn_s_sleep(1); \
    if ((++_sp & 255u) == 0u) { if (xb_ld(&(bar)[XB_TMO])) break; if (_sp > XB_SPIN_CAP) { atomicAdd(&(bar)[XB_TMO], 1u); break; } } } } while (0)

struct XcdBarrier {
    unsigned* bar; unsigned x;
    volatile LAS unsigned* st;
};

__device__ __forceinline__ XcdBarrier xcd_barrier_post(unsigned* bar, volatile LAS unsigned* st) {
    XcdBarrier b; b.bar = bar; b.x = xb_xcc_id(); b.st = st;
    if (threadIdx.x == 0) (void)xb_add(&bar[XB_XCNT(b.x)], 1u);
    return b;
}
__device__ __forceinline__ void xcd_barrier_complete(unsigned* bar, unsigned x, unsigned& nloc, unsigned& nx) {
    const unsigned G = gridDim.x * gridDim.y * gridDim.z;
    unsigned sum, cnt, mine, sp = 0u;
    for (;;) {
        sum = 0u; cnt = 0u; mine = 0u;
#pragma unroll
        for (unsigned j = 0; j < 16; ++j) { const unsigned c = xb_ld(&bar[XB_XCNT(j)]); sum += c; cnt += (c > 0u) ? 1u : 0u; mine = (j == x) ? c : mine; }
        if (sum == G) break;
        __builtin_amdgcn_s_sleep(1);
        if ((++sp & 255u) == 0u) { if (xb_ld(&bar[XB_TMO])) break; if (sp > XB_SPIN_CAP) { atomicAdd(&bar[XB_TMO], 1u); break; } }
    }
    nloc = mine > 0u ? mine : 1u; nx = cnt > 0u ? cnt : 1u;
}

__device__ __forceinline__ void xcd_barrier(const XcdBarrier& b) {
    asm volatile("s_waitcnt vmcnt(0)" ::: "memory");
    __syncthreads();
    if (threadIdx.x == 0) {
        unsigned* bar = b.bar;
        __builtin_amdgcn_s_waitcnt(0);
        unsigned nloc = b.st[0], nx = b.st[1];
        if (nloc == 0u) { xcd_barrier_complete(bar, b.x, nloc, nx); b.st[0] = nloc; b.st[1] = nx; }
        const unsigned old = xb_add(&bar[XB_XSUB(b.x)], 1u);
        const unsigned gen = old / nloc;
        if (old + 1u == (gen + 1u) * nloc) {
            __builtin_amdgcn_fence(__ATOMIC_RELEASE, "agent");
            asm volatile("s_waitcnt vmcnt(0)" ::: "memory");
            const unsigned og = xb_add(&bar[XB_TOP], 1u);
            const unsigned tg = og / nx;
            if (og + 1u == (tg + 1u) * nx) xb_add(&bar[XB_TOPGEN], 1u);
            else XB_SPIN(xb_ld(&bar[XB_TOPGEN]) == tg, bar);
            __builtin_amdgcn_fence(__ATOMIC_ACQUIRE, "agent");
            xb_add(&bar[XB_XGEN(b.x)], 1u);
            asm volatile("s_waitcnt vmcnt(0)" ::: "memory");
        } else {
            XB_SPIN(xb_ld(&bar[XB_XGEN(b.x)]) == gen, bar);
            __builtin_amdgcn_fence(__ATOMIC_ACQUIRE, "agent");
            asm volatile("s_waitcnt vmcnt(0)" ::: "memory");
        }
    }
    __syncthreads();
}

__device__ __forceinline__ void xcd_barrier_arrive(const XcdBarrier& b) {
    asm volatile("s_waitcnt vmcnt(0)" ::: "memory");
    __syncthreads();
    if (threadIdx.x == 0) {
        unsigned* bar = b.bar;
        __builtin_amdgcn_s_waitcnt(0);
        unsigned nloc = b.st[0], nx = b.st[1];
        if (nloc == 0u) { xcd_barrier_complete(bar, b.x, nloc, nx); b.st[0] = nloc; b.st[1] = nx; }
        const unsigned old = xb_add(&bar[XB_XSUB(b.x)], 1u);
        const unsigned gen = old / nloc;
        if (old + 1u == (gen + 1u) * nloc) {
            __builtin_amdgcn_fence(__ATOMIC_RELEASE, "agent");
            asm volatile("s_waitcnt vmcnt(0)" ::: "memory");
            const unsigned og = xb_add(&bar[XB_TOP], 1u);
            const unsigned tg = og / nx;
            if (og + 1u == (tg + 1u) * nx) xb_add(&bar[XB_TOPGEN], 1u);
            xb_add(&bar[XB_XGEN(b.x)], 1u);
        }
        b.st[3] = gen;
    }
}
__device__ __forceinline__ void xcd_barrier_wait(const XcdBarrier& b) {
    if (threadIdx.x == 0) {
        unsigned* bar = b.bar; const unsigned gen = b.st[3];
        XB_SPIN(xb_ld(&bar[XB_TOPGEN]) == gen, bar);
        __builtin_amdgcn_fence(__ATOMIC_ACQUIRE, "agent");
        asm volatile("s_waitcnt vmcnt(0)" ::: "memory");
    }
    __syncthreads();
}


struct MapId { __device__ __forceinline__ int operator()(int r) const { return r; } };
struct MapGu { __device__ __forceinline__ int operator()(int r) const { return gu_src_col(r); } };
struct MapIn { __device__ __forceinline__ int operator()(int r) const { return win_src_col(r); } };
template <class Map>
__device__ __forceinline__ void tr_item(const float* W, int K, int ldw, bf16_t* WT, LAS float* scr, int item, int nblk, int lane, Map map, const float* kscale = nullptr) {
    const int kb = item / nblk, nb = item % nblk, k0 = 64 * kb, n0 = 64 * nb;
    const int r4 = lane >> 4, c4 = lane & 15;
    const int src = map(n0 + 4 * c4);
    f32x4 v[16];
    const float* wp = W + (size_t)(k0 + r4) * ldw + (src >= 0 ? src : 0);
#pragma unroll
    for (int i = 0; i < 16; ++i) v[i] = *(const f32x4*)(wp + (size_t)(4 * i) * ldw);
    if (src < 0) {
#pragma unroll
        for (int i = 0; i < 16; ++i) v[i] = (f32x4){0.f, 0.f, 0.f, 0.f};
    }
    if (kscale) {
#pragma unroll
        for (int i = 0; i < 16; ++i) v[i] = v[i] * kscale[k0 + 4 * i + r4];
    }
#pragma unroll
    for (int i = 0; i < 16; ++i) { LAS float* d = scr + (4 * i + r4) * 65 + 4 * c4; d[0] = v[i][0]; d[1] = v[i][1]; d[2] = v[i][2]; d[3] = v[i][3]; }
    LDS_WAIT(); asm volatile("" ::: "memory");
    const int c = lane & 7;
#pragma unroll
    for (int j = 0; j < 8; ++j) { const int n = (lane >> 3) + 8 * j; const LAS float* sp = scr + (8 * c) * 65 + n;
        u32x4 o; o.x = cvt_pk_bf16(sp[0 * 65], sp[1 * 65]); o.y = cvt_pk_bf16(sp[2 * 65], sp[3 * 65]); o.z = cvt_pk_bf16(sp[4 * 65], sp[5 * 65]); o.w = cvt_pk_bf16(sp[6 * 65], sp[7 * 65]);
        *(u32x4*)(WT + (size_t)(n0 + n) * K + k0 + 8 * c) = o; }
    LDS_WAIT(); asm volatile("" ::: "memory");
}
struct LayerW {
    const float *gu1, *d1, *gu2, *d2, *win, *wout, *w1k, *w1v, *kpe, *vpe, *pre1, *prem, *pre2;
};
__device__ __forceinline__ void phase_convert(const Ctx& c, const LayerW& L, unsigned char* ws) {
    LAS float* scr = (LAS float*)(c.lds + c.wave * 16640);
    constexpr int B_GU = (DM / 256) * (2 * DFF / 128), B_D = (DFF / 256) * (DM / 128), B_IN = (DM / 256) * (NPROJ / 128), B_O = (DM / 256) * (DM / 128), B_1 = (DM / 256) * (256 / 128);
    constexpr int NBI = 2 * B_GU + 2 * B_D + B_IN + B_O + 2 * B_1;
    const int wk = c.wave >> 1, wn = c.wave & 1;
#define TR_CALL(W_, K_, LDW_, WT_, N_, MAP_, KS_) do { const int nb2n = (N_) / 128, kb = 4 * (r / nb2n) + wk, nb = 2 * (r % nb2n) + wn; tr_item(W_, K_, LDW_, WT_, scr, kb * ((N_) / 64) + nb, (N_) / 64, c.lane, MAP_, KS_); } while (0)
    for (int it = c.bid; it < NBI; it += c.G) {
        int r = it;
        if (r < B_GU) { TR_CALL(L.gu1, DM, 2 * DFF, (bf16_t*)(ws + WS_WGU1), 2 * DFF, MapGu(), L.pre1); continue; } r -= B_GU;
        if (r < B_GU) { TR_CALL(L.gu2, DM, 2 * DFF, (bf16_t*)(ws + WS_WGU2), 2 * DFF, MapGu(), L.pre2); continue; } r -= B_GU;
        if (r < B_D) { TR_CALL(L.d1, DFF, DM, (bf16_t*)(ws + WS_WD1), DM, MapId(), nullptr); continue; } r -= B_D;
        if (r < B_D) { TR_CALL(L.d2, DFF, DM, (bf16_t*)(ws + WS_WD2), DM, MapId(), nullptr); continue; } r -= B_D;
        if (r < B_IN) { TR_CALL(L.win, DM, DIN, (bf16_t*)(ws + WS_WIN), NPROJ, MapIn(), L.prem); continue; } r -= B_IN;
        if (r < B_O) { TR_CALL(L.wout, DM, DM, (bf16_t*)(ws + WS_WOUT), DM, MapId(), nullptr); continue; } r -= B_O;
        if (r < B_1) { TR_CALL(L.w1k, DM, 256, (bf16_t*)(ws + WS_W1), 256, MapId(), nullptr); continue; } r -= B_1;
        TR_CALL(L.w1v, DM, 256, (bf16_t*)(ws + WS_W1) + 256 * DM, 256, MapId(), nullptr);
    }
#undef TR_CALL
    for (int seg = c.bid; seg < 256; seg += c.G) {
        const int kv = c.tid >> 8, col = c.tid & 255;
        const float* pe = kv ? L.vpe : L.kpe; const float* w1 = kv ? L.w1v : L.w1k;
        float s = 0.f;
#pragma unroll
        for (int k = 0; k < 8; ++k) s += pe[8 * seg + k] * w1[(size_t)(8 * seg + k) * 256 + col];
        ((float*)(ws + WS_PEP))[(kv * 256 + seg) * 256 + col] = s;
    }
}

__device__ __forceinline__ void phase_norm(const Ctx& c, const float* xin, const bf16_t* T, float alpha, const float* wpost, bf16_t* HB, float* RS, float* outf) {
    const int gw = c.bid * NWAVES + c.wave, NGW = c.G * NWAVES;
    if (xin) {
        for (int row = gw; row < M; row += NGW) {
            const size_t i0 = (size_t)row * 512 + c.lane; float ss = 0.f;
#pragma unroll
            for (int j = 0; j < 8; ++j) { const f32x4 hv = ((const f32x4*)xin)[i0 + 64 * j]; ss += (hv[0] * hv[0] + hv[1] * hv[1]) + (hv[2] * hv[2] + hv[3] * hv[3]);
                u32x2 pk; pk.x = cvt_pk_bf16(hv[0], hv[1]); pk.y = cvt_pk_bf16(hv[2], hv[3]); ((u32x2*)HB)[i0 + 64 * j] = pk; }
            const float rs = 1.0f / sqrtf(wave_sum(ss) * (1.0f / DM) + EPS);
            if (c.lane == 0) RS[row] = rs;
        }
        return;
    }
    for (int row = gw; row < M; row += 2 * NGW) {
        const bool two = row + NGW < M;
        const size_t i0 = (size_t)row * 512 + c.lane, i1 = (size_t)(two ? row + NGW : row) * 512 + c.lane;
        u32x2 tw[2][8], hw[2][8];
#pragma unroll
        for (int j = 0; j < 8; ++j) { tw[0][j] = ((const u32x2*)T)[i0 + 64 * j]; tw[1][j] = ((const u32x2*)T)[i1 + 64 * j]; }
#pragma unroll
        for (int j = 0; j < 8; ++j) { hw[0][j] = ((const u32x2*)HB)[i0 + 64 * j]; hw[1][j] = ((const u32x2*)HB)[i1 + 64 * j]; }
        f32x4 wp[8];
#pragma unroll
        for (int j = 0; j < 8; ++j) wp[j] = ((const f32x4*)wpost)[c.lane + 64 * j];
#pragma unroll
        for (int q = 0; q < 2; ++q) {
            if (q == 1 && !two) break;
            const size_t iq = q ? i1 : i0; const int rq = q ? row + NGW : row;
            f32x4 tv[8]; float ss = 0.f;
#pragma unroll
            for (int j = 0; j < 8; ++j) { tv[j] = (f32x4){bflo(tw[q][j].x), bfhi(tw[q][j].x), bflo(tw[q][j].y), bfhi(tw[q][j].y)};
                ss += (tv[j][0] * tv[j][0] + tv[j][1] * tv[j][1]) + (tv[j][2] * tv[j][2] + tv[j][3] * tv[j][3]); }
            const float rs = alpha / sqrtf(wave_sum(ss) * (1.0f / DM) + EPS);
            float s2 = 0.f;
#pragma unroll
            for (int j = 0; j < 8; ++j) { const f32x4 hv = (f32x4){bflo(hw[q][j].x), bfhi(hw[q][j].x), bflo(hw[q][j].y), bfhi(hw[q][j].y)} + tv[j] * rs * wp[j];
                if (outf) ((f32x4*)outf)[iq + 64 * j] = hv;
                else { s2 += (hv[0] * hv[0] + hv[1] * hv[1]) + (hv[2] * hv[2] + hv[3] * hv[3]);
                    u32x2 pk; pk.x = cvt_pk_bf16(hv[0], hv[1]); pk.y = cvt_pk_bf16(hv[2], hv[3]); ((u32x2*)HB)[iq + 64 * j] = pk; } }
            if (!outf) { const float r2 = 1.0f / sqrtf(wave_sum(s2) * (1.0f / DM) + EPS); if (c.lane == 0) RS[rq] = r2; }
        }
    }
}

struct SsdW { const float *conv_w, *conv_b, *dt_bias, *a_log, *dskip, *norm_w; };
__device__ __forceinline__ float softplus_f(float x) { return x > 20.f ? x : log1pf(__expf(x)); }

__device__ __forceinline__ void ssd_conv8(const bf16_t* PROJ, const SsdW& W, int b, int s, int ch0, float (&out)[8]) {
    const f32x4 b0 = *(const f32x4*)(W.conv_b + ch0), b1 = *(const f32x4*)(W.conv_b + ch0 + 4);
    float acc[8] = {b0[0], b0[1], b0[2], b0[3], b1[0], b1[1], b1[2], b1[3]};
#pragma unroll
    for (int k = 0; k < 4; ++k) {
        const int sr = s - 3 + k;
        if (sr >= 0) {
            const u32x4 x = *(const u32x4*)(PROJ + (size_t)(b * SEQ + sr) * NPROJ + PC_XBC + ch0);
            const f32x4 w0 = *(const f32x4*)(W.conv_w + k * 1536 + ch0), w1 = *(const f32x4*)(W.conv_w + k * 1536 + ch0 + 4);
            acc[0] += w0[0] * bflo(x.x); acc[1] += w0[1] * bfhi(x.x); acc[2] += w0[2] * bflo(x.y); acc[3] += w0[3] * bfhi(x.y);
            acc[4] += w1[0] * bflo(x.z); acc[5] += w1[1] * bfhi(x.z); acc[6] += w1[2] * bflo(x.w); acc[7] += w1[3] * bfhi(x.w);
        }
    }
#pragma unroll
    for (int e = 0; e < 8; ++e) out[e] = silu_f(acc[e]);
}
struct Conv8W { f32x4 w[4][2]; f32x4 b[2]; };
__device__ __forceinline__ Conv8W conv8_load_w(const SsdW& W, int ch0) { Conv8W r;
#pragma unroll
    for (int k = 0; k < 4; ++k) { r.w[k][0] = *(const f32x4*)(W.conv_w + k * 1536 + ch0); r.w[k][1] = *(const f32x4*)(W.conv_w + k * 1536 + ch0 + 4); }
    r.b[0] = *(const f32x4*)(W.conv_b + ch0); r.b[1] = *(const f32x4*)(W.conv_b + ch0 + 4); return r; }
__device__ __forceinline__ void conv8_load_x(const bf16_t* PROJ, int b, int s, int ch0, u32x4 (&x)[4]) {
#pragma unroll
    for (int k = 0; k < 4; ++k) { const int sr = s - 3 + k; x[k] = (u32x4){0u, 0u, 0u, 0u}; if (sr >= 0) x[k] = *(const u32x4*)(PROJ + (size_t)(b * SEQ + sr) * NPROJ + PC_XBC + ch0); } }
__device__ __forceinline__ void conv8_apply(const Conv8W& cw, const u32x4 (&x)[4], float (&out)[8]) {
    float acc[8] = {cw.b[0][0], cw.b[0][1], cw.b[0][2], cw.b[0][3], cw.b[1][0], cw.b[1][1], cw.b[1][2], cw.b[1][3]};
#pragma unroll
    for (int k = 0; k < 4; ++k) {
        acc[0] += cw.w[k][0][0] * bflo(x[k].x); acc[1] += cw.w[k][0][1] * bfhi(x[k].x); acc[2] += cw.w[k][0][2] * bflo(x[k].y); acc[3] += cw.w[k][0][3] * bfhi(x[k].y);
        acc[4] += cw.w[k][1][0] * bflo(x[k].z); acc[5] += cw.w[k][1][1] * bfhi(x[k].z); acc[6] += cw.w[k][1][2] * bflo(x[k].w); acc[7] += cw.w[k][1][3] * bfhi(x[k].w); }
#pragma unroll
    for (int e = 0; e < 8; ++e) out[e] = silu_f(acc[e]);
}
__device__ __forceinline__ u32x4 pack8(const float (&v)[8]) { u32x4 w; w.x = cvt_pk_bf16(v[0], v[1]); w.y = cvt_pk_bf16(v[2], v[3]); w.z = cvt_pk_bf16(v[4], v[5]); w.w = cvt_pk_bf16(v[6], v[7]); return w; }

constexpr int P136 = 272, P72 = 144;
__device__ __forceinline__ void ssd_a_unit(const Ctx& c, const SsdW& W, unsigned char* ws, int unit) {
    const int g = unit & 1, ch = (unit >> 1) & 63, b = unit >> 7;
    const bf16_t* PROJ = (const bf16_t*)(ws + WS_PROJ); bf16_t* XACT = (bf16_t*)(ws + WS_XACT);
    float* DT = (float*)(ws + WS_DT); float* CS = (float*)(ws + WS_CS); float* CDEC = (float*)(ws + WS_CDEC); bf16_t* ST = (bf16_t*)(ws + WS_STATES);
    LAS float* sclS = (LAS float*)(c.lds + 8192);
    LAS unsigned char* Bs = c.lds + 12288;
    LAS unsigned char* Xs = c.lds + 12288 + 128 * P136;
    const int m0 = b * SEQ + ch * 128;
    const int q8 = c.tid & 7, xs = c.tid >> 3;
    Conv8W hw = conv8_load_w(W, 64 * (8 * g) + 8 * q8);
    u32x4 hx[2][4];
#pragma unroll
    for (int i = 0; i < 2; ++i) conv8_load_x(PROJ, b, ch * 128 + xs + 64 * i, 64 * (8 * g) + 8 * q8, hx[i]);
    __syncthreads();
    {
        const int hh = 8 * g + c.wave; const float bias = W.dt_bias[hh], a = -__expf(W.a_log[hh]);
        const int s0 = 2 * c.lane;
        const float r0 = bf2f(PROJ[(size_t)(m0 + s0) * NPROJ + PC_DT + hh]), r1 = bf2f(PROJ[(size_t)(m0 + s0 + 1) * NPROJ + PC_DT + hh]);
        const float dt0 = softplus_f(r0 + bias), dt1 = softplus_f(r1 + bias);
        const float v0 = a * dt0, pair = v0 + a * dt1;
        float x = pair;
#pragma unroll
        for (int o = 1; o < 64; o <<= 1) { const float y = __shfl_up(x, o); if (c.lane >= o) x += y; }
        const float cs0 = (x - pair) + v0, cs1 = x, tot = __shfl(x, 63);
        sclS[c.wave * 128 + s0] = __expf(tot - cs0) * dt0; sclS[c.wave * 128 + s0 + 1] = __expf(tot - cs1) * dt1;
        DT[(size_t)(m0 + s0) * 16 + hh] = dt0; DT[(size_t)(m0 + s0 + 1) * 16 + hh] = dt1;
        CS[(size_t)(m0 + s0) * 16 + hh] = cs0; CS[(size_t)(m0 + s0 + 1) * 16 + hh] = cs1;
        if (c.lane == 63) CDEC[(b * 64 + ch) * 16 + hh] = __expf(tot);
    }
    {
        const int q = c.tid & 31, ch0 = (q < 16) ? 1024 + 128 * g + 8 * q : 1280 + 128 * g + 8 * (q - 16);
        const Conv8W cw = conv8_load_w(W, ch0);
#pragma unroll
        for (int k0 = 0; k0 < 8; k0 += 4) {
            u32x4 x[4][4];
#pragma unroll
            for (int i = 0; i < 4; ++i) conv8_load_x(PROJ, b, ch * 128 + (c.tid >> 5) + 16 * (k0 + i), ch0, x[i]);
#pragma unroll
            for (int i = 0; i < 4; ++i) { const int s = (c.tid >> 5) + 16 * (k0 + i);
                float v[8]; conv8_apply(cw, x[i], v);
                const u32x4 pk = pack8(v);
                *(u32x4*)(XACT + (size_t)(m0 + s) * 1536 + ch0) = pk;
                if (q < 16) *(LAS u32x4*)(Bs + s * P136 + q * 16) = pk; }
        }
    }
    for (int h8 = 0; h8 < 8; ++h8) {
        const int hh = 8 * g + h8;
        __syncthreads();
        {
            const int ch0 = 64 * hh + 8 * q8;
            float v[2][8];
#pragma unroll
            for (int i = 0; i < 2; ++i) conv8_apply(hw, hx[i], v[i]);
            if (h8 < 7) { hw = conv8_load_w(W, ch0 + 64);
#pragma unroll
                for (int i = 0; i < 2; ++i) conv8_load_x(PROJ, b, ch * 128 + xs + 64 * i, ch0 + 64, hx[i]); }
#pragma unroll
            for (int i = 0; i < 2; ++i) { const int s = xs + 64 * i;
                *(u32x4*)(XACT + (size_t)(m0 + s) * 1536 + ch0) = pack8(v[i]);
                const float sc = sclS[h8 * 128 + s];
#pragma unroll
                for (int e = 0; e < 8; ++e) v[i][e] *= sc;
                *(LAS u32x4*)(Xs + s * P72 + q8 * 16) = pack8(v[i]); }
        }
        __syncthreads();
        const int pt = c.wave & 3, ntg = c.wave >> 2;
        f32x4 acc[4];
#pragma unroll
        for (int nt = 0; nt < 4; ++nt) acc[nt] = (f32x4){0.f, 0.f, 0.f, 0.f};
#pragma unroll
        for (int ks = 0; ks < 4; ++ks) {
            const bf16x8 xf = frag_tr(Xs, P72, 32 * ks, 16 * pt, c.lane);
#pragma unroll
            for (int nt = 0; nt < 4; ++nt) { const bf16x8 bf = frag_tr(Bs, P136, 32 * ks, 16 * (4 * ntg + nt), c.lane); acc[nt] = MFMA16(bf, xf, acc[nt]); }
        }
        bf16_t* stp = ST + ((size_t)((b * 64 + ch) * 16 + hh) * 64 + 16 * pt + (c.lane & 15)) * 128 + 4 * (c.lane >> 4);
#pragma unroll
        for (int nt = 0; nt < 4; ++nt) { u32x2 pk; pk.x = cvt_pk_bf16(acc[nt][0], acc[nt][1]); pk.y = cvt_pk_bf16(acc[nt][2], acc[nt][3]); *(u32x2*)(stp + 16 * (4 * ntg + nt)) = pk; }
    }
}

__device__ __forceinline__ void phase_ssd_scan(const Ctx& c, unsigned char* ws) {
    const unsigned* ST = (const unsigned*)(ws + WS_STATES); const float* CDEC = (const float*)(ws + WS_CDEC); unsigned* HP = (unsigned*)(ws + WS_HP);
    for (int chain = c.bid * NTHR + c.tid; chain < NB * 16 * 64 * 64; chain += c.G * NTHR) {
        const int n2 = chain & 63, p = (chain >> 6) & 63, hh = (chain >> 12) & 15, b = chain >> 16;
        f32x2 run = (f32x2){0.f, 0.f};
#pragma unroll 16
        for (int ch = 0; ch < 64; ++ch) {
            const size_t idx = ((size_t)((b * 64 + ch) * 16 + hh) * 64 + p) * 64 + n2;
            const unsigned sp = ST[idx]; const f32x2 s = (f32x2){bflo(sp), bfhi(sp)}; const float dec = CDEC[(b * 64 + ch) * 16 + hh];
            HP[idx] = cvt_pk_bf16(run[0], run[1]);
            run = run * dec + s;
        }
    }
}

__device__ __forceinline__ void ssd_b_unit(const Ctx& c, const SsdW& W, unsigned char* ws, int unit) {
    const int g = unit & 1, ch = (unit >> 1) & 63, b = unit >> 7;
    const bf16_t* PROJ = (const bf16_t*)(ws + WS_PROJ); const bf16_t* XACT = (const bf16_t*)(ws + WS_XACT); const bf16_t* HP = (const bf16_t*)(ws + WS_HP);
    const float* DT = (const float*)(ws + WS_DT); const float* CS = (const float*)(ws + WS_CS); bf16_t* Y = (bf16_t*)(ws + WS_Y);
    LAS float* csS = (LAS float*)(c.lds);
    LAS float* dtS = (LAS float*)(c.lds + 4096);
    LAS unsigned char* Cs = c.lds + 8192;
    LAS unsigned char* Ws = Cs + 128 * P136;
    LAS unsigned char* CBs = Ws + 128 * P136;
    LAS unsigned char* Xs = CBs + 128 * P136;
    LAS unsigned char* Hs = Xs + 128 * P72;
    const int m0 = b * SEQ + ch * 128, lane = c.lane, w = c.wave;
    __syncthreads();
    {
        u32x4 sv[8]; float cv[2], dv[2];
#pragma unroll
        for (int i = 0; i < 8; ++i) { const int it = c.tid + NTHR * i, s = it >> 5, q = it & 31;
            sv[i] = *(const u32x4*)(XACT + (size_t)(m0 + s) * 1536 + ((q < 16) ? 1280 + 128 * g + 8 * q : 1024 + 128 * g + 8 * (q - 16))); }
#pragma unroll
        for (int i = 0; i < 2; ++i) { const int it = c.tid + NTHR * i, s = it >> 3, h8 = it & 7; cv[i] = CS[(size_t)(m0 + s) * 16 + 8 * g + h8]; dv[i] = DT[(size_t)(m0 + s) * 16 + 8 * g + h8]; }
#pragma unroll
        for (int i = 0; i < 8; ++i) { const int it = c.tid + NTHR * i, s = it >> 5, q = it & 31; *(LAS u32x4*)(((q < 16) ? Cs : Ws) + s * P136 + (q & 15) * 16) = sv[i]; }
#pragma unroll
        for (int i = 0; i < 2; ++i) { const int it = c.tid + NTHR * i, s = it >> 3, h8 = it & 7; csS[h8 * 128 + s] = cv[i]; dtS[h8 * 128 + s] = dv[i]; }
    }
    __syncthreads();
    bf16x8 cfr[4];
#pragma unroll
    for (int ks = 0; ks < 4; ++ks) cfr[ks] = frag_row(Cs, P136, 16 * w, 32 * ks, lane);
    for (int st = 0; st <= w; ++st) {
        f32x4 a = (f32x4){0.f, 0.f, 0.f, 0.f};
#pragma unroll
        for (int ks = 0; ks < 4; ++ks) a = MFMA16(frag_row(Ws, P136, 16 * st, 32 * ks, lane), cfr[ks], a);
        u32x2 pk; pk.x = cvt_pk_bf16(a[0], a[1]); pk.y = cvt_pk_bf16(a[2], a[3]);
        *(LAS u32x2*)(CBs + (16 * w + (lane & 15)) * P136 + (16 * st + 4 * (lane >> 4)) * 2) = pk;
    }
    float ssq = 0.f;
    const int tok = 16 * w + (lane & 15);
    const int xs0 = c.tid >> 3, xq = c.tid & 7, hp0 = c.tid >> 4, hq = c.tid & 15;
    u32x4 xr[2], hr[2];
#define SSDB_FETCH(hh_) do { \
        xr[0] = *(const u32x4*)(XACT + (size_t)(m0 + xs0) * 1536 + 64 * (hh_) + 8 * xq); xr[1] = *(const u32x4*)(XACT + (size_t)(m0 + xs0 + 64) * 1536 + 64 * (hh_) + 8 * xq); \
        hr[0] = *(const u32x4*)(HP + ((size_t)((b * 64 + ch) * 16 + (hh_)) * 64 + hp0) * 128 + 8 * hq); hr[1] = *(const u32x4*)(HP + ((size_t)((b * 64 + ch) * 16 + (hh_)) * 64 + hp0 + 32) * 128 + 8 * hq); } while (0)
    SSDB_FETCH(8 * g);
    for (int h8 = 0; h8 < 8; ++h8) {
        const int hh = 8 * g + h8;
        u32x2 zv[4];
#pragma unroll
        for (int pt = 0; pt < 4; ++pt) zv[pt] = *(const u32x2*)(PROJ + (size_t)(m0 + tok) * NPROJ + PC_Z + 64 * hh + 16 * pt + 4 * (lane >> 4));
        __syncthreads();
        *(LAS u32x4*)(Xs + xs0 * P72 + xq * 16) = xr[0]; *(LAS u32x4*)(Xs + (xs0 + 64) * P72 + xq * 16) = xr[1];
        *(LAS u32x4*)(Hs + hp0 * P136 + hq * 16) = hr[0]; *(LAS u32x4*)(Hs + (hp0 + 32) * P136 + hq * 16) = hr[1];
        if (h8 < 7) SSDB_FETCH(hh + 1);
        for (int it = c.tid; it < 128 * 16; it += NTHR) {
            const int l = it >> 4, q = it & 15, s0 = 8 * q;
            u32x4 o = (u32x4){0u, 0u, 0u, 0u};
            if (s0 <= l) {
                const u32x4 cb = *(const LAS u32x4*)(CBs + l * P136 + q * 16); const float cl = csS[h8 * 128 + l];
                float v[8] = {bflo(cb.x), bfhi(cb.x), bflo(cb.y), bfhi(cb.y), bflo(cb.z), bfhi(cb.z), bflo(cb.w), bfhi(cb.w)};
                const f32x4 c0 = *(const LAS f32x4*)(csS + h8 * 128 + s0), c1 = *(const LAS f32x4*)(csS + h8 * 128 + s0 + 4), d0 = *(const LAS f32x4*)(dtS + h8 * 128 + s0), d1 = *(const LAS f32x4*)(dtS + h8 * 128 + s0 + 4);
                const float csv[8] = {c0[0], c0[1], c0[2], c0[3], c1[0], c1[1], c1[2], c1[3]}, dtv[8] = {d0[0], d0[1], d0[2], d0[3], d1[0], d1[1], d1[2], d1[3]};
#pragma unroll
                for (int e = 0; e < 8; ++e) { const int s = s0 + e; v[e] = (s <= l) ? v[e] * __expf(cl - csv[e]) * dtv[e] : 0.f; }
                o = pack8(v);
            }
            *(LAS u32x4*)(Ws + l * P136 + q * 16) = o;
        }
        __syncthreads();
        const int nks = (w >> 1) + 1;
        const float ecs = __expf(csS[h8 * 128 + tok]), dsk = W.dskip[hh];
#pragma unroll
        for (int pt = 0; pt < 4; ++pt) {
            f32x4 yd = (f32x4){0.f, 0.f, 0.f, 0.f}, yo = (f32x4){0.f, 0.f, 0.f, 0.f};
            for (int ks = 0; ks < nks; ++ks) yd = MFMA16(frag_tr(Xs, P72, 32 * ks, 16 * pt, lane), frag_row(Ws, P136, 16 * w, 32 * ks, lane), yd);
#pragma unroll
            for (int ks = 0; ks < 4; ++ks) yo = MFMA16(frag_row(Hs, P136, 16 * pt, 32 * ks, lane), cfr[ks], yo);
            const int p0 = 16 * pt + 4 * (lane >> 4);
            const u32x2 xv = *(const LAS u32x2*)(Xs + tok * P72 + p0 * 2);
            const float xx[4] = {bflo(xv.x), bfhi(xv.x), bflo(xv.y), bfhi(xv.y)}, zz[4] = {bflo(zv[pt].x), bfhi(zv[pt].x), bflo(zv[pt].y), bfhi(zv[pt].y)};
            float yv[4];
#pragma unroll
            for (int r = 0; r < 4; ++r) { yv[r] = (yd[r] + ecs * yo[r] + dsk * xx[r]) * silu_f(zz[r]); ssq += yv[r] * yv[r]; }
            u32x2 pk; pk.x = cvt_pk_bf16(yv[0], yv[1]); pk.y = cvt_pk_bf16(yv[2], yv[3]);
            *(u32x2*)(Y + (size_t)(m0 + tok) * DM + 64 * hh + p0) = pk;
        }
    }
#undef SSDB_FETCH
    ssq += __shfl_xor(ssq, 16); ssq += __shfl_xor(ssq, 32);
    const float rstd = 1.0f / sqrtf(ssq * (1.0f / 512.f) + EPS);
    VM_WAIT(); __builtin_amdgcn_fence(__ATOMIC_ACQUIRE, "agent"); VM_WAIT();
    const f32x4 nw0 = *(const f32x4*)(W.norm_w + 512 * g + 8 * lane), nw1 = *(const f32x4*)(W.norm_w + 512 * g + 8 * lane + 4);
    u32x4 yrow[16];
#pragma unroll
    for (int t = 0; t < 16; ++t) yrow[t] = *(const u32x4*)(Y + (size_t)(m0 + 16 * w + t) * DM + 512 * g + 8 * lane);
#pragma unroll
    for (int t = 0; t < 16; ++t) {
        const float rs = __shfl(rstd, t);
        bf16_t* yp = Y + (size_t)(m0 + 16 * w + t) * DM + 512 * g + 8 * lane;
        const u32x4 v = yrow[t];
        float o[8] = {bflo(v.x) * rs * nw0[0], bfhi(v.x) * rs * nw0[1], bflo(v.y) * rs * nw0[2], bfhi(v.y) * rs * nw0[3],
                      bflo(v.z) * rs * nw1[0], bfhi(v.z) * rs * nw1[1], bflo(v.w) * rs * nw1[2], bfhi(v.w) * rs * nw1[3]};
        *(u32x4*)yp = pack8(o);
    }
}

struct CnvW { const float *dw_w, *dw_b, *ln_w, *ln_b; };
__device__ __forceinline__ void cnv_unit(const Ctx& c, const CnvW& W, unsigned char* ws, int unit) {
    const bf16_t* PROJ = (const bf16_t*)(ws + WS_PROJ); bf16_t* Y = (bf16_t*)(ws + WS_Y);
    LAS float* vin = (LAS float*)c.lds;
    LAS float* red = (LAS float*)(c.lds + 62 * 512 * 4);
    const int b = unit >> 8, s0 = (unit & 255) * 32;
    __syncthreads();
    {
        u32x4 ra[8], rg[8];
#pragma unroll
        for (int i = 0; i < 8; ++i) { const int it = c.tid + NTHR * i, r = it >> 6, q = it & 63, s = s0 - 30 + r;
            ra[i] = (u32x4){0u, 0u, 0u, 0u}; rg[i] = (u32x4){0u, 0u, 0u, 0u};
            if (it < 62 * 64 && s >= 0) { const bf16_t* row = PROJ + (size_t)(b * SEQ + s) * NPROJ + PC_GLU + 8 * q; ra[i] = *(const u32x4*)row; rg[i] = *(const u32x4*)(row + 512); } }
#pragma unroll
        for (int i = 0; i < 8; ++i) { const int it = c.tid + NTHR * i, r = it >> 6, q = it & 63;
            if (it < 62 * 64) {
                const u32x4 a = ra[i], gt = rg[i];
                const float av[8] = {bflo(a.x), bfhi(a.x), bflo(a.y), bfhi(a.y), bflo(a.z), bfhi(a.z), bflo(a.w), bfhi(a.w)};
                const float gv[8] = {bflo(gt.x), bfhi(gt.x), bflo(gt.y), bfhi(gt.y), bflo(gt.z), bfhi(gt.z), bflo(gt.w), bfhi(gt.w)};
                float v[8];
#pragma unroll
                for (int e = 0; e < 8; ++e) v[e] = av[e] * __builtin_amdgcn_rcpf(1.0f + __expf(-gv[e]));
                *(LAS f32x4*)(vin + r * 512 + 8 * q) = (f32x4){v[0], v[1], v[2], v[3]}; *(LAS f32x4*)(vin + r * 512 + 8 * q + 4) = (f32x4){v[4], v[5], v[6], v[7]};
            } }
    }
    __syncthreads();
    const int ch = c.tid;
    float acc[32];
    { const float bias = W.dw_b[ch];
#pragma unroll
      for (int t = 0; t < 32; ++t) acc[t] = bias; }
    {
        float xin[62];
#pragma unroll
        for (int r = 0; r < 62; ++r) xin[r] = vin[r * 512 + ch];
#pragma unroll
        for (int k = 0; k < 31; ++k) { const float wk = W.dw_w[k * 512 + ch];
#pragma unroll
            for (int t = 0; t < 32; ++t) acc[t] += wk * xin[t + k]; }
    }
#pragma unroll
    for (int t = 0; t < 32; ++t) { const float s1 = wave_sum(acc[t]), s2 = wave_sum(acc[t] * acc[t]); if (c.lane == 0) { red[(c.wave * 32 + t) * 2] = s1; red[(c.wave * 32 + t) * 2 + 1] = s2; } }
    __syncthreads();
    const float lw = W.ln_w[ch], lb = W.ln_b[ch];
#pragma unroll
    for (int t = 0; t < 32; ++t) {
        float s1 = 0.f, s2 = 0.f;
#pragma unroll
        for (int wv = 0; wv < 8; ++wv) { s1 += red[(wv * 32 + t) * 2]; s2 += red[(wv * 32 + t) * 2 + 1]; }
        const float mu = s1 * (1.0f / 512.f), var = fmaxf(s2 * (1.0f / 512.f) - mu * mu, 0.f);
        const float o = silu_f((acc[t] - mu) * __builtin_amdgcn_rsqf(var + EPS) * lw + lb);
        Y[(size_t)(b * SEQ + s0 + t) * DM + 1536 + ch] = (bf16_t)(cvt_pk_bf16(o, 0.f) & 0xffffu);
    }
}

__device__ __forceinline__ void nsa_cmp2(const Ctx& c, const float* w2, const bf16_t* H1, bf16_t* KC, int pm) {
    LAS unsigned char* W2s = c.lds;
    VM_WAIT(); __syncthreads();
    __builtin_amdgcn_fence(__ATOMIC_ACQUIRE, "agent"); VM_WAIT();
    for (int it = c.tid; it < 256 * 8; it += NTHR) { const int k = it >> 3, q = it & 7;
        const f32x4 a = *(const f32x4*)(w2 + k * 64 + 8 * q), b = *(const f32x4*)(w2 + k * 64 + 8 * q + 4);
        u32x4 o; o.x = cvt_pk_bf16(a[0], a[1]); o.y = cvt_pk_bf16(a[2], a[3]); o.z = cvt_pk_bf16(b[0], b[1]); o.w = cvt_pk_bf16(b[2], b[3]);
        *(LAS u32x4*)(W2s + k * P72 + q * 16) = o; }
    __syncthreads();
    const int lane = c.lane;
#pragma unroll
    for (int rt = 0; rt < 2; ++rt) {
        const int r0 = pm * 256 + c.wave * 32 + rt * 16;
        f32x4 acc[4];
#pragma unroll
        for (int dt = 0; dt < 4; ++dt) acc[dt] = (f32x4){0.f, 0.f, 0.f, 0.f};
        for (int ks = 0; ks < 8; ++ks) {
            const bf16x8 hf = *(const bf16x8*)(H1 + (size_t)(r0 + (lane & 15)) * 256 + 32 * ks + 8 * (lane >> 4));
#pragma unroll
            for (int dt = 0; dt < 4; ++dt) acc[dt] = MFMA16(frag_tr(W2s, P72, 32 * ks, 16 * dt, lane), hf, acc[dt]);
        }
#pragma unroll
        for (int dt = 0; dt < 4; ++dt) { u32x2 pk; pk.x = cvt_pk_bf16(acc[dt][0], acc[dt][1]); pk.y = cvt_pk_bf16(acc[dt][2], acc[dt][3]);
            *(u32x2*)(KC + (size_t)(r0 + (lane & 15)) * 64 + 16 * dt + 4 * (lane >> 4)) = pk; }
    }
}

typedef unsigned long long u64;
__device__ __forceinline__ int next_bit(u64 lo, u64 hi, int from) {
    if (from < 64) { const u64 m = lo & (~0ull << from); if (m) return __builtin_ctzll(m); from = 64; }
    if (from < 128) { const u64 m = hi & (~0ull << (from - 64)); if (m) return 64 + __builtin_ctzll(m); }
    return -1;
}
constexpr int NSA_D = 6, NSA_SLOT = 16384, NSA_RING = 0, NSA_IMP = NSA_D * NSA_SLOT, NSA_SELM = NSA_IMP + 8 * 8 * 132 * 4, NSA_END = NSA_SELM + 64 * 16;
static_assert(NSA_END <= LDS_WORK, "NSA LDS map");
__device__ __forceinline__ bf16x8 frag_row_sw(const LAS unsigned char* base, int row0, int k0, int lane) {
    const int r = row0 + (lane & 15), cc = (k0 >> 3) + (lane >> 4);
    return *(const LAS bf16x8*)(base + r * 128 + ((cc ^ ((r >> 1) & 7)) << 4));
}
__device__ __forceinline__ void vtr_half(bf16x8 (&vf)[2][2], unsigned a00, unsigned a01, unsigned a10, unsigned a11) {
    s16x4 t[2][2][2];
    asm volatile(
        "ds_read_b64_tr_b16 %0, %8\n\tds_read_b64_tr_b16 %1, %9\n\tds_read_b64_tr_b16 %2, %8 offset:4096\n\tds_read_b64_tr_b16 %3, %9 offset:4096\n\t"
        "ds_read_b64_tr_b16 %4, %10\n\tds_read_b64_tr_b16 %5, %11\n\tds_read_b64_tr_b16 %6, %10 offset:4096\n\tds_read_b64_tr_b16 %7, %11 offset:4096\n\t"
        "s_waitcnt lgkmcnt(0)"
        : "=&v"(t[0][0][0]), "=&v"(t[0][0][1]), "=&v"(t[0][1][0]), "=&v"(t[0][1][1]), "=&v"(t[1][0][0]), "=&v"(t[1][0][1]), "=&v"(t[1][1][0]), "=&v"(t[1][1][1])
        : "v"(a00), "v"(a01), "v"(a10), "v"(a11)
        : "memory");
#pragma unroll
    for (int dt = 0; dt < 2; ++dt)
#pragma unroll
        for (int ks = 0; ks < 2; ++ks) vf[dt][ks] = (bf16x8){t[dt][ks][0][0], t[dt][ks][0][1], t[dt][ks][0][2], t[dt][ks][0][3], t[dt][ks][1][0], t[dt][ks][1][1], t[dt][ks][1][2], t[dt][ks][1][3]};
}
__device__ __forceinline__ u64 uni64(u64 x) { return ((u64)(unsigned)__builtin_amdgcn_readfirstlane((int)(x >> 32)) << 32) | (u64)(unsigned)__builtin_amdgcn_readfirstlane((int)x); }
__device__ __forceinline__ void wait_vm_n(int n) {
    if (n >= 4) asm volatile("s_waitcnt vmcnt(4)" ::: "memory"); else if (n == 2) asm volatile("s_waitcnt vmcnt(2)" ::: "memory");
    else if (n == 1) asm volatile("s_waitcnt vmcnt(1)" ::: "memory"); else asm volatile("s_waitcnt vmcnt(0)" ::: "memory");
}
__device__ __forceinline__ bool bit128(u64 lo, u64 hi, int j) { return (j < 64) ? ((lo >> j) & 1ull) : ((hi >> (j - 64)) & 1ull); }
struct NsaRows {
    int ql, hg, kq;
    int t[2];
    int tmin, tmax;
    u64 selLo[2], selHi[2];
};
template <int MODE, int KIND, bool MASKED>
__device__ __forceinline__ void nsa_block(const LAS unsigned char* Ks, unsigned vbase, const unsigned (&voff)[4][2], LAS unsigned char* Ps, LAS float* imp, int j, int lane,
                                          const NsaRows& R, const bf16x8 (&qf)[2][2], float (&lrow)[2], f32x4 (&lacc)[2], const float (&invl)[2], f32x4 (&o)[2][4]) {
    const float NEGINF = -INFINITY;
    f32x4 s[2][4];
#pragma unroll
    for (int T = 0; T < 2; ++T) {
        float sinit = 0.f;
        if (KIND == 1) sinit = bit128(R.selLo[T], R.selHi[T], j) ? 0.f : NEGINF;
#pragma unroll
        for (int kt = 0; kt < 4; ++kt) s[T][kt] = (f32x4){sinit, sinit, sinit, sinit};
    }
#pragma unroll
    for (int kt = 0; kt < 4; ++kt) {
        const bf16x8 k0 = frag_row_sw(Ks, 16 * kt, 0, lane), k1 = frag_row_sw(Ks, 16 * kt, 32, lane);
#pragma unroll
        for (int T = 0; T < 2; ++T) { s[T][kt] = MFMA16(k0, qf[T][0], s[T][kt]); s[T][kt] = MFMA16(k1, qf[T][1], s[T][kt]); }
    }
    float p[2][4][4]; bf16x8 pf[2][2];
#pragma unroll
    for (int T = 0; T < 2; ++T) {
        if (MASKED) {
#pragma unroll
            for (int kt = 0; kt < 4; ++kt)
#pragma unroll
                for (int r = 0; r < 4; ++r) {
                    const int key = 64 * j + 16 * kt + 4 * R.kq + r;
                    bool ok;
                    if (KIND == 0) ok = (16 * key + 31 <= R.t[T]);
                    else if (KIND == 1) ok = (key <= R.t[T]);
                    else ok = (key <= R.t[T]) && (R.t[T] - key < 512);
                    s[T][kt][r] = ok ? s[T][kt][r] : NEGINF;
                }
        }
        float ps = 0.f;
#pragma unroll
        for (int kt = 0; kt < 4; ++kt)
#pragma unroll
            for (int r = 0; r < 4; ++r) { p[T][kt][r] = __builtin_amdgcn_exp2f(s[T][kt][r]); if (MODE == 1) ps += p[T][kt][r]; }
        if (MODE == 1) lrow[T] += ps;
        if (MODE == 2) {
#pragma unroll
            for (int kt = 0; kt < 4; ++kt)
#pragma unroll
                for (int r = 0; r < 4; ++r) p[T][kt][r] *= invl[T];
        }
        if (MODE != 1) {
#pragma unroll
            for (int ks = 0; ks < 2; ++ks) { u32x4 w; w.x = cvt_pk_bf16(p[T][2 * ks][0], p[T][2 * ks][1]); w.y = cvt_pk_bf16(p[T][2 * ks][2], p[T][2 * ks][3]);
                w.z = cvt_pk_bf16(p[T][2 * ks + 1][0], p[T][2 * ks + 1][1]); w.w = cvt_pk_bf16(p[T][2 * ks + 1][2], p[T][2 * ks + 1][3]); pf[T][ks] = __builtin_bit_cast(bf16x8, w); }
            if (MODE == 0) {
                const u32x4 o1 = (u32x4){0x3f803f80u, 0x3f803f80u, 0x3f803f80u, 0x3f803f80u}; const bf16x8 ones = __builtin_bit_cast(bf16x8, o1);
                lacc[T] = MFMA16(ones, pf[T][0], lacc[T]); lacc[T] = MFMA16(ones, pf[T][1], lacc[T]); }
        }
    }
    if (MODE == 2) {
#pragma unroll
        for (int T = 0; T < 2; ++T)
#pragma unroll
            for (int kt = 0; kt < 4; ++kt) {
                float q4[4];
#pragma unroll
                for (int r = 0; r < 4; ++r) { float v = p[T][kt][r]; v += __shfl_xor(v, 1); v += __shfl_xor(v, 2); q4[r] = v; }
                if (R.hg == 0) { LAS float* ip = imp + (4 * T + R.ql) * 132 + 16 * j + 4 * kt + R.kq;
                    ip[0] += 2.f * (q4[0] + q4[1] + q4[2]) + q4[3]; asm volatile("" ::: "memory"); ip[1] += q4[3]; asm volatile("" ::: "memory"); }
            }
    }
    if (MODE != 1) {
#pragma unroll
        for (int dh = 0; dh < 2; ++dh) {
            bf16x8 vf[2][2];
            vtr_half(vf, vbase + voff[2 * dh][0], vbase + voff[2 * dh][1], vbase + voff[2 * dh + 1][0], vbase + voff[2 * dh + 1][1]);
#pragma unroll
            for (int T = 0; T < 2; ++T)
#pragma unroll
                for (int d2 = 0; d2 < 2; ++d2) { o[T][2 * dh + d2] = MFMA16(vf[d2][0], pf[T][0], o[T][2 * dh + d2]); o[T][2 * dh + d2] = MFMA16(vf[d2][1], pf[T][1], o[T][2 * dh + d2]); }
        }
    }
}
template <int MODE, int KIND>
__device__ __forceinline__ void nsa_pass(const Ctx& c, u64 mlo_, u64 mhi_, u64 wlo_, u64 whi_, const bf16_t* Kg, const bf16_t* Vg,
                                         const NsaRows& R, const bf16x8 (&qf)[2][2], float (&lrow)[2], const float (&invl)[2], f32x4 (&o)[2][4]) {
    f32x4 lacc[2] = {(f32x4){0.f, 0.f, 0.f, 0.f}, (f32x4){0.f, 0.f, 0.f, 0.f}};
    const u64 mlo = uni64(mlo_), mhi = uni64(mhi_), wlo = uni64(wlo_), whi = uni64(whi_);
    LAS unsigned char* ring = c.lds + NSA_RING; LAS unsigned char* Ps = nullptr;
    LAS float* imp = (LAS float*)(c.lds + NSA_IMP) + c.wave * 8 * 132;
    int lane = c.lane; asm volatile("" : "+v"(lane));
    constexpr int LPB = (MODE == 1) ? 1 : 2;
    const int drow = 8 * c.wave + (lane >> 3), dch = (lane & 7) ^ ((drow >> 1) & 7);
    const size_t goff = (size_t)drow * 64 + 8 * dch;
    unsigned voff[4][2];
    { const int g = lane >> 4, q = (lane & 15) >> 2, p = lane & 3;
#pragma unroll
      for (int dt = 0; dt < 4; ++dt)
#pragma unroll
          for (int h = 0; h < 2; ++h) { const int r = 4 * g + q + 16 * h, col = 16 * dt + 4 * p; voff[dt][h] = (unsigned)(r * 128 + (((col >> 3) ^ ((r >> 1) & 7)) << 4) + (col & 7) * 2); } }
    const unsigned ring_addr = (unsigned)(uintptr_t)ring;
#define NSA_ISSUE(jb, slot) do { \
        __builtin_amdgcn_global_load_lds((const unsigned*)(Kg + (size_t)(jb) * 4096 + goff), (LAS unsigned*)(ring + (slot) * NSA_SLOT + c.wave * 1024), 16, 0, 0); \
        if (MODE != 1) __builtin_amdgcn_global_load_lds((const unsigned*)(Vg + (size_t)(jb) * 4096 + goff), (LAS unsigned*)(ring + (slot) * NSA_SLOT + 8192 + c.wave * 1024), 16, 0, 0); } while (0)
    VM_WAIT();
    __builtin_amdgcn_s_barrier();
#define NSA_COMPUTE(jb, nth) do { if (bit128(wlo, whi, (jb))) { \
            const LAS unsigned char* Ks = ring + ((nth) % NSA_D) * NSA_SLOT; const unsigned vbase = ring_addr + (unsigned)(((nth) % NSA_D) * NSA_SLOT + 8192); \
            bool full; \
            if (KIND == 0) full = (16 * (64 * (jb) + 63) + 31 <= R.tmin); else if (KIND == 1) full = (64 * (jb) + 63 <= R.tmin); else full = (64 * (jb) + 63 <= R.tmin) && (R.tmax - 64 * (jb) < 512); \
            if (full) nsa_block<MODE, KIND, false>(Ks, vbase, voff, Ps, imp, (jb), lane, R, qf, lrow, lacc, invl, o); \
            else nsa_block<MODE, KIND, true>(Ks, vbase, voff, Ps, imp, (jb), lane, R, qf, lrow, lacc, invl, o); } } while (0)
    int ji = next_bit(mlo, mhi, 0), nissued = 0;
    for (int k = 0; k < 4 && ji >= 0; ++k) { NSA_ISSUE(ji, nissued % NSA_D); ++nissued; ji = next_bit(mlo, mhi, ji + 1); }
    int ja = next_bit(mlo, mhi, 0), ncomp = 0;
    while (ja >= 0) {
        const int jb = next_bit(mlo, mhi, ja + 1);
        const int target = ncomp + (jb >= 0 ? 2 : 1);
        wait_vm_n((nissued - target) * LPB);
        __builtin_amdgcn_s_barrier();
        for (int k = 0; k < 2 && ji >= 0; ++k) { NSA_ISSUE(ji, nissued % NSA_D); ++nissued; ji = next_bit(mlo, mhi, ji + 1); }
        NSA_COMPUTE(ja, ncomp);
        if (jb >= 0) NSA_COMPUTE(jb, ncomp + 1);
        ncomp = target; ja = (jb >= 0) ? next_bit(mlo, mhi, jb + 1) : -1;
    }
#undef NSA_COMPUTE
#undef NSA_ISSUE
    if (MODE == 0) { lrow[0] = lacc[0][0]; lrow[1] = lacc[1][0]; }
}

__device__ __forceinline__ void nsa_unit(const Ctx& c, unsigned char* ws, int b, int g, int qb) {
    const bf16_t* PROJ = (const bf16_t*)(ws + WS_PROJ); const bf16_t* KC = (const bf16_t*)(ws + WS_KC); const bf16_t* KV = (const bf16_t*)(ws + WS_KV); bf16_t* Y = (bf16_t*)(ws + WS_Y);
    const int lane = c.lane, w = c.wave, q0 = 64 * qb;
    NsaRows R; R.ql = (lane & 15) >> 2; R.hg = lane & 3; R.kq = lane >> 4; R.tmin = q0 + 8 * w; R.tmax = R.tmin + 7;
    const int tumax = q0 + 63, hq = 4 * g + R.hg;
    constexpr float QSC = 0.125f * 1.4426950408889634f;
    bf16x8 qf[2][2]; f32x4 o[2][4]; float lrow[2], invl[2]; unsigned glp[2], glq[2];
#pragma unroll
    for (int T = 0; T < 2; ++T) {
        R.t[T] = R.tmin + 4 * T + R.ql; R.selLo[T] = 0ull; R.selHi[T] = 0ull;
        const size_t mrow0 = (size_t)(b * SEQ + R.t[T]) * NPROJ;
#pragma unroll
        for (int ks = 0; ks < 2; ++ks) { const u32x4 v = *(const u32x4*)(PROJ + mrow0 + PC_Q + 64 * hq + 32 * ks + 8 * R.kq);
            u32x4 x; x.x = cvt_pk_bf16(bflo(v.x) * QSC, bfhi(v.x) * QSC); x.y = cvt_pk_bf16(bflo(v.y) * QSC, bfhi(v.y) * QSC);
            x.z = cvt_pk_bf16(bflo(v.z) * QSC, bfhi(v.z) * QSC); x.w = cvt_pk_bf16(bflo(v.w) * QSC, bfhi(v.w) * QSC);
            qf[T][ks] = __builtin_bit_cast(bf16x8, x); }
#pragma unroll
        for (int dt = 0; dt < 4; ++dt) o[T][dt] = (f32x4){0.f, 0.f, 0.f, 0.f};
        lrow[T] = 0.f; invl[T] = 0.f;
        { const bf16_t* gp = PROJ + mrow0 + PC_GL + hq * 3; glp[T] = (unsigned)gp[0] | ((unsigned)gp[1] << 16); glq[T] = (unsigned)gp[2]; }
    }
    LAS float* imp = (LAS float*)(c.lds + NSA_IMP) + w * 8 * 132;
    LAS u64* selm = (LAS u64*)(c.lds + NSA_SELM);
    __syncthreads();
    for (int i = lane; i < 8 * 132; i += 64) imp[i] = 0.f;
    const bf16_t* kc = KC + (size_t)((b * 2 + g) * 512) * 64; const bf16_t* vc = kc + (size_t)2048 * 64;
    const int ncu = (tumax >= 31) ? ((tumax - 31) / 16) / 64 + 1 : 0;
    const int ncw = (R.tmax >= 31) ? ((R.tmax - 31) / 16) / 64 + 1 : 0;
    const u64 cmu = ncu ? (ncu >= 64 ? ~0ull : ((1ull << ncu) - 1ull)) : 0ull, cmw = ncw ? (ncw >= 64 ? ~0ull : ((1ull << ncw) - 1ull)) : 0ull;
    nsa_pass<1, 0>(c, cmu, 0ull, cmw, 0ull, kc, kc, R, qf, lrow, invl, o);
#pragma unroll
    for (int T = 0; T < 2; ++T) { float lt = lrow[T]; lt += __shfl_xor(lt, 16); lt += __shfl_xor(lt, 32); invl[T] = lt > 0.f ? 1.0f / lt : 0.f; }
    nsa_pass<2, 0>(c, cmu, 0ull, cmw, 0ull, kc, vc, R, qf, lrow, invl, o);
#pragma unroll
    for (int T = 0; T < 2; ++T) { const float gt = __builtin_amdgcn_rcpf(1.0f + __expf(-bflo(glp[T])));
        bf16_t* yp = Y + (size_t)(b * SEQ + R.t[T]) * DM + 1024 + 64 * hq + 4 * R.kq;
#pragma unroll
        for (int dt = 0; dt < 4; ++dt) { const f32x4 v = o[T][dt] * gt; u32x2 pk; pk.x = cvt_pk_bf16(v[0], v[1]); pk.y = cvt_pk_bf16(v[2], v[3]); *(u32x2*)(yp + 16 * dt) = pk; o[T][dt] = (f32x4){0.f, 0.f, 0.f, 0.f}; } }
    asm volatile("s_waitcnt lgkmcnt(0)" ::: "memory");
    for (int qi = 0; qi < 2; ++qi) {
        unsigned key[4][2]; bool valid2[4][2];
#pragma unroll
        for (int z = 0; z < 4; ++z) { const int cur = (R.tmin + qi + 2 * z) >> 6;
#pragma unroll
            for (int e = 0; e < 2; ++e) { const int jj = lane + 64 * e; valid2[z][e] = jj <= cur; const bool forced = (jj == 0) || (jj == cur) || (jj == cur - 1);
                const float v = imp[(qi + 2 * z) * 132 + jj] + (forced ? 1000.f : 0.f); key[z][e] = valid2[z][e] ? __float_as_uint(v) + 1u : 0u; } }
        unsigned T[4] = {0u, 0u, 0u, 0u};
        for (int bit = 31; bit >= 0; --bit) {
#pragma unroll
            for (int z = 0; z < 4; ++z) { const unsigned cand = T[z] | (1u << bit);
                const int cnt = __builtin_popcountll(__ballot(key[z][0] >= cand)) + __builtin_popcountll(__ballot(key[z][1] >= cand)); if (cnt >= 16) T[z] = cand; } }
        const u64 below = (1ull << lane) - 1ull;
#pragma unroll
        for (int z = 0; z < 4; ++z) {
            const u64 gt0 = __ballot(key[z][0] > T[z]), gt1 = __ballot(key[z][1] > T[z]), eq0 = __ballot(valid2[z][0] && key[z][0] == T[z]), eq1 = __ballot(valid2[z][1] && key[z][1] == T[z]);
            const int need = 16 - __builtin_popcountll(gt0) - __builtin_popcountll(gt1);
            const int re0 = __builtin_popcountll(eq0 & below), re1 = __builtin_popcountll(eq0) + __builtin_popcountll(eq1 & below);
            const u64 lo = __ballot(valid2[z][0] && (key[z][0] > T[z] || (key[z][0] == T[z] && re0 < need))), hi = __ballot(valid2[z][1] && (key[z][1] > T[z] || (key[z][1] == T[z] && re1 < need)));
            if (lane == 0) { selm[(8 * w + qi + 2 * z) * 2] = lo; selm[(8 * w + qi + 2 * z) * 2 + 1] = hi; } }
    }
    __syncthreads();
    u64 ulo = 0ull, uhi = 0ull, wlo = 0ull, whi = 0ull;
#pragma unroll 8
    for (int q = 0; q < 64; ++q) { const u64 a = selm[2 * q], bb = selm[2 * q + 1]; ulo |= a; uhi |= bb; if ((q >> 3) == w) { wlo |= a; whi |= bb; } }
#pragma unroll
    for (int T = 0; T < 2; ++T) { R.selLo[T] = selm[(8 * w + 4 * T + R.ql) * 2]; R.selHi[T] = selm[(8 * w + 4 * T + R.ql) * 2 + 1]; lrow[T] = 0.f; }
    nsa_pass<0, 1>(c, ulo, uhi, wlo, whi, KV + (size_t)((2 * 2 + b) * 2 + g) * 8192 * 64, KV + (size_t)((3 * 2 + b) * 2 + g) * 8192 * 64, R, qf, lrow, invl, o);
#pragma unroll
    for (int T = 0; T < 2; ++T) { const float lt = lrow[T]; lrow[T] = 0.f;
        const float gt = __builtin_amdgcn_rcpf(1.0f + __expf(-bfhi(glp[T]))); const float sc = lt > 0.f ? gt / lt : 0.f;
        bf16_t* yp = Y + (size_t)(b * SEQ + R.t[T]) * DM + 1024 + 64 * hq + 4 * R.kq;
#pragma unroll
        for (int dt = 0; dt < 4; ++dt) { const f32x4 v = o[T][dt] * sc; const u32x2 y0 = *(const u32x2*)(yp + 16 * dt); u32x2 pk; pk.x = cvt_pk_bf16(bflo(y0.x) + v[0], bfhi(y0.x) + v[1]); pk.y = cvt_pk_bf16(bflo(y0.y) + v[2], bfhi(y0.y) + v[3]);
            *(u32x2*)(yp + 16 * dt) = pk; o[T][dt] = (f32x4){0.f, 0.f, 0.f, 0.f}; } }
    {
        const int jhi = tumax >> 6, jlo = (q0 - 511) > 0 ? ((q0 - 511) >> 6) : 0;
        const int wjhi = R.tmax >> 6, wjlo = (R.tmin - 511) > 0 ? ((R.tmin - 511) >> 6) : 0;
        u64 alo = 0ull, ahi = 0ull, blo = 0ull, bhi = 0ull;
        for (int jj = jlo; jj <= jhi; ++jj) { if (jj < 64) alo |= 1ull << jj; else ahi |= 1ull << (jj - 64); }
        for (int jj = wjlo; jj <= wjhi; ++jj) { if (jj < 64) blo |= 1ull << jj; else bhi |= 1ull << (jj - 64); }
        nsa_pass<0, 2>(c, alo, ahi, blo, bhi, KV + (size_t)((4 * 2 + b) * 2 + g) * 8192 * 64, KV + (size_t)((5 * 2 + b) * 2 + g) * 8192 * 64, R, qf, lrow, invl, o);
#pragma unroll
        for (int T = 0; T < 2; ++T) { const float lt = lrow[T];
            const float gt = __builtin_amdgcn_rcpf(1.0f + __expf(-bflo(glq[T]))); const float sc = lt > 0.f ? gt / lt : 0.f;
            bf16_t* yp = Y + (size_t)(b * SEQ + R.t[T]) * DM + 1024 + 64 * hq + 4 * R.kq;
#pragma unroll
            for (int dt = 0; dt < 4; ++dt) { const f32x4 v = o[T][dt] * sc; const u32x2 y0 = *(const u32x2*)(yp + 16 * dt); u32x2 pk; pk.x = cvt_pk_bf16(bflo(y0.x) + v[0], bfhi(y0.x) + v[1]); pk.y = cvt_pk_bf16(bflo(y0.y) + v[2], bfhi(y0.y) + v[3]);
                *(u32x2*)(yp + 16 * dt) = pk; } }
    }
}

#ifndef PH5_MASK
#define PH5_MASK 31
#endif
#ifndef WGM_IN
#define WGM_IN 4
#endif
#ifndef WGM_GU
#define WGM_GU 4
#endif
#ifndef WGM_N8
#define WGM_N8 2
#endif
#ifndef DUP5A
#define DUP5A 0
#endif
#ifndef DUP5C
#define DUP5C 0
#endif
#ifndef DUP7A
#define DUP7A 0
#endif
#ifndef DUP7B
#define DUP7B 0
#endif
#ifndef DUP_MASK
#define DUP_MASK 0
#endif
#ifndef PH_MASK
#define PH_MASK 0x1fff
#endif
constexpr int NPH = 13;
struct Params { const float* in[31]; float* out; unsigned char* ws; int l_lo, l_hi, p_lo, p_hi; };
enum { I_X = 0, I_F1PRE, I_F1GU, I_F1D, I_F1POST, I_MPRE, I_WIN, I_SCW, I_SCB, I_SDTB, I_SALOG, I_SD, I_SNW, I_KPE, I_KW1, I_KB1, I_KW2, I_VPE, I_VW1, I_VB1, I_VW2,
       I_CW, I_CB, I_CLW, I_CLB, I_WOUT, I_MPOST, I_F2PRE, I_F2GU, I_F2D, I_F2POST };

template <int l>
__device__ __forceinline__ void run_layer(const Ctx& c, const Params& P, const XcdBarrier& bar, unsigned char* ws) {
    bf16_t* U = (bf16_t*)(ws + WS_U); bf16_t* T = (bf16_t*)(ws + WS_T); bf16_t* HID = (bf16_t*)(ws + WS_HID); bf16_t* PROJ = (bf16_t*)(ws + WS_PROJ); bf16_t* Y = (bf16_t*)(ws + WS_Y);
    float* RS = (float*)(ws + WS_RS);
    {
        const int plo = (l == P.l_lo) ? P.p_lo : 0, phi = (l == P.l_hi - 1) ? P.p_hi : NPH;
#define IN(k) (((PH_MASK >> (k)) & 1) && plo <= (k) && (k) < phi)
#define REPS(k) ((((DUP_MASK) >> (k)) & 1) ? 2 : 1)
#define SEAM(k) do { if (!(l == P.l_hi - 1 && (k) == P.p_hi - 1)) xcd_barrier(bar); } while (0)
        if (IN(0) && l == 0) _Pragma("unroll") for (int rep = 0; rep < REPS(0); ++rep) {
            LayerW LW; LW.gu1 = P.in[I_F1GU] + (size_t)l * DM * 2 * DFF; LW.d1 = P.in[I_F1D] + (size_t)l * DFF * DM; LW.gu2 = P.in[I_F2GU] + (size_t)l * DM * 2 * DFF; LW.d2 = P.in[I_F2D] + (size_t)l * DFF * DM;
            LW.win = P.in[I_WIN] + (size_t)l * DM * DIN; LW.wout = P.in[I_WOUT] + (size_t)l * DM * DM; LW.w1k = P.in[I_KW1] + (size_t)l * 2048 * 256; LW.w1v = P.in[I_VW1] + (size_t)l * 2048 * 256;
            LW.kpe = P.in[I_KPE] + (size_t)l * 2048; LW.vpe = P.in[I_VPE] + (size_t)l * 2048; LW.pre1 = P.in[I_F1PRE] + l * DM; LW.prem = P.in[I_MPRE] + l * DM; LW.pre2 = P.in[I_F2PRE] + l * DM;
            phase_convert(c, LW, ws);
            if (l == 0) {
                phase_norm(c, P.in[I_X], nullptr, 0.f, nullptr, U, RS, nullptr);
                for (int i = c.bid * NTHR + c.tid; i < 65536; i += c.G * NTHR) ((u32x4*)(ws + WS_KV + 6 * 4 * 8192 * 64 * 2))[i] = (u32x4){0u, 0u, 0u, 0u};
            }
            SEAM(0);
        }
        if (IN(1)) _Pragma("unroll") for (int rep = 0; rep < REPS(1); ++rep) {
            pg8::Gemm g{U, (const bf16_t*)(ws + WS_WGU1), M, 2 * DFF, DM, DM, 128, 0}; pg8::StaticOrder S; S.init(M, 2 * DFF, c.G, c.bid, WGM_GU);
            pg8::EpiSwiglu E{HID, DFF, RS};
            pg8::gemm_phase<pg8::EpiSwiglu, pg8::StaticOrder, true, true>(c.lds, g, S, E);
            SEAM(1);
        }
        if (IN(2)) _Pragma("unroll") for (int rep = 0; rep < REPS(2); ++rep) {
            pg8::Gemm g{HID, (const bf16_t*)(ws + WS_WD1), M, DM, DFF, DFF, 128, 0}; pg8::StaticOrder S; S.init(M, DM, c.G, c.bid, WGM_N8);
            pg8::EpiStore E{T, DM};
            pg8::gemm_phase<pg8::EpiStore, pg8::StaticOrder, true, true>(c.lds, g, S, E);
            SEAM(2);
        }
        if (IN(3)) { phase_norm(c, nullptr, T, 0.5f, P.in[I_F1POST] + l * DM, U, RS, nullptr); SEAM(3); }
        if (IN(4)) _Pragma("unroll") for (int rep = 0; rep < REPS(4); ++rep) {
            pg8::Gemm g{U, (const bf16_t*)(ws + WS_WIN), M, NPROJ, DM, DM, 128, 0}; pg8::StaticOrder S; S.init(M, NPROJ, c.G, c.bid, WGM_IN);
            pg8::EpiProj E{PROJ, NPROJ, (bf16_t*)(ws + WS_KV), RS};
            pg8::gemm_phase<pg8::EpiProj, pg8::StaticOrder, true, true>(c.lds, g, S, E);
            SEAM(4);
        }
        SsdW SW; SW.conv_w = P.in[I_SCW] + (size_t)l * 4 * 1536; SW.conv_b = P.in[I_SCB] + l * 1536; SW.dt_bias = P.in[I_SDTB] + l * 16; SW.a_log = P.in[I_SALOG] + l * 16; SW.dskip = P.in[I_SD] + l * 16; SW.norm_w = P.in[I_SNW] + l * 1024;
        if (IN(5)) _Pragma("unroll") for (int rep = 0; rep < REPS(5); ++rep) {
            if (PH5_MASK & 1) for (int u = c.bid; u < 256 * (1 + DUP5A); u += c.G) ssd_a_unit(c, SW, ws, u & 255);
            if ((PH5_MASK & 2) && c.bid < 16) { const int cu = c.bid;
                const int kv = cu >> 3, pm = cu & 7;
                __syncthreads();
                pg8::Gemm g{(const bf16_t*)(ws + WS_KV) + (size_t)kv * 4 * 8192 * 64, (const bf16_t*)(ws + WS_W1) + (size_t)kv * 256 * DM, 2048, 256, 2048, 1024, 128, 0};
                pg8::OneUnit S; S.u0.pm = pm; S.u0.pn = 0;
                bf16_t* H1 = (bf16_t*)(ws + WS_H1) + (size_t)kv * 2048 * 256;
                LAS float* biasS = (LAS float*)(c.lds + 131072);
                if (c.tid < 256) { const float* b1 = (kv ? P.in[I_VB1] : P.in[I_KB1]) + l * 256; const float* pep = (const float*)(ws + WS_PEP) + kv * 256 * 256;
                    float sb = b1[c.tid];
#pragma unroll 8
                    for (int q = 0; q < 256; ++q) sb += pep[q * 256 + c.tid];
                    biasS[c.tid] = sb; }
                __syncthreads();
                pg8::EpiBiasSilu E{H1, 256, biasS};
                pg8::gemm_phase<pg8::EpiBiasSilu, pg8::OneUnit, false, true>(c.lds, g, S, E);
                nsa_cmp2(c, (kv ? P.in[I_VW2] : P.in[I_KW2]) + (size_t)l * 256 * 64, H1, (bf16_t*)(ws + WS_KC) + (size_t)kv * 2048 * 64, pm);
            }
            CnvW CW; CW.dw_w = P.in[I_CW] + (size_t)l * 31 * 512; CW.dw_b = P.in[I_CB] + l * 512; CW.ln_w = P.in[I_CLW] + l * 512; CW.ln_b = P.in[I_CLB] + l * 512;
            if (PH5_MASK & 4) { if (c.G > 32) { if (c.bid >= 16) for (int u = c.bid - 16; u < 512 * (1 + DUP5C); u += c.G - 16) cnv_unit(c, CW, ws, u & 511); }
            else for (int u = c.bid; u < 512; u += c.G) cnv_unit(c, CW, ws, u); }
            SEAM(5);
        }
        const bool split67 = IN(6) && IN(7);
        if (IN(6)) { phase_ssd_scan(c, ws); if (split67) xcd_barrier_arrive(bar); else SEAM(6); }
        if (IN(7)) _Pragma("unroll") for (int rep = 0; rep < REPS(7); ++rep) {
            if (PH5_MASK & 16) for (int v0 = c.bid; v0 < 256 * (1 + DUP7B); v0 += c.G) { const int v = v0 & 255;
                const int bg = v & 3, jq = v >> 2;
                for (int e = 0; e < 2; ++e) { const int qb = (e == 0) ? 127 - jq : jq; nsa_unit(c, ws, bg >> 1, bg & 1, qb); }
            }
            if (split67 && rep == 0) xcd_barrier_wait(bar);
            if (PH5_MASK & 8) for (int u = c.bid; u < 256 * (1 + DUP7A); u += c.G) ssd_b_unit(c, SW, ws, u & 255);
            SEAM(7);
        }
        if (IN(8)) _Pragma("unroll") for (int rep = 0; rep < REPS(8); ++rep) {
            pg8::Gemm g{Y, (const bf16_t*)(ws + WS_WOUT), M, DM, DM, DM, 128, 0}; pg8::StaticOrder S; S.init(M, DM, c.G, c.bid, WGM_N8);
            pg8::EpiStore E{T, DM};
            pg8::gemm_phase<pg8::EpiStore, pg8::StaticOrder, true, true>(c.lds, g, S, E);
            SEAM(8);
        }
        if (IN(9)) { phase_norm(c, nullptr, T, 1.0f, P.in[I_MPOST] + l * DM, U, RS, nullptr); SEAM(9); }
        if (IN(10)) _Pragma("unroll") for (int rep = 0; rep < REPS(10); ++rep) {
            pg8::Gemm g{U, (const bf16_t*)(ws + WS_WGU2), M, 2 * DFF, DM, DM, 128, 0}; pg8::StaticOrder S; S.init(M, 2 * DFF, c.G, c.bid, WGM_GU);
            pg8::EpiSwiglu E{HID, DFF, RS};
            pg8::gemm_phase<pg8::EpiSwiglu, pg8::StaticOrder, true, true>(c.lds, g, S, E);
            SEAM(10);
        }
        if (IN(11)) _Pragma("unroll") for (int rep = 0; rep < REPS(11); ++rep) {
            pg8::Gemm g{HID, (const bf16_t*)(ws + WS_WD2), M, DM, DFF, DFF, 128, 0}; pg8::StaticOrder S; S.init(M, DM, c.G, c.bid, WGM_N8);
            pg8::EpiStore E{T, DM};
            pg8::gemm_phase<pg8::EpiStore, pg8::StaticOrder, true, true>(c.lds, g, S, E);
            SEAM(11);
        }
        if (IN(12)) {
            phase_norm(c, nullptr, T, 0.5f, P.in[I_F2POST] + l * DM, U, RS, (l + 1 < DEPTH) ? nullptr : P.out);
            if (l + 1 < DEPTH) {
                const int n = l + 1;
                LayerW LW; LW.gu1 = P.in[I_F1GU] + (size_t)n * DM * 2 * DFF; LW.d1 = P.in[I_F1D] + (size_t)n * DFF * DM; LW.gu2 = P.in[I_F2GU] + (size_t)n * DM * 2 * DFF; LW.d2 = P.in[I_F2D] + (size_t)n * DFF * DM;
                LW.win = P.in[I_WIN] + (size_t)n * DM * DIN; LW.wout = P.in[I_WOUT] + (size_t)n * DM * DM; LW.w1k = P.in[I_KW1] + (size_t)n * 2048 * 256; LW.w1v = P.in[I_VW1] + (size_t)n * 2048 * 256;
                LW.kpe = P.in[I_KPE] + (size_t)n * 2048; LW.vpe = P.in[I_VPE] + (size_t)n * 2048; LW.pre1 = P.in[I_F1PRE] + n * DM; LW.prem = P.in[I_MPRE] + n * DM; LW.pre2 = P.in[I_F2PRE] + n * DM;
                phase_convert(c, LW, ws);
            }
            SEAM(12);
        }
#undef IN
#undef SEAM
    }
}

__global__ void __launch_bounds__(NTHR, 2) mega_fwd(Params P) {
    extern __shared__ __attribute__((aligned(16))) unsigned char lds_raw[];
    Ctx c; c.lds = (LAS unsigned char*)lds_raw; c.tid = threadIdx.x; c.lane = c.tid & 63; c.wave = __builtin_amdgcn_readfirstlane(c.tid >> 6); c.G = gridDim.x; c.bid = blockIdx.x;
    unsigned char* ws = P.ws;
    volatile LAS unsigned* MISC = (volatile LAS unsigned*)(c.lds + LDS_CTL_OFF);
    if (c.tid < 32) MISC[c.tid] = 0u;
    __syncthreads();
    const bool multi = !((P.l_hi - P.l_lo) == 1 && (P.p_hi - P.p_lo) == 1);
    XcdBarrier bar; bar.bar = (unsigned*)(ws + WS_CTL) + 4096; bar.x = 0; bar.st = MISC + 8;
    if (multi) bar = xcd_barrier_post((unsigned*)(ws + WS_CTL) + 4096, MISC + 8);

    if (0 >= P.l_lo && 0 < P.l_hi) run_layer<0>(c, P, bar, ws);
    if (1 >= P.l_lo && 1 < P.l_hi) run_layer<1>(c, P, bar, ws);
    if (2 >= P.l_lo && 2 < P.l_hi) run_layer<2>(c, P, bar, ws);
    if (3 >= P.l_lo && 3 < P.l_hi) run_layer<3>(c, P, bar, ws);
}

extern "C" void kernel_launch(void* const* d_in, const int* in_sizes, int n_in, void* d_out, int out_size, void* d_ws, size_t ws_size, hipStream_t stream) {
    static int grid = 0;
    if (grid == 0) {
        if (n_in != 31 || in_sizes[0] != M * DM || out_size != M * DM || ws_size < WS_END) { fprintf(stderr, "kernel_launch: unexpected shapes (n_in %d, in0 %d, out %d, ws %zu); nothing launched\n", n_in, n_in > 0 ? in_sizes[0] : -1, out_size, ws_size); grid = -1; return; }
        int dev = 0, cus = 0, per_cu = 0;
        if (hipGetDevice(&dev) != hipSuccess || hipDeviceGetAttribute(&cus, hipDeviceAttributeMultiprocessorCount, dev) != hipSuccess) { grid = -1; return; }
        if (hipFuncSetAttribute((const void*)mega_fwd, hipFuncAttributeMaxDynamicSharedMemorySize, LDS_BYTES) != hipSuccess) { fprintf(stderr, "kernel_launch: hipFuncSetAttribute failed\n"); grid = -1; return; }
        if (hipOccupancyMaxActiveBlocksPerMultiprocessor(&per_cu, (const void*)mega_fwd, NTHR, LDS_BYTES) != hipSuccess || per_cu < 1) { fprintf(stderr, "kernel_launch: occupancy query says %d\n", per_cu); per_cu = 1; }
        (void)hipGetLastError();
        grid = cus;
    }
    if (grid < 0) return;
    if (hipMemsetAsync((char*)d_ws + WS_CTL, 0, CTL_ZERO_BYTES, stream) != hipSuccess) return;
    Params p{};
    for (int i = 0; i < 31; ++i) p.in[i] = (const float*)d_in[i];
    p.out = (float*)d_out; p.ws = (unsigned char*)d_ws;
#if MK_PER_PHASE
    for (int l = 0; l < DEPTH; ++l)
        for (int k = 0; k < NPH; ++k) { p.l_lo = l; p.l_hi = l + 1; p.p_lo = k; p.p_hi = k + 1; hipLaunchKernelGGL(mega_fwd, dim3(grid), dim3(NTHR), LDS_BYTES, stream, p); }
#else
    p.l_lo = 0; p.l_hi = DEPTH; p.p_lo = 0; p.p_hi = NPH;
    hipLaunchKernelGGL(mega_fwd, dim3(grid), dim3(NTHR), LDS_BYTES, stream, p);
#endif
}
```

```cpp
#include <hip/hip_runtime.h>
#include <cstdio>
#include <cstdint>
#include <cmath>

#ifndef MK_PER_PHASE
#define MK_PER_PHASE 0
#endif

#define LAS __attribute__((address_space(3)))
#define GAS __attribute__((address_space(1)))

namespace pg8 {
#define PG8_LAS __attribute__((address_space(3)))
typedef unsigned short bf16_t;
typedef short bf16x8 __attribute__((ext_vector_type(8)));
typedef float f32x4 __attribute__((ext_vector_type(4)));
typedef unsigned u32x4 __attribute__((ext_vector_type(4)));
constexpr int BM = 256, BK = 64, HALF = 128, HTB = HALF * BK * 2  , STAGE_BYTES = 8 * HTB, NXCD = 8, WGM = 4;

__host__ __device__ __forceinline__ int lds_byte(int r, int c) { const int st = (r >> 4) * 2 + (c >> 5), rr = r & 15, cc = c & 31, ob = rr * 64 + cc * 2; return st * 1024 + (ob ^ (((ob >> 9) & 1) << 5)); }
__host__ __device__ __forceinline__ void stage_rc(int b, int& R, int& C) { const int st = b / 1024, sb = b % 1024, swz = sb ^ (((sb >> 9) & 1) << 5); R = (st >> 1) * 16 + swz / 64; C = (st & 1) * 32 + (swz % 64) / 2; }
__host__ __device__ __forceinline__ int perm32(int rho) { const int n = rho >> 4, i = rho & 15; return 8 * (i >> 2) + 4 * n + (i & 3); }

struct Unit { int pm, pn; };

struct StaticOrder {
    int nM, nN, nwg, G, c, wgm;
    __host__ __device__ void init(int M, int N, int G_, int c_, int wgm_ = WGM) { nM = M / BM; nN = N / BM; nwg = nM * nN; G = G_; c = c_; wgm = wgm_; }
    __host__ __device__ bool next(int i, Unit& u) const {
        const long L = (long)i * G + c; if (L >= nwg) return false;
        int wgid = (int)L; { const int q = nwg / NXCD, r = nwg % NXCD, xcd = wgid % NXCD, off = wgid / NXCD; wgid = (xcd < r ? xcd * (q + 1) : r * (q + 1) + (xcd - r) * q) + off; }
        const int nig = wgm * nN, gid = wgid / nig, fm = gid * wgm, gsz = (nM - fm) < wgm ? (nM - fm) : wgm;
        u.pm = fm + ((wgid % nig) % gsz); u.pn = (wgid % nig) / gsz; return true;
    }
    __device__ __forceinline__ void a_ready(const Unit&) const {}
    __device__ __forceinline__ void done(const Unit&) const {}
};


struct Gemm { const bf16_t* A; const bf16_t* Bt; int M, N, K; int lda; int kstepA; int amode;
    __device__ __forceinline__ size_t abase(int pm) const {
        if (amode == 0) return (size_t)pm * BM * (size_t)lda * 2;
        return ((size_t)((pm >> 2) * 8192 + (pm & 1) * 4096) * 5120 + (size_t)((pm >> 1) & 1) * 64) * 2;
    }
};
struct OneUnit {
    Unit u0;
    __device__ __forceinline__ bool next(int i, Unit& u) const { if (i != 0) return false; u = u0; return true; }
    __device__ __forceinline__ void a_ready(const Unit&) const {}
    __device__ __forceinline__ void done(const Unit&) const {}
};

typedef float f32x2_t __attribute__((ext_vector_type(2))); typedef __bf16 bf16x2_t __attribute__((ext_vector_type(2)));
__device__ __forceinline__ unsigned cvt_pk_bf16(float lo, float hi) { const f32x2_t v = {lo, hi}; const bf16x2_t b = __builtin_convertvector(v, bf16x2_t); return __builtin_bit_cast(unsigned, b); }
__device__ __forceinline__ float silu_f(float x) { return x * __builtin_amdgcn_rcpf(1.0f + __expf(-x)); }

struct EpiStore {
    static constexpr bool PERM = true, AFTER_DRAIN = false, ROWSCALE = false;
    bf16_t* O; int ldc;
    __device__ __forceinline__ void operator()(const f32x4 (&acc)[2][2][4][2], const Unit& u, int wr, int wc, int fr, int fq, const PG8_LAS float* rsl) const {
        const int row0 = u.pm * BM + wr * 64 + fr, col0 = u.pn * BM + wc * 32 + 8 * fq;
#pragma unroll
        for (int ai = 0; ai < 2; ++ai)
#pragma unroll
            for (int m = 0; m < 4; ++m) { bf16_t* rowp = O + (size_t)(row0 + ai * HALF + m * 16) * ldc + col0;
#pragma unroll
                for (int bj = 0; bj < 2; ++bj) { const f32x4 v0 = acc[ai][bj][m][0], v1 = acc[ai][bj][m][1];
                    u32x4 w; w.x = cvt_pk_bf16(v0[0], v0[1]); w.y = cvt_pk_bf16(v0[2], v0[3]); w.z = cvt_pk_bf16(v1[0], v1[1]); w.w = cvt_pk_bf16(v1[2], v1[3]);
                    *(u32x4*)(rowp + bj * HALF) = w; } }
    }
};
struct EpiProj {
    static constexpr bool PERM = true, AFTER_DRAIN = false, ROWSCALE = true;
    bf16_t* O; int ldc; bf16_t* KV; const float* rs;
    __device__ __forceinline__ void operator()(const f32x4 (&acc)[2][2][4][2], const Unit& u, int wr, int wc, int fr, int fq, const PG8_LAS float* rsl) const {
        const bool kvt = (u.pn >= 16 && u.pn <= 18);
        const int pitch = kvt ? 64 : ldc;
        const int rloc = (kvt ? ((u.pm * BM) & 8191) : u.pm * BM) + wr * 64 + fr;
        bf16_t* base[2];
#pragma unroll
        for (int bj = 0; bj < 2; ++bj)
            base[bj] = kvt ? KV + (size_t)((((u.pn - 16) * 2 + bj) * 2 + ((u.pm * BM) >> 13)) * 2 + (wc >> 1)) * 8192 * 64 + (wc & 1) * 32 + 8 * fq
                           : O + u.pn * BM + bj * HALF + wc * 32 + 8 * fq;
#pragma unroll
        for (int ai = 0; ai < 2; ++ai)
#pragma unroll
            for (int m = 0; m < 4; ++m) { const size_t roff = (size_t)(rloc + ai * HALF + m * 16) * pitch; const float r = rsl[wr * 64 + fr + ai * HALF + m * 16];
#pragma unroll
                for (int bj = 0; bj < 2; ++bj) { const f32x4 v0 = acc[ai][bj][m][0] * r, v1 = acc[ai][bj][m][1] * r;
                    u32x4 w; w.x = cvt_pk_bf16(v0[0], v0[1]); w.y = cvt_pk_bf16(v0[2], v0[3]); w.z = cvt_pk_bf16(v1[0], v1[1]); w.w = cvt_pk_bf16(v1[2], v1[3]);
                    *(u32x4*)(base[bj] + roff) = w; } }
    }
};
struct EpiSwiglu {
    static constexpr bool PERM = true, AFTER_DRAIN = false, ROWSCALE = true;
    bf16_t* O; int ldc; const float* rs;
    __device__ __forceinline__ void operator()(const f32x4 (&acc)[2][2][4][2], const Unit& u, int wr, int wc, int fr, int fq, const PG8_LAS float* rsl) const {
        const int row0 = u.pm * BM + wr * 64 + fr, col0 = u.pn * HALF + wc * 32 + 8 * fq;
#pragma unroll
        for (int ai = 0; ai < 2; ++ai)
#pragma unroll
            for (int m = 0; m < 4; ++m) { bf16_t* rowp = O + (size_t)(row0 + ai * HALF + m * 16) * ldc + col0; const float r = rsl[wr * 64 + fr + ai * HALF + m * 16];
                const f32x4 g0 = acc[ai][0][m][0] * r, g1 = acc[ai][0][m][1] * r, v0 = acc[ai][1][m][0] * r, v1 = acc[ai][1][m][1] * r;
                u32x4 w;
                w.x = cvt_pk_bf16(silu_f(g0[0]) * v0[0], silu_f(g0[1]) * v0[1]); w.y = cvt_pk_bf16(silu_f(g0[2]) * v0[2], silu_f(g0[3]) * v0[3]);
                w.z = cvt_pk_bf16(silu_f(g1[0]) * v1[0], silu_f(g1[1]) * v1[1]); w.w = cvt_pk_bf16(silu_f(g1[2]) * v1[2], silu_f(g1[3]) * v1[3]);
                *(u32x4*)rowp = w; }
    }
};
struct EpiBiasSilu {
    static constexpr bool PERM = true, AFTER_DRAIN = false, ROWSCALE = false;
    bf16_t* O; int ldc; const PG8_LAS float* bias;
    __device__ __forceinline__ void operator()(const f32x4 (&acc)[2][2][4][2], const Unit& u, int wr, int wc, int fr, int fq, const PG8_LAS float* rsl) const {
        const int row0 = u.pm * BM + wr * 64 + fr, col0 = u.pn * BM + wc * 32 + 8 * fq;
#pragma unroll
        for (int bj = 0; bj < 2; ++bj) {
            const f32x4 b0 = *(const PG8_LAS f32x4*)(bias + col0 + bj * HALF), b1 = *(const PG8_LAS f32x4*)(bias + col0 + bj * HALF + 4);
#pragma unroll
            for (int ai = 0; ai < 2; ++ai)
#pragma unroll
                for (int m = 0; m < 4; ++m) { bf16_t* rowp = O + (size_t)(row0 + ai * HALF + m * 16) * ldc + col0 + bj * HALF;
                    const f32x4 v0 = acc[ai][bj][m][0] + b0, v1 = acc[ai][bj][m][1] + b1;
                    u32x4 w; w.x = cvt_pk_bf16(silu_f(v0[0]), silu_f(v0[1])); w.y = cvt_pk_bf16(silu_f(v0[2]), silu_f(v0[3]));
                    w.z = cvt_pk_bf16(silu_f(v1[0]), silu_f(v1[1])); w.w = cvt_pk_bf16(silu_f(v1[2]), silu_f(v1[3]));
                    *(u32x4*)rowp = w; }
        }
    }
};

template <class Epi, class Sched, bool ALIGN_EPI = false, bool SP2 = false>
__device__ __forceinline__ void gemm_phase(PG8_LAS unsigned char* lds, const Gemm g, const Sched& S, const Epi& E) {
    const int tid = threadIdx.x, wid = __builtin_amdgcn_readfirstlane(tid >> 6), lane = tid & 63, wr = wid >> 2, wc = wid & 3, fr = lane & 15, fq = lane >> 4;
    const int K = g.K, nt = K / BK;
    unsigned voffA[2], voffB[2];
#pragma unroll
    for (int i = 0; i < 2; ++i) { int R, C; stage_rc(tid * 16 + i * 8192, R, C); const int Rb = Epi::PERM ? ((R & ~31) + perm32(R & 31)) : R;
        voffA[i] = (unsigned)(R * g.lda + C) * 2u; voffB[i] = (unsigned)(Rb * K + C) * 2u; }
    const size_t kstepB = (size_t)(BK * 2), kstepA = (size_t)g.kstepA;
    const size_t hstepB = (size_t)HALF * K * 2, hstepA = (size_t)HALF * g.lda * 2;
    const size_t tstepB = 2 * hstepB;
    const unsigned ldsw = (unsigned)wid * 1024u;
    const int aoff = lds_byte(wr * 64 + fr, fq * 8), boff = lds_byte(wc * 32 + fr, fq * 8);
#define PG8_SA(b, h) (((b) * 2 + (h)) * HTB)
#define PG8_RSL (8 * HTB + 1024)
#define PG8_SB(b, h) ((4 + (b) * 2 + (h)) * HTB)
#define PG8_STAGE(bufoff, gbase, voff) do { _Pragma("unroll") for (int _i = 0; _i < 2; ++_i) \
        __builtin_amdgcn_global_load_lds((const unsigned*)((const char*)(gbase) + (voff)[_i]), (PG8_LAS unsigned*)(lds + (bufoff) + ldsw + _i * 8192), 16, 0, 0); } while (0)
#define PG8_LDA(dst, b, h) do { _Pragma("unroll") for (int m = 0; m < 4; ++m) _Pragma("unroll") for (int k = 0; k < 2; ++k) dst[m][k] = *(const PG8_LAS bf16x8*)(lds + PG8_SA(b, h) + aoff + m * 2048 + k * 1024); } while (0)
#define PG8_LDB(dst, b, h) do { _Pragma("unroll") for (int n = 0; n < 2; ++n) _Pragma("unroll") for (int k = 0; k < 2; ++k) dst[n][k] = *(const PG8_LAS bf16x8*)(lds + PG8_SB(b, h) + boff + n * 2048 + k * 1024); } while (0)
#define PG8_MMA(ai, bj, At, Bt) do { __builtin_amdgcn_s_setprio(1); _Pragma("unroll") for (int m = 0; m < 4; ++m) _Pragma("unroll") for (int n = 0; n < 2; ++n) _Pragma("unroll") for (int k = 0; k < 2; ++k) \
        acc[ai][bj][m][n] = __builtin_amdgcn_mfma_f32_16x16x32_bf16(Bt[n][k], At[m][k], acc[ai][bj][m][n], 0, 0, 0); __builtin_amdgcn_s_setprio(0); } while (0)
#define PG8_WAIT_V(n) asm volatile("s_waitcnt vmcnt(" #n ")" ::: "memory")
#define PG8_WAIT_L(n) asm volatile("s_waitcnt lgkmcnt(" #n ")" ::: "memory")
#define PG8_BAR __builtin_amdgcn_s_barrier()
#define PG8_SCHED __builtin_amdgcn_sched_barrier(0)
    Unit cur, nxt; int ui = 0;
    if (!S.next(0, cur)) return;
    f32x4 acc[2][2][4][2];
#pragma unroll
    for (int a = 0; a < 2; ++a)
#pragma unroll
        for (int b = 0; b < 2; ++b)
#pragma unroll
            for (int m = 0; m < 4; ++m)
#pragma unroll
                for (int n = 0; n < 2; ++n) acc[a][b][m][n] = (f32x4){0.f, 0.f, 0.f, 0.f};
    bf16x8 At[4][2], B0[2][2], B1[2][2];
    const char* cA = (const char*)g.A + g.abase(cur.pm); const char* cB = (const char*)g.Bt + (size_t)cur.pn * tstepB;
    S.a_ready(cur);
    if constexpr (SP2) {
        PG8_STAGE(PG8_SB(0, 0), cB, voffB); PG8_STAGE(PG8_SB(0, 1), cB + hstepB, voffB); PG8_STAGE(PG8_SA(0, 0), cA, voffA); PG8_STAGE(PG8_SA(0, 1), cA + hstepA, voffA);
        if (wr == 1) PG8_BAR;
        PG8_WAIT_V(2); PG8_BAR;
        PG8_STAGE(PG8_SB(1, 0), cB + kstepB, voffB); PG8_STAGE(PG8_SA(1, 0), cA + kstepA, voffA); PG8_STAGE(PG8_SB(1, 1), cB + hstepB + kstepB, voffB);
        PG8_WAIT_V(6); PG8_BAR;
    } else {
        PG8_STAGE(PG8_SB(0, 0), cB, voffB); PG8_STAGE(PG8_SA(0, 0), cA, voffA); PG8_STAGE(PG8_SB(0, 1), cB + hstepB, voffB); PG8_STAGE(PG8_SA(0, 1), cA + hstepA, voffA);
        if (wr == 1) PG8_BAR;
        PG8_WAIT_V(4); PG8_BAR;
        PG8_STAGE(PG8_SB(1, 0), cB + kstepB, voffB); PG8_STAGE(PG8_SA(1, 0), cA + kstepA, voffA); PG8_STAGE(PG8_SB(1, 1), cB + hstepB + kstepB, voffB);
        PG8_WAIT_V(6); PG8_BAR;
    }
    for (;;) {
        const bool has_next = S.next(ui + 1, nxt);
        const char* nA = has_next ? (const char*)g.A + g.abase(nxt.pm) : cA + (size_t)(nt - 2) * kstepA; const char* nB = has_next ? (const char*)g.Bt + (size_t)nxt.pn * tstepB : cB + (size_t)(nt - 2) * kstepB;
        if constexpr (Epi::ROWSCALE) { if (wid < 4) __builtin_amdgcn_global_load_lds((const unsigned*)(E.rs + cur.pm * BM + wid * 64 + lane), (PG8_LAS unsigned*)(lds + PG8_RSL + (ui & 1) * 1024 + wid * 256), 4, 0, 0); }
        for (int t = 0; t < nt; t += 2) {
            const bool last = (t == nt - 2);
            const char* a1 = cA + (size_t)(t + 1) * kstepA;
            const char* a2 = last ? nA : cA + (size_t)(t + 2) * kstepA; const char* b2 = last ? nB : cB + (size_t)(t + 2) * kstepB;
            const char* a3 = a2 + kstepA; const char* b3 = b2 + kstepB;
            if (last && has_next) S.a_ready(nxt);
            if constexpr (SP2) {
            PG8_LDB(B0, 0, 0); PG8_LDB(B1, 0, 1); PG8_SCHED; PG8_LDA(At, 0, 0); PG8_STAGE(PG8_SA(1, 1), a1 + hstepA, voffA);
            PG8_WAIT_V(8); PG8_WAIT_L(0); PG8_BAR; PG8_MMA(0, 0, At, B0); PG8_MMA(0, 1, At, B1); PG8_BAR; PG8_SCHED;
            PG8_LDA(At, 0, 1); PG8_STAGE(PG8_SB(0, 0), b2, voffB); PG8_STAGE(PG8_SB(0, 1), b2 + hstepB, voffB); PG8_STAGE(PG8_SA(0, 0), a2, voffA);
            PG8_WAIT_V(8); PG8_WAIT_L(0); PG8_BAR; PG8_MMA(1, 0, At, B0); PG8_MMA(1, 1, At, B1); PG8_BAR; PG8_SCHED;
            PG8_LDB(B0, 1, 0); PG8_LDB(B1, 1, 1); PG8_SCHED; PG8_LDA(At, 1, 0); PG8_STAGE(PG8_SA(0, 1), a2 + hstepA, voffA);
            PG8_WAIT_V(8); PG8_WAIT_L(0); PG8_BAR; PG8_MMA(0, 0, At, B0); PG8_MMA(0, 1, At, B1); PG8_BAR; PG8_SCHED;
            PG8_LDA(At, 1, 1); PG8_STAGE(PG8_SB(1, 0), b3, voffB); PG8_STAGE(PG8_SB(1, 1), b3 + hstepB, voffB); PG8_STAGE(PG8_SA(1, 0), a3, voffA);
            PG8_WAIT_V(8); PG8_WAIT_L(0); PG8_BAR; PG8_MMA(1, 0, At, B0); PG8_MMA(1, 1, At, B1); PG8_BAR; PG8_SCHED;
            } else {
            PG8_LDB(B0, 0, 0); PG8_SCHED; PG8_LDA(At, 0, 0); PG8_STAGE(PG8_SA(1, 1), a1 + hstepA, voffA);
            PG8_WAIT_L(8); PG8_BAR; PG8_WAIT_L(0); PG8_MMA(0, 0, At, B0); PG8_BAR; PG8_SCHED;
            PG8_LDB(B1, 0, 1); PG8_STAGE(PG8_SB(0, 0), b2, voffB);
            PG8_BAR; PG8_WAIT_L(0); PG8_MMA(0, 1, At, B1); PG8_BAR;
            PG8_LDA(At, 0, 1); PG8_STAGE(PG8_SA(0, 0), a2, voffA);
            PG8_BAR; PG8_WAIT_L(0); PG8_MMA(1, 0, At, B0); PG8_BAR; PG8_SCHED;
            PG8_STAGE(PG8_SB(0, 1), b2 + hstepB, voffB);
            PG8_WAIT_V(6); PG8_BAR; PG8_MMA(1, 1, At, B1); PG8_BAR;
            PG8_LDB(B0, 1, 0); PG8_SCHED; PG8_LDA(At, 1, 0); PG8_STAGE(PG8_SA(0, 1), a2 + hstepA, voffA);
            PG8_WAIT_L(8); PG8_BAR; PG8_WAIT_L(0); PG8_MMA(0, 0, At, B0); PG8_BAR; PG8_SCHED;
            PG8_LDB(B1, 1, 1); PG8_STAGE(PG8_SB(1, 0), b3, voffB);
            PG8_BAR; PG8_WAIT_L(0); PG8_MMA(0, 1, At, B1); PG8_BAR;
            PG8_LDA(At, 1, 1); PG8_STAGE(PG8_SA(1, 0), a3, voffA);
            PG8_BAR; PG8_WAIT_L(0); PG8_MMA(1, 0, At, B0); PG8_BAR; PG8_SCHED;
            PG8_STAGE(PG8_SB(1, 1), b3 + hstepB, voffB);
            PG8_WAIT_V(6); PG8_BAR; PG8_MMA(1, 1, At, B1); PG8_BAR;
            }
        }
        if constexpr (ALIGN_EPI) { if (wr == 0) PG8_BAR; }
        if constexpr (!Epi::AFTER_DRAIN) { E(acc, cur, wr, wc, fr, fq, (const PG8_LAS float*)(lds + PG8_RSL + (ui & 1) * 1024)); S.done(cur); }
        if (!has_next) break;
#pragma unroll
        for (int a = 0; a < 2; ++a)
#pragma unroll
            for (int b = 0; b < 2; ++b)
#pragma unroll
                for (int m = 0; m < 4; ++m)
#pragma unroll
                    for (int n = 0; n < 2; ++n) acc[a][b][m][n] = (f32x4){0.f, 0.f, 0.f, 0.f};
        cur = nxt; cA = nA; cB = nB; ++ui;
        if constexpr (ALIGN_EPI) { if (wr == 1) PG8_BAR; }
    }
    PG8_WAIT_V(0);
    if constexpr (!ALIGN_EPI) { if (wr == 0) PG8_BAR; }
    PG8_BAR;
    if constexpr (Epi::AFTER_DRAIN) { E.fused(acc, cur, wr, wc, fr, fq, lds, wid, lane); S.done(cur); }
#undef PG8_SA
#undef PG8_RSL
#undef PG8_SB
#undef PG8_STAGE
#undef PG8_LDA
#undef PG8_LDB
#undef PG8_MMA
#undef PG8_WAIT_V
#undef PG8_WAIT_L
#undef PG8_BAR
#undef PG8_SCHED
}
}


using pg8::bf16_t; using pg8::bf16x8; using pg8::f32x4; using pg8::u32x4; using pg8::cvt_pk_bf16; using pg8::silu_f;
typedef short s16x4 __attribute__((ext_vector_type(4)));
typedef float f32x2 __attribute__((ext_vector_type(2)));
typedef unsigned u32x2 __attribute__((ext_vector_type(2)));

constexpr int DM = 2048, NB = 2, SEQ = 8192, M = NB * SEQ, DEPTH = 4, DFF = 5632, DIN = 4904, NPROJ = 5120;
constexpr int NWAVES = 8, NTHR = 512;
constexpr float EPS = 1e-6f;
constexpr int PC_Z = 0, PC_XBC = 1024, PC_GLU = 2560, PC_Q = 3584, PC_KC = 4096, PC_VC = 4224, PC_KS = 4352, PC_VS = 4480, PC_KW = 4608, PC_VW = 4736, PC_DT = 4864, PC_GL = 4880;
__device__ __forceinline__ int win_src_col(int j) {
    if (j < 2560) return j;
    if (j < 3584) return 3880 + (j - 2560);
    if (j < 4096) return 2576 + (j - 3584);
    if (j < 4864) return 3088 + (j - 4096);
    if (j < 4880) return 2560 + (j - 4864);
    if (j < 4904) return 3856 + (j - 4880);
    return -1;
}
__device__ __forceinline__ int gu_src_col(int R) { const int pn = R >> 8, rr = R & 255; return rr < 128 ? 128 * pn + rr : DFF + 128 * pn + (rr - 128); }

constexpr size_t MiB = 1u << 20;
constexpr size_t WS_CTL = 0, CTL_ZERO_BYTES = 1 * MiB;
constexpr size_t WS_WGU1 = 2 * MiB;
constexpr size_t WS_WGU2 = WS_WGU1 + 44 * MiB;
constexpr size_t WS_WD1 = WS_WGU2 + 44 * MiB;
constexpr size_t WS_WD2 = WS_WD1 + 22 * MiB;
constexpr size_t WS_WIN = WS_WD2 + 22 * MiB;
constexpr size_t WS_WOUT = WS_WIN + 20 * MiB;
constexpr size_t WS_W1 = WS_WOUT + 8 * MiB;
constexpr size_t WS_U = 180 * MiB;
constexpr size_t WS_T = 244 * MiB;
constexpr size_t WS_HID = 308 * MiB;
constexpr size_t WS_PROJ = 486 * MiB;
constexpr size_t WS_Y = 648 * MiB;
constexpr size_t WS_XACT = 712 * MiB;
constexpr size_t WS_STATES = 760 * MiB;
constexpr size_t WS_HP = 824 * MiB;
constexpr size_t WS_DT = 856 * MiB;
constexpr size_t WS_CS = 857 * MiB;
constexpr size_t WS_CDEC = 858 * MiB;
constexpr size_t WS_PEP = WS_CDEC + 64 * 1024;
constexpr size_t WS_KC = 859 * MiB;
constexpr size_t WS_H1 = 860 * MiB;
constexpr size_t WS_RS = 863 * MiB;
constexpr size_t WS_KV = 864 * MiB;
constexpr size_t WS_END = 890 * MiB;
static_assert(WS_W1 + 2 * MiB <= WS_U, "weights fit below U");
static_assert(WS_HID + (size_t)M * DFF * 2 <= WS_PROJ && WS_PROJ + (size_t)(M + 64) * NPROJ * 2 <= WS_Y, "ws map");

constexpr int LDS_WORK = 150 * 1024;
constexpr int LDS_CTL_OFF = LDS_WORK;
constexpr int LDS_BYTES = 152 * 1024;

typedef GAS unsigned gu32;
#define RLX_AGENT __ATOMIC_RELAXED, __HIP_MEMORY_SCOPE_AGENT
#define LDS_WAIT() asm volatile("s_waitcnt lgkmcnt(0)" ::: "memory")
#define VM_WAIT() asm volatile("s_waitcnt vmcnt(0)" ::: "memory")
__device__ __forceinline__ float bf2f(unsigned v) { return __uint_as_float(v << 16); }
__device__ __forceinline__ float bflo(unsigned u) { return __uint_as_float(u << 16); }
__device__ __forceinline__ float bfhi(unsigned u) { return __uint_as_float(u & 0xffff0000u); }
__device__ __forceinline__ float wave_sum(float v) {
#pragma unroll
    for (int o = 1; o < 64; o <<= 1) v += __shfl_xor(v, o);
    return v;
}
struct Ctx { LAS unsigned char* lds; int tid, lane, wave, G, bid; };

__device__ __forceinline__ bf16x8 frag_row(const LAS unsigned char* base, int pitch, int row0, int k0, int lane) {
    return *(const LAS bf16x8*)(base + (row0 + (lane & 15)) * pitch + (k0 + 8 * (lane >> 4)) * 2);
}
__device__ __forceinline__ s16x4 tr16(const LAS unsigned char* p) { return __builtin_bit_cast(s16x4, __builtin_amdgcn_ds_read_tr16_b64_v4i16((LAS s16x4*)p)); }
__device__ __forceinline__ bf16x8 frag_tr(const LAS unsigned char* base, int pitch, int k0, int n0, int lane) {
    const int g = lane >> 4, q = (lane & 15) >> 2, p = lane & 3;
    const LAS unsigned char* a = base + (k0 + 8 * g + q) * pitch + (n0 + 4 * p) * 2;
    const s16x4 lo = tr16(a), hi = tr16(a + 4 * pitch);
    return (bf16x8){lo[0], lo[1], lo[2], lo[3], hi[0], hi[1], hi[2], hi[3]};
}
#define MFMA16(a, b, c) __builtin_amdgcn_mfma_f32_16x16x32_bf16((a), (b), (c), 0, 0, 0)

#define XB_TMO      128
#define XB_XCNT(j)  (256  + 64 * (j))
#define XB_XSUB(j)  (1280 + 64 * (j))
#define XB_XGEN(j)  (2304 + 64 * (j))
#define XB_TOP      3328
#define XB_TOPGEN   3392
#define XCD_BAR_WORDS 3456
#define XB_SPIN_CAP (1u << 18)

__device__ __forceinline__ unsigned xb_ld(unsigned* p)              { return __hip_atomic_load(p, __ATOMIC_RELAXED, __HIP_MEMORY_SCOPE_AGENT); }
__device__ __forceinline__ unsigned xb_add(unsigned* p, unsigned v) { return __hip_atomic_fetch_add(p, v, __ATOMIC_RELAXED, __HIP_MEMORY_SCOPE_AGENT); }
__device__ __forceinline__ unsigned xb_xcc_id() { return (unsigned)__builtin_amdgcn_s_getreg((3 << 11) | 20) & 0xFu; }
#define XB_SPIN(cond, bar) do { unsigned _sp = 0; while (cond) { __builtin_amdgcn_s_sleep(1); \
    if ((++_sp & 255u) == 0u) { if (xb_ld(&(bar)[XB_TMO])) break; if (_sp > XB_SPIN_CAP) { atomicAdd(&(bar)[XB_TMO], 1u); break; } } } } while (0)

struct XcdBarrier {
    unsigned* bar; unsigned x;
    volatile LAS unsigned* st;
};

__device__ __forceinline__ XcdBarrier xcd_barrier_post(unsigned* bar, volatile LAS unsigned* st) {
    XcdBarrier b; b.bar = bar; b.x = xb_xcc_id(); b.st = st;
    if (threadIdx.x == 0) (void)xb_add(&bar[XB_XCNT(b.x)], 1u);
    return b;
}
__device__ __forceinline__ void xcd_barrier_complete(unsigned* bar, unsigned x, unsigned& nloc, unsigned& nx) {
    const unsigned G = gridDim.x * gridDim.y * gridDim.z;
    unsigned sum, cnt, mine, sp = 0u;
    for (;;) {
        sum = 0u; cnt = 0u; mine = 0u;
#pragma unroll
        for (unsigned j = 0; j < 16; ++j) { const unsigned c = xb_ld(&bar[XB_XCNT(j)]); sum += c; cnt += (c > 0u) ? 1u : 0u; mine = (j == x) ? c : mine; }
        if (sum == G) break;
        __builtin_amdgcn_s_sleep(1);
        if ((++sp & 255u) == 0u) { if (xb_ld(&bar[XB_TMO])) break; if (sp > XB_SPIN_CAP) { atomicAdd(&bar[XB_TMO], 1u); break; } }
    }
    nloc = mine > 0u ? mine : 1u; nx = cnt > 0u ? cnt : 1u;
}

__device__ __forceinline__ void xcd_barrier(const XcdBarrier& b) {
    asm volatile("s_waitcnt vmcnt(0)" ::: "memory");
    __syncthreads();
    if (threadIdx.x == 0) {
        unsigned* bar = b.bar;
        __builtin_amdgcn_s_waitcnt(0);
        unsigned nloc = b.st[0], nx = b.st[1];
        if (nloc == 0u) { xcd_barrier_complete(bar, b.x, nloc, nx); b.st[0] = nloc; b.st[1] = nx; }
        const unsigned old = xb_add(&bar[XB_XSUB(b.x)], 1u);
        const unsigned gen = old / nloc;
        if (old + 1u == (gen + 1u) * nloc) {
            __builtin_amdgcn_fence(__ATOMIC_RELEASE, "agent");
            asm volatile("s_waitcnt vmcnt(0)" ::: "memory");
            const unsigned og = xb_add(&bar[XB_TOP], 1u);
            const unsigned tg = og / nx;
            if (og + 1u == (tg + 1u) * nx) xb_add(&bar[XB_TOPGEN], 1u);
            else XB_SPIN(xb_ld(&bar[XB_TOPGEN]) == tg, bar);
            __builtin_amdgcn_fence(__ATOMIC_ACQUIRE, "agent");
            xb_add(&bar[XB_XGEN(b.x)], 1u);
            asm volatile("s_waitcnt vmcnt(0)" ::: "memory");
        } else {
            XB_SPIN(xb_ld(&bar[XB_TOPGEN]) == gen, bar);
            __builtin_amdgcn_fence(__ATOMIC_ACQUIRE, "agent");
            asm volatile("s_waitcnt vmcnt(0)" ::: "memory");
        }
    }
    __syncthreads();
}

__device__ __forceinline__ void xcd_barrier_arrive(const XcdBarrier& b) {
    asm volatile("s_waitcnt vmcnt(0)" ::: "memory");
    __syncthreads();
    if (threadIdx.x == 0) {
        unsigned* bar = b.bar;
        __builtin_amdgcn_s_waitcnt(0);
        unsigned nloc = b.st[0], nx = b.st[1];
        if (nloc == 0u) { xcd_barrier_complete(bar, b.x, nloc, nx); b.st[0] = nloc; b.st[1] = nx; }
        const unsigned old = xb_add(&bar[XB_XSUB(b.x)], 1u);
        const unsigned gen = old / nloc;
        if (old + 1u == (gen + 1u) * nloc) {
            __builtin_amdgcn_fence(__ATOMIC_RELEASE, "agent");
            asm volatile("s_waitcnt vmcnt(0)" ::: "memory");
            const unsigned og = xb_add(&bar[XB_TOP], 1u);
            const unsigned tg = og / nx;
            if (og + 1u == (tg + 1u) * nx) xb_add(&bar[XB_TOPGEN], 1u);
            xb_add(&bar[XB_XGEN(b.x)], 1u);
        }
        b.st[3] = gen;
    }
}
__device__ __forceinline__ void xcd_barrier_wait(const XcdBarrier& b) {
    if (threadIdx.x == 0) {
        unsigned* bar = b.bar; const unsigned gen = b.st[3];
        XB_SPIN(xb_ld(&bar[XB_TOPGEN]) == gen, bar);
        __builtin_amdgcn_fence(__ATOMIC_ACQUIRE, "agent");
        asm volatile("s_waitcnt vmcnt(0)" ::: "memory");
    }
    __syncthreads();
}


struct MapId { __device__ __forceinline__ int operator()(int r) const { return r; } };
struct MapGu { __device__ __forceinline__ int operator()(int r) const { return gu_src_col(r); } };
struct MapIn { __device__ __forceinline__ int operator()(int r) const { return win_src_col(r); } };
template <class Map>
__device__ __forceinline__ void tr_item(const float* W, int K, int ldw, bf16_t* WT, LAS float* scr, int item, int nblk, int lane, Map map, const float* kscale = nullptr) {
    const int kb = item / nblk, nb = item % nblk, k0 = 64 * kb, n0 = 64 * nb;
    const int r4 = lane >> 4, c4 = lane & 15;
    const int src = map(n0 + 4 * c4);
    f32x4 v[16];
    const float* wp = W + (size_t)(k0 + r4) * ldw + (src >= 0 ? src : 0);
#pragma unroll
    for (int i = 0; i < 16; ++i) v[i] = *(const f32x4*)(wp + (size_t)(4 * i) * ldw);
    if (src < 0) {
#pragma unroll
        for (int i = 0; i < 16; ++i) v[i] = (f32x4){0.f, 0.f, 0.f, 0.f};
    }
    if (kscale) {
#pragma unroll
        for (int i = 0; i < 16; ++i) v[i] = v[i] * kscale[k0 + 4 * i + r4];
    }
#pragma unroll
    for (int i = 0; i < 16; ++i) { LAS float* d = scr + (4 * i + r4) * 65 + 4 * c4; d[0] = v[i][0]; d[1] = v[i][1]; d[2] = v[i][2]; d[3] = v[i][3]; }
    LDS_WAIT(); asm volatile("" ::: "memory");
    const int c = lane & 7;
#pragma unroll
    for (int j = 0; j < 8; ++j) { const int n = (lane >> 3) + 8 * j; const LAS float* sp = scr + (8 * c) * 65 + n;
        u32x4 o; o.x = cvt_pk_bf16(sp[0 * 65], sp[1 * 65]); o.y = cvt_pk_bf16(sp[2 * 65], sp[3 * 65]); o.z = cvt_pk_bf16(sp[4 * 65], sp[5 * 65]); o.w = cvt_pk_bf16(sp[6 * 65], sp[7 * 65]);
        *(u32x4*)(WT + (size_t)(n0 + n) * K + k0 + 8 * c) = o; }
    LDS_WAIT(); asm volatile("" ::: "memory");
}
struct LayerW {
    const float *gu1, *d1, *gu2, *d2, *win, *wout, *w1k, *w1v, *kpe, *vpe, *pre1, *prem, *pre2;
};
__device__ __forceinline__ void phase_convert(const Ctx& c, const LayerW& L, unsigned char* ws) {
    LAS float* scr = (LAS float*)(c.lds + c.wave * 16640);
    constexpr int B_GU = (DM / 256) * (2 * DFF / 128), B_D = (DFF / 256) * (DM / 128), B_IN = (DM / 256) * (NPROJ / 128), B_O = (DM / 256) * (DM / 128), B_1 = (DM / 256) * (256 / 128);
    constexpr int NBI = 2 * B_GU + 2 * B_D + B_IN + B_O + 2 * B_1;
    const int wk = c.wave >> 1, wn = c.wave & 1;
#define TR_CALL(W_, K_, LDW_, WT_, N_, MAP_, KS_) do { const int nb2n = (N_) / 128, kb = 4 * (r / nb2n) + wk, nb = 2 * (r % nb2n) + wn; tr_item(W_, K_, LDW_, WT_, scr, kb * ((N_) / 64) + nb, (N_) / 64, c.lane, MAP_, KS_); } while (0)
    for (int it = c.bid; it < NBI; it += c.G) {
        int r = it;
        if (r < B_GU) { TR_CALL(L.gu1, DM, 2 * DFF, (bf16_t*)(ws + WS_WGU1), 2 * DFF, MapGu(), L.pre1); continue; } r -= B_GU;
        if (r < B_GU) { TR_CALL(L.gu2, DM, 2 * DFF, (bf16_t*)(ws + WS_WGU2), 2 * DFF, MapGu(), L.pre2); continue; } r -= B_GU;
        if (r < B_D) { TR_CALL(L.d1, DFF, DM, (bf16_t*)(ws + WS_WD1), DM, MapId(), nullptr); continue; } r -= B_D;
        if (r < B_D) { TR_CALL(L.d2, DFF, DM, (bf16_t*)(ws + WS_WD2), DM, MapId(), nullptr); continue; } r -= B_D;
        if (r < B_IN) { TR_CALL(L.win, DM, DIN, (bf16_t*)(ws + WS_WIN), NPROJ, MapIn(), L.prem); continue; } r -= B_IN;
        if (r < B_O) { TR_CALL(L.wout, DM, DM, (bf16_t*)(ws + WS_WOUT), DM, MapId(), nullptr); continue; } r -= B_O;
        if (r < B_1) { TR_CALL(L.w1k, DM, 256, (bf16_t*)(ws + WS_W1), 256, MapId(), nullptr); continue; } r -= B_1;
        TR_CALL(L.w1v, DM, 256, (bf16_t*)(ws + WS_W1) + 256 * DM, 256, MapId(), nullptr);
    }
#undef TR_CALL
    for (int seg = c.bid; seg < 256; seg += c.G) {
        const int kv = c.tid >> 8, col = c.tid & 255;
        const float* pe = kv ? L.vpe : L.kpe; const float* w1 = kv ? L.w1v : L.w1k;
        float s = 0.f;
#pragma unroll
        for (int k = 0; k < 8; ++k) s += pe[8 * seg + k] * w1[(size_t)(8 * seg + k) * 256 + col];
        ((float*)(ws + WS_PEP))[(kv * 256 + seg) * 256 + col] = s;
    }
}

__device__ __forceinline__ void phase_norm(const Ctx& c, const float* xin, const bf16_t* T, float alpha, const float* wpost, bf16_t* HB, float* RS, float* outf) {
    const int gw = c.bid * NWAVES + c.wave, NGW = c.G * NWAVES;
    if (xin) {
        for (int row = gw; row < M; row += NGW) {
            const size_t i0 = (size_t)row * 512 + c.lane; float ss = 0.f;
#pragma unroll
            for (int j = 0; j < 8; ++j) { const f32x4 hv = ((const f32x4*)xin)[i0 + 64 * j]; ss += (hv[0] * hv[0] + hv[1] * hv[1]) + (hv[2] * hv[2] + hv[3] * hv[3]);
                u32x2 pk; pk.x = cvt_pk_bf16(hv[0], hv[1]); pk.y = cvt_pk_bf16(hv[2], hv[3]); ((u32x2*)HB)[i0 + 64 * j] = pk; }
            const float rs = 1.0f / sqrtf(wave_sum(ss) * (1.0f / DM) + EPS);
            if (c.lane == 0) RS[row] = rs;
        }
        return;
    }
    for (int row = gw; row < M; row += 2 * NGW) {
        const bool two = row + NGW < M;
        const size_t i0 = (size_t)row * 512 + c.lane, i1 = (size_t)(two ? row + NGW : row) * 512 + c.lane;
        u32x2 tw[2][8], hw[2][8];
#pragma unroll
        for (int j = 0; j < 8; ++j) { tw[0][j] = ((const u32x2*)T)[i0 + 64 * j]; tw[1][j] = ((const u32x2*)T)[i1 + 64 * j]; }
#pragma unroll
        for (int j = 0; j < 8; ++j) { hw[0][j] = ((const u32x2*)HB)[i0 + 64 * j]; hw[1][j] = ((const u32x2*)HB)[i1 + 64 * j]; }
        f32x4 wp[8];
#pragma unroll
        for (int j = 0; j < 8; ++j) wp[j] = ((const f32x4*)wpost)[c.lane + 64 * j];
#pragma unroll
        for (int q = 0; q < 2; ++q) {
            if (q == 1 && !two) break;
            const size_t iq = q ? i1 : i0; const int rq = q ? row + NGW : row;
            f32x4 tv[8]; float ss = 0.f;
#pragma unroll
            for (int j = 0; j < 8; ++j) { tv[j] = (f32x4){bflo(tw[q][j].x), bfhi(tw[q][j].x), bflo(tw[q][j].y), bfhi(tw[q][j].y)};
                ss += (tv[j][0] * tv[j][0] + tv[j][1] * tv[j][1]) + (tv[j][2] * tv[j][2] + tv[j][3] * tv[j][3]); }
            const float rs = alpha / sqrtf(wave_sum(ss) * (1.0f / DM) + EPS);
            float s2 = 0.f;
#pragma unroll
            for (int j = 0; j < 8; ++j) { const f32x4 hv = (f32x4){bflo(hw[q][j].x), bfhi(hw[q][j].x), bflo(hw[q][j].y), bfhi(hw[q][j].y)} + tv[j] * rs * wp[j];
                if (outf) ((f32x4*)outf)[iq + 64 * j] = hv;
                else { s2 += (hv[0] * hv[0] + hv[1] * hv[1]) + (hv[2] * hv[2] + hv[3] * hv[3]);
                    u32x2 pk; pk.x = cvt_pk_bf16(hv[0], hv[1]); pk.y = cvt_pk_bf16(hv[2], hv[3]); ((u32x2*)HB)[iq + 64 * j] = pk; } }
            if (!outf) { const float r2 = 1.0f / sqrtf(wave_sum(s2) * (1.0f / DM) + EPS); if (c.lane == 0) RS[rq] = r2; }
        }
    }
}

struct SsdW { const float *conv_w, *conv_b, *dt_bias, *a_log, *dskip, *norm_w; };
__device__ __forceinline__ float softplus_f(float x) { return x > 20.f ? x : log1pf(__expf(x)); }

__device__ __forceinline__ void ssd_conv8(const bf16_t* PROJ, const SsdW& W, int b, int s, int ch0, float (&out)[8]) {
    const f32x4 b0 = *(const f32x4*)(W.conv_b + ch0), b1 = *(const f32x4*)(W.conv_b + ch0 + 4);
    float acc[8] = {b0[0], b0[1], b0[2], b0[3], b1[0], b1[1], b1[2], b1[3]};
#pragma unroll
    for (int k = 0; k < 4; ++k) {
        const int sr = s - 3 + k;
        if (sr >= 0) {
            const u32x4 x = *(const u32x4*)(PROJ + (size_t)(b * SEQ + sr) * NPROJ + PC_XBC + ch0);
            const f32x4 w0 = *(const f32x4*)(W.conv_w + k * 1536 + ch0), w1 = *(const f32x4*)(W.conv_w + k * 1536 + ch0 + 4);
            acc[0] += w0[0] * bflo(x.x); acc[1] += w0[1] * bfhi(x.x); acc[2] += w0[2] * bflo(x.y); acc[3] += w0[3] * bfhi(x.y);
            acc[4] += w1[0] * bflo(x.z); acc[5] += w1[1] * bfhi(x.z); acc[6] += w1[2] * bflo(x.w); acc[7] += w1[3] * bfhi(x.w);
        }
    }
#pragma unroll
    for (int e = 0; e < 8; ++e) out[e] = silu_f(acc[e]);
}
struct Conv8W { f32x4 w[4][2]; f32x4 b[2]; };
__device__ __forceinline__ Conv8W conv8_load_w(const SsdW& W, int ch0) { Conv8W r;
#pragma unroll
    for (int k = 0; k < 4; ++k) { r.w[k][0] = *(const f32x4*)(W.conv_w + k * 1536 + ch0); r.w[k][1] = *(const f32x4*)(W.conv_w + k * 1536 + ch0 + 4); }
    r.b[0] = *(const f32x4*)(W.conv_b + ch0); r.b[1] = *(const f32x4*)(W.conv_b + ch0 + 4); return r; }
__device__ __forceinline__ void conv8_load_x(const bf16_t* PROJ, int b, int s, int ch0, u32x4 (&x)[4]) {
#pragma unroll
    for (int k = 0; k < 4; ++k) { const int sr = s - 3 + k; x[k] = (u32x4){0u, 0u, 0u, 0u}; if (sr >= 0) x[k] = *(const u32x4*)(PROJ + (size_t)(b * SEQ + sr) * NPROJ + PC_XBC + ch0); } }
__device__ __forceinline__ void conv8_apply(const Conv8W& cw, const u32x4 (&x)[4], float (&out)[8]) {
    float acc[8] = {cw.b[0][0], cw.b[0][1], cw.b[0][2], cw.b[0][3], cw.b[1][0], cw.b[1][1], cw.b[1][2], cw.b[1][3]};
#pragma unroll
    for (int k = 0; k < 4; ++k) {
        acc[0] += cw.w[k][0][0] * bflo(x[k].x); acc[1] += cw.w[k][0][1] * bfhi(x[k].x); acc[2] += cw.w[k][0][2] * bflo(x[k].y); acc[3] += cw.w[k][0][3] * bfhi(x[k].y);
        acc[4] += cw.w[k][1][0] * bflo(x[k].z); acc[5] += cw.w[k][1][1] * bfhi(x[k].z); acc[6] += cw.w[k][1][2] * bflo(x[k].w); acc[7] += cw.w[k][1][3] * bfhi(x[k].w); }
#pragma unroll
    for (int e = 0; e < 8; ++e) out[e] = silu_f(acc[e]);
}
__device__ __forceinline__ u32x4 pack8(const float (&v)[8]) { u32x4 w; w.x = cvt_pk_bf16(v[0], v[1]); w.y = cvt_pk_bf16(v[2], v[3]); w.z = cvt_pk_bf16(v[4], v[5]); w.w = cvt_pk_bf16(v[6], v[7]); return w; }

constexpr int P136 = 272, P72 = 144;
__device__ __forceinline__ void ssd_a_unit(const Ctx& c, const SsdW& W, unsigned char* ws, int unit) {
    const int g = unit & 1, ch = (unit >> 1) & 63, b = unit >> 7;
    const bf16_t* PROJ = (const bf16_t*)(ws + WS_PROJ); bf16_t* XACT = (bf16_t*)(ws + WS_XACT);
    float* DT = (float*)(ws + WS_DT); float* CS = (float*)(ws + WS_CS); float* CDEC = (float*)(ws + WS_CDEC); bf16_t* ST = (bf16_t*)(ws + WS_STATES);
    LAS float* sclS = (LAS float*)(c.lds + 8192);
    LAS unsigned char* Bs = c.lds + 12288;
    LAS unsigned char* Xs = c.lds + 12288 + 128 * P136;
    const int m0 = b * SEQ + ch * 128;
    const int q8 = c.tid & 7, xs = c.tid >> 3;
    Conv8W hw = conv8_load_w(W, 64 * (8 * g) + 8 * q8);
    u32x4 hx[2][4];
#pragma unroll
    for (int i = 0; i < 2; ++i) conv8_load_x(PROJ, b, ch * 128 + xs + 64 * i, 64 * (8 * g) + 8 * q8, hx[i]);
    __syncthreads();
    {
        const int hh = 8 * g + c.wave; const float bias = W.dt_bias[hh], a = -__expf(W.a_log[hh]);
        const int s0 = 2 * c.lane;
        const float r0 = bf2f(PROJ[(size_t)(m0 + s0) * NPROJ + PC_DT + hh]), r1 = bf2f(PROJ[(size_t)(m0 + s0 + 1) * NPROJ + PC_DT + hh]);
        const float dt0 = softplus_f(r0 + bias), dt1 = softplus_f(r1 + bias);
        const float v0 = a * dt0, pair = v0 + a * dt1;
        float x = pair;
#pragma unroll
        for (int o = 1; o < 64; o <<= 1) { const float y = __shfl_up(x, o); if (c.lane >= o) x += y; }
        const float cs0 = (x - pair) + v0, cs1 = x, tot = __shfl(x, 63);
        sclS[c.wave * 128 + s0] = __expf(tot - cs0) * dt0; sclS[c.wave * 128 + s0 + 1] = __expf(tot - cs1) * dt1;
        DT[(size_t)(m0 + s0) * 16 + hh] = dt0; DT[(size_t)(m0 + s0 + 1) * 16 + hh] = dt1;
        CS[(size_t)(m0 + s0) * 16 + hh] = cs0; CS[(size_t)(m0 + s0 + 1) * 16 + hh] = cs1;
        if (c.lane == 63) CDEC[(b * 64 + ch) * 16 + hh] = __expf(tot);
    }
    {
        const int q = c.tid & 31, ch0 = (q < 16) ? 1024 + 128 * g + 8 * q : 1280 + 128 * g + 8 * (q - 16);
        const Conv8W cw = conv8_load_w(W, ch0);
#pragma unroll
        for (int k0 = 0; k0 < 8; k0 += 4) {
            u32x4 x[4][4];
#pragma unroll
            for (int i = 0; i < 4; ++i) conv8_load_x(PROJ, b, ch * 128 + (c.tid >> 5) + 16 * (k0 + i), ch0, x[i]);
#pragma unroll
            for (int i = 0; i < 4; ++i) { const int s = (c.tid >> 5) + 16 * (k0 + i);
                float v[8]; conv8_apply(cw, x[i], v);
                const u32x4 pk = pack8(v);
                *(u32x4*)(XACT + (size_t)(m0 + s) * 1536 + ch0) = pk;
                if (q < 16) *(LAS u32x4*)(Bs + s * P136 + q * 16) = pk; }
        }
    }
    for (int h8 = 0; h8 < 8; ++h8) {
        const int hh = 8 * g + h8;
        __syncthreads();
        {
            const int ch0 = 64 * hh + 8 * q8;
            float v[2][8];
#pragma unroll
            for (int i = 0; i < 2; ++i) conv8_apply(hw, hx[i], v[i]);
            if (h8 < 7) { hw = conv8_load_w(W, ch0 + 64);
#pragma unroll
                for (int i = 0; i < 2; ++i) conv8_load_x(PROJ, b, ch * 128 + xs + 64 * i, ch0 + 64, hx[i]); }
#pragma unroll
            for (int i = 0; i < 2; ++i) { const int s = xs + 64 * i;
                *(u32x4*)(XACT + (size_t)(m0 + s) * 1536 + ch0) = pack8(v[i]);
                const float sc = sclS[h8 * 128 + s];
#pragma unroll
                for (int e = 0; e < 8; ++e) v[i][e] *= sc;
                *(LAS u32x4*)(Xs + s * P72 + q8 * 16) = pack8(v[i]); }
        }
        __syncthreads();
        const int pt = c.wave & 3, ntg = c.wave >> 2;
        f32x4 acc[4];
#pragma unroll
        for (int nt = 0; nt < 4; ++nt) acc[nt] = (f32x4){0.f, 0.f, 0.f, 0.f};
#pragma unroll
        for (int ks = 0; ks < 4; ++ks) {
            const bf16x8 xf = frag_tr(Xs, P72, 32 * ks, 16 * pt, c.lane);
#pragma unroll
            for (int nt = 0; nt < 4; ++nt) { const bf16x8 bf = frag_tr(Bs, P136, 32 * ks, 16 * (4 * ntg + nt), c.lane); acc[nt] = MFMA16(bf, xf, acc[nt]); }
        }
        bf16_t* stp = ST + ((size_t)((b * 64 + ch) * 16 + hh) * 64 + 16 * pt + (c.lane & 15)) * 128 + 4 * (c.lane >> 4);
#pragma unroll
        for (int nt = 0; nt < 4; ++nt) { u32x2 pk; pk.x = cvt_pk_bf16(acc[nt][0], acc[nt][1]); pk.y = cvt_pk_bf16(acc[nt][2], acc[nt][3]); *(u32x2*)(stp + 16 * (4 * ntg + nt)) = pk; }
    }
}

__device__ __forceinline__ void phase_ssd_scan(const Ctx& c, unsigned char* ws) {
    const unsigned* ST = (const unsigned*)(ws + WS_STATES); const float* CDEC = (const float*)(ws + WS_CDEC); unsigned* HP = (unsigned*)(ws + WS_HP);
    for (int chain = c.bid * NTHR + c.tid; chain < NB * 16 * 64 * 64; chain += c.G * NTHR) {
        const int n2 = chain & 63, p = (chain >> 6) & 63, hh = (chain >> 12) & 15, b = chain >> 16;
        f32x2 run = (f32x2){0.f, 0.f};
#pragma unroll 16
        for (int ch = 0; ch < 64; ++ch) {
            const size_t idx = ((size_t)((b * 64 + ch) * 16 + hh) * 64 + p) * 64 + n2;
            const unsigned sp = ST[idx]; const f32x2 s = (f32x2){bflo(sp), bfhi(sp)}; const float dec = CDEC[(b * 64 + ch) * 16 + hh];
            HP[idx] = cvt_pk_bf16(run[0], run[1]);
            run = run * dec + s;
        }
    }
}

__device__ __forceinline__ void ssd_b_unit(const Ctx& c, const SsdW& W, unsigned char* ws, int unit) {
    const int g = unit & 1, ch = (unit >> 1) & 63, b = unit >> 7;
    const bf16_t* PROJ = (const bf16_t*)(ws + WS_PROJ); const bf16_t* XACT = (const bf16_t*)(ws + WS_XACT); const bf16_t* HP = (const bf16_t*)(ws + WS_HP);
    const float* DT = (const float*)(ws + WS_DT); const float* CS = (const float*)(ws + WS_CS); bf16_t* Y = (bf16_t*)(ws + WS_Y);
    LAS float* csS = (LAS float*)(c.lds);
    LAS float* dtS = (LAS float*)(c.lds + 4096);
    LAS unsigned char* Cs = c.lds + 8192;
    LAS unsigned char* Ws = Cs + 128 * P136;
    LAS unsigned char* CBs = Ws + 128 * P136;
    LAS unsigned char* Xs = CBs + 128 * P136;
    LAS unsigned char* Hs = Xs + 128 * P72;
    const int m0 = b * SEQ + ch * 128, lane = c.lane, w = c.wave;
    __syncthreads();
    {
        u32x4 sv[8]; float cv[2], dv[2];
#pragma unroll
        for (int i = 0; i < 8; ++i) { const int it = c.tid + NTHR * i, s = it >> 5, q = it & 31;
            sv[i] = *(const u32x4*)(XACT + (size_t)(m0 + s) * 1536 + ((q < 16) ? 1280 + 128 * g + 8 * q : 1024 + 128 * g + 8 * (q - 16))); }
#pragma unroll
        for (int i = 0; i < 2; ++i) { const int it = c.tid + NTHR * i, s = it >> 3, h8 = it & 7; cv[i] = CS[(size_t)(m0 + s) * 16 + 8 * g + h8]; dv[i] = DT[(size_t)(m0 + s) * 16 + 8 * g + h8]; }
#pragma unroll
        for (int i = 0; i < 8; ++i) { const int it = c.tid + NTHR * i, s = it >> 5, q = it & 31; *(LAS u32x4*)(((q < 16) ? Cs : Ws) + s * P136 + (q & 15) * 16) = sv[i]; }
#pragma unroll
        for (int i = 0; i < 2; ++i) { const int it = c.tid + NTHR * i, s = it >> 3, h8 = it & 7; csS[h8 * 128 + s] = cv[i]; dtS[h8 * 128 + s] = dv[i]; }
    }
    __syncthreads();
    bf16x8 cfr[4];
#pragma unroll
    for (int ks = 0; ks < 4; ++ks) cfr[ks] = frag_row(Cs, P136, 16 * w, 32 * ks, lane);
    for (int st = 0; st <= w; ++st) {
        f32x4 a = (f32x4){0.f, 0.f, 0.f, 0.f};
#pragma unroll
        for (int ks = 0; ks < 4; ++ks) a = MFMA16(frag_row(Ws, P136, 16 * st, 32 * ks, lane), cfr[ks], a);
        u32x2 pk; pk.x = cvt_pk_bf16(a[0], a[1]); pk.y = cvt_pk_bf16(a[2], a[3]);
        *(LAS u32x2*)(CBs + (16 * w + (lane & 15)) * P136 + (16 * st + 4 * (lane >> 4)) * 2) = pk;
    }
    float ssq = 0.f;
    const int tok = 16 * w + (lane & 15);
    const int xs0 = c.tid >> 3, xq = c.tid & 7, hp0 = c.tid >> 4, hq = c.tid & 15;
    u32x4 xr[2], hr[2];
#define SSDB_FETCH(hh_) do { \
        xr[0] = *(const u32x4*)(XACT + (size_t)(m0 + xs0) * 1536 + 64 * (hh_) + 8 * xq); xr[1] = *(const u32x4*)(XACT + (size_t)(m0 + xs0 + 64) * 1536 + 64 * (hh_) + 8 * xq); \
        hr[0] = *(const u32x4*)(HP + ((size_t)((b * 64 + ch) * 16 + (hh_)) * 64 + hp0) * 128 + 8 * hq); hr[1] = *(const u32x4*)(HP + ((size_t)((b * 64 + ch) * 16 + (hh_)) * 64 + hp0 + 32) * 128 + 8 * hq); } while (0)
    SSDB_FETCH(8 * g);
    for (int h8 = 0; h8 < 8; ++h8) {
        const int hh = 8 * g + h8;
        u32x2 zv[4];
#pragma unroll
        for (int pt = 0; pt < 4; ++pt) zv[pt] = *(const u32x2*)(PROJ + (size_t)(m0 + tok) * NPROJ + PC_Z + 64 * hh + 16 * pt + 4 * (lane >> 4));
        __syncthreads();
        *(LAS u32x4*)(Xs + xs0 * P72 + xq * 16) = xr[0]; *(LAS u32x4*)(Xs + (xs0 + 64) * P72 + xq * 16) = xr[1];
        *(LAS u32x4*)(Hs + hp0 * P136 + hq * 16) = hr[0]; *(LAS u32x4*)(Hs + (hp0 + 32) * P136 + hq * 16) = hr[1];
        if (h8 < 7) SSDB_FETCH(hh + 1);
        for (int it = c.tid; it < 128 * 16; it += NTHR) {
            const int l = it >> 4, q = it & 15, s0 = 8 * q;
            u32x4 o = (u32x4){0u, 0u, 0u, 0u};
            if (s0 <= l) {
                const u32x4 cb = *(const LAS u32x4*)(CBs + l * P136 + q * 16); const float cl = csS[h8 * 128 + l];
                float v[8] = {bflo(cb.x), bfhi(cb.x), bflo(cb.y), bfhi(cb.y), bflo(cb.z), bfhi(cb.z), bflo(cb.w), bfhi(cb.w)};
                const f32x4 c0 = *(const LAS f32x4*)(csS + h8 * 128 + s0), c1 = *(const LAS f32x4*)(csS + h8 * 128 + s0 + 4), d0 = *(const LAS f32x4*)(dtS + h8 * 128 + s0), d1 = *(const LAS f32x4*)(dtS + h8 * 128 + s0 + 4);
                const float csv[8] = {c0[0], c0[1], c0[2], c0[3], c1[0], c1[1], c1[2], c1[3]}, dtv[8] = {d0[0], d0[1], d0[2], d0[3], d1[0], d1[1], d1[2], d1[3]};
#pragma unroll
                for (int e = 0; e < 8; ++e) { const int s = s0 + e; v[e] = (s <= l) ? v[e] * __expf(cl - csv[e]) * dtv[e] : 0.f; }
                o = pack8(v);
            }
            *(LAS u32x4*)(Ws + l * P136 + q * 16) = o;
        }
        __syncthreads();
        const int nks = (w >> 1) + 1;
        const float ecs = __expf(csS[h8 * 128 + tok]), dsk = W.dskip[hh];
#pragma unroll
        for (int pt = 0; pt < 4; ++pt) {
            f32x4 yd = (f32x4){0.f, 0.f, 0.f, 0.f}, yo = (f32x4){0.f, 0.f, 0.f, 0.f};
            for (int ks = 0; ks < nks; ++ks) yd = MFMA16(frag_tr(Xs, P72, 32 * ks, 16 * pt, lane), frag_row(Ws, P136, 16 * w, 32 * ks, lane), yd);
#pragma unroll
            for (int ks = 0; ks < 4; ++ks) yo = MFMA16(frag_row(Hs, P136, 16 * pt, 32 * ks, lane), cfr[ks], yo);
            const int p0 = 16 * pt + 4 * (lane >> 4);
            const u32x2 xv = *(const LAS u32x2*)(Xs + tok * P72 + p0 * 2);
            const float xx[4] = {bflo(xv.x), bfhi(xv.x), bflo(xv.y), bfhi(xv.y)}, zz[4] = {bflo(zv[pt].x), bfhi(zv[pt].x), bflo(zv[pt].y), bfhi(zv[pt].y)};
            float yv[4];
#pragma unroll
            for (int r = 0; r < 4; ++r) { yv[r] = (yd[r] + ecs * yo[r] + dsk * xx[r]) * silu_f(zz[r]); ssq += yv[r] * yv[r]; }
            u32x2 pk; pk.x = cvt_pk_bf16(yv[0], yv[1]); pk.y = cvt_pk_bf16(yv[2], yv[3]);
            *(u32x2*)(Y + (size_t)(m0 + tok) * DM + 64 * hh + p0) = pk;
        }
    }
#undef SSDB_FETCH
    ssq += __shfl_xor(ssq, 16); ssq += __shfl_xor(ssq, 32);
    const float rstd = 1.0f / sqrtf(ssq * (1.0f / 512.f) + EPS);
    VM_WAIT(); __builtin_amdgcn_fence(__ATOMIC_ACQUIRE, "agent"); VM_WAIT();
    const f32x4 nw0 = *(const f32x4*)(W.norm_w + 512 * g + 8 * lane), nw1 = *(const f32x4*)(W.norm_w + 512 * g + 8 * lane + 4);
    u32x4 yrow[16];
#pragma unroll
    for (int t = 0; t < 16; ++t) yrow[t] = *(const u32x4*)(Y + (size_t)(m0 + 16 * w + t) * DM + 512 * g + 8 * lane);
#pragma unroll
    for (int t = 0; t < 16; ++t) {
        const float rs = __shfl(rstd, t);
        bf16_t* yp = Y + (size_t)(m0 + 16 * w + t) * DM + 512 * g + 8 * lane;
        const u32x4 v = yrow[t];
        float o[8] = {bflo(v.x) * rs * nw0[0], bfhi(v.x) * rs * nw0[1], bflo(v.y) * rs * nw0[2], bfhi(v.y) * rs * nw0[3],
                      bflo(v.z) * rs * nw1[0], bfhi(v.z) * rs * nw1[1], bflo(v.w) * rs * nw1[2], bfhi(v.w) * rs * nw1[3]};
        *(u32x4*)yp = pack8(o);
    }
}

struct CnvW { const float *dw_w, *dw_b, *ln_w, *ln_b; };
__device__ __forceinline__ void cnv_unit(const Ctx& c, const CnvW& W, unsigned char* ws, int unit) {
    const bf16_t* PROJ = (const bf16_t*)(ws + WS_PROJ); bf16_t* Y = (bf16_t*)(ws + WS_Y);
    LAS float* vin = (LAS float*)c.lds;
    LAS float* red = (LAS float*)(c.lds + 62 * 512 * 4);
    const int b = unit >> 8, s0 = (unit & 255) * 32;
    __syncthreads();
    {
        u32x4 ra[8], rg[8];
#pragma unroll
        for (int i = 0; i < 8; ++i) { const int it = c.tid + NTHR * i, r = it >> 6, q = it & 63, s = s0 - 30 + r;
            ra[i] = (u32x4){0u, 0u, 0u, 0u}; rg[i] = (u32x4){0u, 0u, 0u, 0u};
            if (it < 62 * 64 && s >= 0) { const bf16_t* row = PROJ + (size_t)(b * SEQ + s) * NPROJ + PC_GLU + 8 * q; ra[i] = *(const u32x4*)row; rg[i] = *(const u32x4*)(row + 512); } }
#pragma unroll
        for (int i = 0; i < 8; ++i) { const int it = c.tid + NTHR * i, r = it >> 6, q = it & 63;
            if (it < 62 * 64) {
                const u32x4 a = ra[i], gt = rg[i];
                const float av[8] = {bflo(a.x), bfhi(a.x), bflo(a.y), bfhi(a.y), bflo(a.z), bfhi(a.z), bflo(a.w), bfhi(a.w)};
                const float gv[8] = {bflo(gt.x), bfhi(gt.x), bflo(gt.y), bfhi(gt.y), bflo(gt.z), bfhi(gt.z), bflo(gt.w), bfhi(gt.w)};
                float v[8];
#pragma unroll
                for (int e = 0; e < 8; ++e) v[e] = av[e] * __builtin_amdgcn_rcpf(1.0f + __expf(-gv[e]));
                *(LAS f32x4*)(vin + r * 512 + 8 * q) = (f32x4){v[0], v[1], v[2], v[3]}; *(LAS f32x4*)(vin + r * 512 + 8 * q + 4) = (f32x4){v[4], v[5], v[6], v[7]};
            } }
    }
    __syncthreads();
    const int ch = c.tid;
    float acc[32];
    { const float bias = W.dw_b[ch];
#pragma unroll
      for (int t = 0; t < 32; ++t) acc[t] = bias; }
    {
        float xin[62];
#pragma unroll
        for (int r = 0; r < 62; ++r) xin[r] = vin[r * 512 + ch];
#pragma unroll
        for (int k = 0; k < 31; ++k) { const float wk = W.dw_w[k * 512 + ch];
#pragma unroll
            for (int t = 0; t < 32; ++t) acc[t] += wk * xin[t + k]; }
    }
#pragma unroll
    for (int t = 0; t < 32; ++t) { const float s1 = wave_sum(acc[t]), s2 = wave_sum(acc[t] * acc[t]); if (c.lane == 0) { red[(c.wave * 32 + t) * 2] = s1; red[(c.wave * 32 + t) * 2 + 1] = s2; } }
    __syncthreads();
    const float lw = W.ln_w[ch], lb = W.ln_b[ch];
#pragma unroll
    for (int t = 0; t < 32; ++t) {
        float s1 = 0.f, s2 = 0.f;
#pragma unroll
        for (int wv = 0; wv < 8; ++wv) { s1 += red[(wv * 32 + t) * 2]; s2 += red[(wv * 32 + t) * 2 + 1]; }
        const float mu = s1 * (1.0f / 512.f), var = fmaxf(s2 * (1.0f / 512.f) - mu * mu, 0.f);
        const float o = silu_f((acc[t] - mu) * __builtin_amdgcn_rsqf(var + EPS) * lw + lb);
        Y[(size_t)(b * SEQ + s0 + t) * DM + 1536 + ch] = (bf16_t)(cvt_pk_bf16(o, 0.f) & 0xffffu);
    }
}

__device__ __forceinline__ void nsa_cmp2(const Ctx& c, const float* w2, const bf16_t* H1, bf16_t* KC, int pm) {
    LAS unsigned char* W2s = c.lds;
    VM_WAIT(); __syncthreads();
    __builtin_amdgcn_fence(__ATOMIC_ACQUIRE, "agent"); VM_WAIT();
    for (int it = c.tid; it < 256 * 8; it += NTHR) { const int k = it >> 3, q = it & 7;
        const f32x4 a = *(const f32x4*)(w2 + k * 64 + 8 * q), b = *(const f32x4*)(w2 + k * 64 + 8 * q + 4);
        u32x4 o; o.x = cvt_pk_bf16(a[0], a[1]); o.y = cvt_pk_bf16(a[2], a[3]); o.z = cvt_pk_bf16(b[0], b[1]); o.w = cvt_pk_bf16(b[2], b[3]);
        *(LAS u32x4*)(W2s + k * P72 + q * 16) = o; }
    __syncthreads();
    const int lane = c.lane;
#pragma unroll
    for (int rt = 0; rt < 2; ++rt) {
        const int r0 = pm * 256 + c.wave * 32 + rt * 16;
        f32x4 acc[4];
#pragma unroll
        for (int dt = 0; dt < 4; ++dt) acc[dt] = (f32x4){0.f, 0.f, 0.f, 0.f};
        for (int ks = 0; ks < 8; ++ks) {
            const bf16x8 hf = *(const bf16x8*)(H1 + (size_t)(r0 + (lane & 15)) * 256 + 32 * ks + 8 * (lane >> 4));
#pragma unroll
            for (int dt = 0; dt < 4; ++dt) acc[dt] = MFMA16(frag_tr(W2s, P72, 32 * ks, 16 * dt, lane), hf, acc[dt]);
        }
#pragma unroll
        for (int dt = 0; dt < 4; ++dt) { u32x2 pk; pk.x = cvt_pk_bf16(acc[dt][0], acc[dt][1]); pk.y = cvt_pk_bf16(acc[dt][2], acc[dt][3]);
            *(u32x2*)(KC + (size_t)(r0 + (lane & 15)) * 64 + 16 * dt + 4 * (lane >> 4)) = pk; }
    }
}

typedef unsigned long long u64;
__device__ __forceinline__ int next_bit(u64 lo, u64 hi, int from) {
    if (from < 64) { const u64 m = lo & (~0ull << from); if (m) return __builtin_ctzll(m); from = 64; }
    if (from < 128) { const u64 m = hi & (~0ull << (from - 64)); if (m) return 64 + __builtin_ctzll(m); }
    return -1;
}
constexpr int NSA_D = 6, NSA_SLOT = 16384, NSA_RING = 0, NSA_IMP = NSA_D * NSA_SLOT, NSA_SELM = NSA_IMP + 8 * 8 * 132 * 4, NSA_END = NSA_SELM + 64 * 16;
static_assert(NSA_END <= LDS_WORK, "NSA LDS map");
__device__ __forceinline__ bf16x8 frag_row_sw(const LAS unsigned char* base, int row0, int k0, int lane) {
    const int r = row0 + (lane & 15), cc = (k0 >> 3) + (lane >> 4);
    return *(const LAS bf16x8*)(base + r * 128 + ((cc ^ ((r >> 1) & 7)) << 4));
}
__device__ __forceinline__ void vtr_half(bf16x8 (&vf)[2][2], unsigned a00, unsigned a01, unsigned a10, unsigned a11) {
    s16x4 t[2][2][2];
    asm volatile(
        "ds_read_b64_tr_b16 %0, %8\n\tds_read_b64_tr_b16 %1, %9\n\tds_read_b64_tr_b16 %2, %8 offset:4096\n\tds_read_b64_tr_b16 %3, %9 offset:4096\n\t"
        "ds_read_b64_tr_b16 %4, %10\n\tds_read_b64_tr_b16 %5, %11\n\tds_read_b64_tr_b16 %6, %10 offset:4096\n\tds_read_b64_tr_b16 %7, %11 offset:4096\n\t"
        "s_waitcnt lgkmcnt(0)"
        : "=&v"(t[0][0][0]), "=&v"(t[0][0][1]), "=&v"(t[0][1][0]), "=&v"(t[0][1][1]), "=&v"(t[1][0][0]), "=&v"(t[1][0][1]), "=&v"(t[1][1][0]), "=&v"(t[1][1][1])
        : "v"(a00), "v"(a01), "v"(a10), "v"(a11)
        : "memory");
#pragma unroll
    for (int dt = 0; dt < 2; ++dt)
#pragma unroll
        for (int ks = 0; ks < 2; ++ks) vf[dt][ks] = (bf16x8){t[dt][ks][0][0], t[dt][ks][0][1], t[dt][ks][0][2], t[dt][ks][0][3], t[dt][ks][1][0], t[dt][ks][1][1], t[dt][ks][1][2], t[dt][ks][1][3]};
}
__device__ __forceinline__ u64 uni64(u64 x) { return ((u64)(unsigned)__builtin_amdgcn_readfirstlane((int)(x >> 32)) << 32) | (u64)(unsigned)__builtin_amdgcn_readfirstlane((int)x); }
__device__ __forceinline__ void wait_vm_n(int n) {
    if (n >= 4) asm volatile("s_waitcnt vmcnt(4)" ::: "memory"); else if (n == 2) asm volatile("s_waitcnt vmcnt(2)" ::: "memory");
    else if (n == 1) asm volatile("s_waitcnt vmcnt(1)" ::: "memory"); else asm volatile("s_waitcnt vmcnt(0)" ::: "memory");
}
__device__ __forceinline__ bool bit128(u64 lo, u64 hi, int j) { return (j < 64) ? ((lo >> j) & 1ull) : ((hi >> (j - 64)) & 1ull); }
struct NsaRows {
    int ql, hg, kq;
    int t[2];
    int tmin, tmax;
    u64 selLo[2], selHi[2];
};
template <int MODE, int KIND, bool MASKED>
__device__ __forceinline__ void nsa_block(const LAS unsigned char* Ks, unsigned vbase, const unsigned (&voff)[4][2], LAS unsigned char* Ps, LAS float* imp, int j, int lane,
                                          const NsaRows& R, const bf16x8 (&qf)[2][2], float (&lrow)[2], f32x4 (&lacc)[2], const float (&invl)[2], f32x4 (&o)[2][4]) {
    const float NEGINF = -INFINITY;
    f32x4 s[2][4];
#pragma unroll
    for (int T = 0; T < 2; ++T) {
        float sinit = 0.f;
        if (KIND == 1) sinit = bit128(R.selLo[T], R.selHi[T], j) ? 0.f : NEGINF;
#pragma unroll
        for (int kt = 0; kt < 4; ++kt) s[T][kt] = (f32x4){sinit, sinit, sinit, sinit};
    }
#pragma unroll
    for (int kt = 0; kt < 4; ++kt) {
        const bf16x8 k0 = frag_row_sw(Ks, 16 * kt, 0, lane), k1 = frag_row_sw(Ks, 16 * kt, 32, lane);
#pragma unroll
        for (int T = 0; T < 2; ++T) { s[T][kt] = MFMA16(k0, qf[T][0], s[T][kt]); s[T][kt] = MFMA16(k1, qf[T][1], s[T][kt]); }
    }
    float p[2][4][4]; bf16x8 pf[2][2];
#pragma unroll
    for (int T = 0; T < 2; ++T) {
        if (MASKED) {
#pragma unroll
            for (int kt = 0; kt < 4; ++kt)
#pragma unroll
                for (int r = 0; r < 4; ++r) {
                    const int key = 64 * j + 16 * kt + 4 * R.kq + r;
                    bool ok;
                    if (KIND == 0) ok = (16 * key + 31 <= R.t[T]);
                    else if (KIND == 1) ok = (key <= R.t[T]);
                    else ok = (key <= R.t[T]) && (R.t[T] - key < 512);
                    s[T][kt][r] = ok ? s[T][kt][r] : NEGINF;
                }
        }
        float ps = 0.f;
#pragma unroll
        for (int kt = 0; kt < 4; ++kt)
#pragma unroll
            for (int r = 0; r < 4; ++r) { p[T][kt][r] = __builtin_amdgcn_exp2f(s[T][kt][r]); if (MODE == 1) ps += p[T][kt][r]; }
        if (MODE == 1) lrow[T] += ps;
        if (MODE == 2) {
#pragma unroll
            for (int kt = 0; kt < 4; ++kt)
#pragma unroll
                for (int r = 0; r < 4; ++r) p[T][kt][r] *= invl[T];
        }
        if (MODE != 1) {
#pragma unroll
            for (int ks = 0; ks < 2; ++ks) { u32x4 w; w.x = cvt_pk_bf16(p[T][2 * ks][0], p[T][2 * ks][1]); w.y = cvt_pk_bf16(p[T][2 * ks][2], p[T][2 * ks][3]);
                w.z = cvt_pk_bf16(p[T][2 * ks + 1][0], p[T][2 * ks + 1][1]); w.w = cvt_pk_bf16(p[T][2 * ks + 1][2], p[T][2 * ks + 1][3]); pf[T][ks] = __builtin_bit_cast(bf16x8, w); }
            if (MODE == 0) {
                const u32x4 o1 = (u32x4){0x3f803f80u, 0x3f803f80u, 0x3f803f80u, 0x3f803f80u}; const bf16x8 ones = __builtin_bit_cast(bf16x8, o1);
                lacc[T] = MFMA16(ones, pf[T][0], lacc[T]); lacc[T] = MFMA16(ones, pf[T][1], lacc[T]); }
        }
    }
    if (MODE == 2) {
#pragma unroll
        for (int T = 0; T < 2; ++T)
#pragma unroll
            for (int kt = 0; kt < 4; ++kt) {
                float q4[4];
#pragma unroll
                for (int r = 0; r < 4; ++r) { float v = p[T][kt][r]; v += __shfl_xor(v, 1); v += __shfl_xor(v, 2); q4[r] = v; }
                if (R.hg == 0) { LAS float* ip = imp + (4 * T + R.ql) * 132 + 16 * j + 4 * kt + R.kq;
                    ip[0] += 2.f * (q4[0] + q4[1] + q4[2]) + q4[3]; asm volatile("" ::: "memory"); ip[1] += q4[3]; asm volatile("" ::: "memory"); }
            }
    }
    if (MODE != 1) {
#pragma unroll
        for (int dh = 0; dh < 2; ++dh) {
            bf16x8 vf[2][2];
            vtr_half(vf, vbase + voff[2 * dh][0], vbase + voff[2 * dh][1], vbase + voff[2 * dh + 1][0], vbase + voff[2 * dh + 1][1]);
#pragma unroll
            for (int T = 0; T < 2; ++T)
#pragma unroll
                for (int d2 = 0; d2 < 2; ++d2) { o[T][2 * dh + d2] = MFMA16(vf[d2][0], pf[T][0], o[T][2 * dh + d2]); o[T][2 * dh + d2] = MFMA16(vf[d2][1], pf[T][1], o[T][2 * dh + d2]); }
        }
    }
}
template <int MODE, int KIND>
__device__ __forceinline__ void nsa_pass(const Ctx& c, u64 mlo_, u64 mhi_, u64 wlo_, u64 whi_, const bf16_t* Kg, const bf16_t* Vg,
                                         const NsaRows& R, const bf16x8 (&qf)[2][2], float (&lrow)[2], const float (&invl)[2], f32x4 (&o)[2][4]) {
    f32x4 lacc[2] = {(f32x4){0.f, 0.f, 0.f, 0.f}, (f32x4){0.f, 0.f, 0.f, 0.f}};
    const u64 mlo = uni64(mlo_), mhi = uni64(mhi_), wlo = uni64(wlo_), whi = uni64(whi_);
    LAS unsigned char* ring = c.lds + NSA_RING; LAS unsigned char* Ps = nullptr;
    LAS float* imp = (LAS float*)(c.lds + NSA_IMP) + c.wave * 8 * 132;
    int lane = c.lane; asm volatile("" : "+v"(lane));
    constexpr int LPB = (MODE == 1) ? 1 : 2;
    const int drow = 8 * c.wave + (lane >> 3), dch = (lane & 7) ^ ((drow >> 1) & 7);
    const size_t goff = (size_t)drow * 64 + 8 * dch;
    unsigned voff[4][2];
    { const int g = lane >> 4, q = (lane & 15) >> 2, p = lane & 3;
#pragma unroll
      for (int dt = 0; dt < 4; ++dt)
#pragma unroll
          for (int h = 0; h < 2; ++h) { const int r = 4 * g + q + 16 * h, col = 16 * dt + 4 * p; voff[dt][h] = (unsigned)(r * 128 + (((col >> 3) ^ ((r >> 1) & 7)) << 4) + (col & 7) * 2); } }
    const unsigned ring_addr = (unsigned)(uintptr_t)ring;
#define NSA_ISSUE(jb, slot) do { \
        __builtin_amdgcn_global_load_lds((const unsigned*)(Kg + (size_t)(jb) * 4096 + goff), (LAS unsigned*)(ring + (slot) * NSA_SLOT + c.wave * 1024), 16, 0, 0); \
        if (MODE != 1) __builtin_amdgcn_global_load_lds((const unsigned*)(Vg + (size_t)(jb) * 4096 + goff), (LAS unsigned*)(ring + (slot) * NSA_SLOT + 8192 + c.wave * 1024), 16, 0, 0); } while (0)
    VM_WAIT();
    __builtin_amdgcn_s_barrier();
#define NSA_COMPUTE(jb, nth) do { if (bit128(wlo, whi, (jb))) { \
            const LAS unsigned char* Ks = ring + ((nth) % NSA_D) * NSA_SLOT; const unsigned vbase = ring_addr + (unsigned)(((nth) % NSA_D) * NSA_SLOT + 8192); \
            bool full; \
            if (KIND == 0) full = (16 * (64 * (jb) + 63) + 31 <= R.tmin); else if (KIND == 1) full = (64 * (jb) + 63 <= R.tmin); else full = (64 * (jb) + 63 <= R.tmin) && (R.tmax - 64 * (jb) < 512); \
            if (full) nsa_block<MODE, KIND, false>(Ks, vbase, voff, Ps, imp, (jb), lane, R, qf, lrow, lacc, invl, o); \
            else nsa_block<MODE, KIND, true>(Ks, vbase, voff, Ps, imp, (jb), lane, R, qf, lrow, lacc, invl, o); } } while (0)
    int ji = next_bit(mlo, mhi, 0), nissued = 0;
    for (int k = 0; k < 4 && ji >= 0; ++k) { NSA_ISSUE(ji, nissued % NSA_D); ++nissued; ji = next_bit(mlo, mhi, ji + 1); }
    int ja = next_bit(mlo, mhi, 0), ncomp = 0;
    while (ja >= 0) {
        const int jb = next_bit(mlo, mhi, ja + 1);
        const int target = ncomp + (jb >= 0 ? 2 : 1);
        wait_vm_n((nissued - target) * LPB);
        __builtin_amdgcn_s_barrier();
        for (int k = 0; k < 2 && ji >= 0; ++k) { NSA_ISSUE(ji, nissued % NSA_D); ++nissued; ji = next_bit(mlo, mhi, ji + 1); }
        NSA_COMPUTE(ja, ncomp);
        if (jb >= 0) NSA_COMPUTE(jb, ncomp + 1);
        ncomp = target; ja = (jb >= 0) ? next_bit(mlo, mhi, jb + 1) : -1;
    }
#undef NSA_COMPUTE
#undef NSA_ISSUE
    if (MODE == 0) { lrow[0] = lacc[0][0]; lrow[1] = lacc[1][0]; }
}

__device__ __forceinline__ void nsa_unit(const Ctx& c, unsigned char* ws, int b, int g, int qb) {
    const bf16_t* PROJ = (const bf16_t*)(ws + WS_PROJ); const bf16_t* KC = (const bf16_t*)(ws + WS_KC); const bf16_t* KV = (const bf16_t*)(ws + WS_KV); bf16_t* Y = (bf16_t*)(ws + WS_Y);
    const int lane = c.lane, w = c.wave, q0 = 64 * qb;
    NsaRows R; R.ql = (lane & 15) >> 2; R.hg = lane & 3; R.kq = lane >> 4; R.tmin = q0 + 8 * w; R.tmax = R.tmin + 7;
    const int tumax = q0 + 63, hq = 4 * g + R.hg;
    constexpr float QSC = 0.125f * 1.4426950408889634f;
    bf16x8 qf[2][2]; f32x4 o[2][4]; float lrow[2], invl[2]; unsigned glp[2], glq[2];
#pragma unroll
    for (int T = 0; T < 2; ++T) {
        R.t[T] = R.tmin + 4 * T + R.ql; R.selLo[T] = 0ull; R.selHi[T] = 0ull;
        const size_t mrow0 = (size_t)(b * SEQ + R.t[T]) * NPROJ;
#pragma unroll
        for (int ks = 0; ks < 2; ++ks) { const u32x4 v = *(const u32x4*)(PROJ + mrow0 + PC_Q + 64 * hq + 32 * ks + 8 * R.kq);
            u32x4 x; x.x = cvt_pk_bf16(bflo(v.x) * QSC, bfhi(v.x) * QSC); x.y = cvt_pk_bf16(bflo(v.y) * QSC, bfhi(v.y) * QSC);
            x.z = cvt_pk_bf16(bflo(v.z) * QSC, bfhi(v.z) * QSC); x.w = cvt_pk_bf16(bflo(v.w) * QSC, bfhi(v.w) * QSC);
            qf[T][ks] = __builtin_bit_cast(bf16x8, x); }
#pragma unroll
        for (int dt = 0; dt < 4; ++dt) o[T][dt] = (f32x4){0.f, 0.f, 0.f, 0.f};
        lrow[T] = 0.f; invl[T] = 0.f;
        { const bf16_t* gp = PROJ + mrow0 + PC_GL + hq * 3; glp[T] = (unsigned)gp[0] | ((unsigned)gp[1] << 16); glq[T] = (unsigned)gp[2]; }
    }
    LAS float* imp = (LAS float*)(c.lds + NSA_IMP) + w * 8 * 132;
    LAS u64* selm = (LAS u64*)(c.lds + NSA_SELM);
    __syncthreads();
    for (int i = lane; i < 8 * 132; i += 64) imp[i] = 0.f;
    const bf16_t* kc = KC + (size_t)((b * 2 + g) * 512) * 64; const bf16_t* vc = kc + (size_t)2048 * 64;
    const int ncu = (tumax >= 31) ? ((tumax - 31) / 16) / 64 + 1 : 0;
    const int ncw = (R.tmax >= 31) ? ((R.tmax - 31) / 16) / 64 + 1 : 0;
    const u64 cmu = ncu ? (ncu >= 64 ? ~0ull : ((1ull << ncu) - 1ull)) : 0ull, cmw = ncw ? (ncw >= 64 ? ~0ull : ((1ull << ncw) - 1ull)) : 0ull;
    nsa_pass<1, 0>(c, cmu, 0ull, cmw, 0ull, kc, kc, R, qf, lrow, invl, o);
#pragma unroll
    for (int T = 0; T < 2; ++T) { float lt = lrow[T]; lt += __shfl_xor(lt, 16); lt += __shfl_xor(lt, 32); invl[T] = lt > 0.f ? 1.0f / lt : 0.f; }
    nsa_pass<2, 0>(c, cmu, 0ull, cmw, 0ull, kc, vc, R, qf, lrow, invl, o);
#pragma unroll
    for (int T = 0; T < 2; ++T) { const float gt = __builtin_amdgcn_rcpf(1.0f + __expf(-bflo(glp[T])));
        bf16_t* yp = Y + (size_t)(b * SEQ + R.t[T]) * DM + 1024 + 64 * hq + 4 * R.kq;
#pragma unroll
        for (int dt = 0; dt < 4; ++dt) { const f32x4 v = o[T][dt] * gt; u32x2 pk; pk.x = cvt_pk_bf16(v[0], v[1]); pk.y = cvt_pk_bf16(v[2], v[3]); *(u32x2*)(yp + 16 * dt) = pk; o[T][dt] = (f32x4){0.f, 0.f, 0.f, 0.f}; } }
    asm volatile("s_waitcnt lgkmcnt(0)" ::: "memory");
    for (int qi = 0; qi < 2; ++qi) {
        unsigned key[4][2]; bool valid2[4][2];
#pragma unroll
        for (int z = 0; z < 4; ++z) { const int cur = (R.tmin + qi + 2 * z) >> 6;
#pragma unroll
            for (int e = 0; e < 2; ++e) { const int jj = lane + 64 * e; valid2[z][e] = jj <= cur; const bool forced = (jj == 0) || (jj == cur) || (jj == cur - 1);
                const float v = imp[(qi + 2 * z) * 132 + jj] + (forced ? 1000.f : 0.f); key[z][e] = valid2[z][e] ? __float_as_uint(v) + 1u : 0u; } }
        unsigned T[4] = {0u, 0u, 0u, 0u};
        for (int bit = 31; bit >= 0; --bit) {
#pragma unroll
            for (int z = 0; z < 4; ++z) { const unsigned cand = T[z] | (1u << bit);
                const int cnt = __builtin_popcountll(__ballot(key[z][0] >= cand)) + __builtin_popcountll(__ballot(key[z][1] >= cand)); if (cnt >= 16) T[z] = cand; } }
        const u64 below = (1ull << lane) - 1ull;
#pragma unroll
        for (int z = 0; z < 4; ++z) {
            const u64 gt0 = __ballot(key[z][0] > T[z]), gt1 = __ballot(key[z][1] > T[z]), eq0 = __ballot(valid2[z][0] && key[z][0] == T[z]), eq1 = __ballot(valid2[z][1] && key[z][1] == T[z]);
            const int need = 16 - __builtin_popcountll(gt0) - __builtin_popcountll(gt1);
            const int re0 = __builtin_popcountll(eq0 & below), re1 = __builtin_popcountll(eq0) + __builtin_popcountll(eq1 & below);
            const u64 lo = __ballot(valid2[z][0] && (key[z][0] > T[z] || (key[z][0] == T[z] && re0 < need))), hi = __ballot(valid2[z][1] && (key[z][1] > T[z] || (key[z][1] == T[z] && re1 < need)));
            if (lane == 0) { selm[(8 * w + qi + 2 * z) * 2] = lo; selm[(8 * w + qi + 2 * z) * 2 + 1] = hi; } }
    }
    __syncthreads();
    u64 ulo = 0ull, uhi = 0ull, wlo = 0ull, whi = 0ull;
#pragma unroll 8
    for (int q = 0; q < 64; ++q) { const u64 a = selm[2 * q], bb = selm[2 * q + 1]; ulo |= a; uhi |= bb; if ((q >> 3) == w) { wlo |= a; whi |= bb; } }
#pragma unroll
    for (int T = 0; T < 2; ++T) { R.selLo[T] = selm[(8 * w + 4 * T + R.ql) * 2]; R.selHi[T] = selm[(8 * w + 4 * T + R.ql) * 2 + 1]; lrow[T] = 0.f; }
    nsa_pass<0, 1>(c, ulo, uhi, wlo, whi, KV + (size_t)((2 * 2 + b) * 2 + g) * 8192 * 64, KV + (size_t)((3 * 2 + b) * 2 + g) * 8192 * 64, R, qf, lrow, invl, o);
#pragma unroll
    for (int T = 0; T < 2; ++T) { const float lt = lrow[T]; lrow[T] = 0.f;
        const float gt = __builtin_amdgcn_rcpf(1.0f + __expf(-bfhi(glp[T]))); const float sc = lt > 0.f ? gt / lt : 0.f;
        bf16_t* yp = Y + (size_t)(b * SEQ + R.t[T]) * DM + 1024 + 64 * hq + 4 * R.kq;
#pragma unroll
        for (int dt = 0; dt < 4; ++dt) { const f32x4 v = o[T][dt] * sc; const u32x2 y0 = *(const u32x2*)(yp + 16 * dt); u32x2 pk; pk.x = cvt_pk_bf16(bflo(y0.x) + v[0], bfhi(y0.x) + v[1]); pk.y = cvt_pk_bf16(bflo(y0.y) + v[2], bfhi(y0.y) + v[3]);
            *(u32x2*)(yp + 16 * dt) = pk; o[T][dt] = (f32x4){0.f, 0.f, 0.f, 0.f}; } }
    {
        const int jhi = tumax >> 6, jlo = (q0 - 511) > 0 ? ((q0 - 511) >> 6) : 0;
        const int wjhi = R.tmax >> 6, wjlo = (R.tmin - 511) > 0 ? ((R.tmin - 511) >> 6) : 0;
        u64 alo = 0ull, ahi = 0ull, blo = 0ull, bhi = 0ull;
        for (int jj = jlo; jj <= jhi; ++jj) { if (jj < 64) alo |= 1ull << jj; else ahi |= 1ull << (jj - 64); }
        for (int jj = wjlo; jj <= wjhi; ++jj) { if (jj < 64) blo |= 1ull << jj; else bhi |= 1ull << (jj - 64); }
        nsa_pass<0, 2>(c, alo, ahi, blo, bhi, KV + (size_t)((4 * 2 + b) * 2 + g) * 8192 * 64, KV + (size_t)((5 * 2 + b) * 2 + g) * 8192 * 64, R, qf, lrow, invl, o);
#pragma unroll
        for (int T = 0; T < 2; ++T) { const float lt = lrow[T];
            const float gt = __builtin_amdgcn_rcpf(1.0f + __expf(-bflo(glq[T]))); const float sc = lt > 0.f ? gt / lt : 0.f;
            bf16_t* yp = Y + (size_t)(b * SEQ + R.t[T]) * DM + 1024 + 64 * hq + 4 * R.kq;
#pragma unroll
            for (int dt = 0; dt < 4; ++dt) { const f32x4 v = o[T][dt] * sc; const u32x2 y0 = *(const u32x2*)(yp + 16 * dt); u32x2 pk; pk.x = cvt_pk_bf16(bflo(y0.x) + v[0], bfhi(y0.x) + v[1]); pk.y = cvt_pk_bf16(bflo(y0.y) + v[2], bfhi(y0.y) + v[3]);
                *(u32x2*)(yp + 16 * dt) = pk; } }
    }
}

#ifndef PH5_MASK
#define PH5_MASK 31
#endif
#ifndef WGM_IN
#define WGM_IN 4
#endif
#ifndef WGM_GU
#define WGM_GU 4
#endif
#ifndef WGM_N8
#define WGM_N8 2
#endif
#ifndef DUP5A
#define DUP5A 0
#endif
#ifndef DUP5C
#define DUP5C 0
#endif
#ifndef DUP7A
#define DUP7A 0
#endif
#ifndef DUP7B
#define DUP7B 0
#endif
#ifndef DUP_MASK
#define DUP_MASK 0
#endif
#ifndef PH_MASK
#define PH_MASK 0x1fff
#endif
constexpr int NPH = 13;
struct Params { const float* in[31]; float* out; unsigned char* ws; int l_lo, l_hi, p_lo, p_hi; };
enum { I_X = 0, I_F1PRE, I_F1GU, I_F1D, I_F1POST, I_MPRE, I_WIN, I_SCW, I_SCB, I_SDTB, I_SALOG, I_SD, I_SNW, I_KPE, I_KW1, I_KB1, I_KW2, I_VPE, I_VW1, I_VB1, I_VW2,
       I_CW, I_CB, I_CLW, I_CLB, I_WOUT, I_MPOST, I_F2PRE, I_F2GU, I_F2D, I_F2POST };

template <int l>
__device__ __forceinline__ void run_layer(const Ctx& c, const Params& P, const XcdBarrier& bar, unsigned char* ws) {
    bf16_t* U = (bf16_t*)(ws + WS_U); bf16_t* T = (bf16_t*)(ws + WS_T); bf16_t* HID = (bf16_t*)(ws + WS_HID); bf16_t* PROJ = (bf16_t*)(ws + WS_PROJ); bf16_t* Y = (bf16_t*)(ws + WS_Y);
    float* RS = (float*)(ws + WS_RS);
    {
        const int plo = (l == P.l_lo) ? P.p_lo : 0, phi = (l == P.l_hi - 1) ? P.p_hi : NPH;
#define IN(k) (((PH_MASK >> (k)) & 1) && plo <= (k) && (k) < phi)
#define REPS(k) ((((DUP_MASK) >> (k)) & 1) ? 2 : 1)
#define SEAM(k) do { if (!(l == P.l_hi - 1 && (k) == P.p_hi - 1)) xcd_barrier(bar); } while (0)
        if (IN(0) && l == 0) _Pragma("unroll") for (int rep = 0; rep < REPS(0); ++rep) {
            LayerW LW; LW.gu1 = P.in[I_F1GU] + (size_t)l * DM * 2 * DFF; LW.d1 = P.in[I_F1D] + (size_t)l * DFF * DM; LW.gu2 = P.in[I_F2GU] + (size_t)l * DM * 2 * DFF; LW.d2 = P.in[I_F2D] + (size_t)l * DFF * DM;
            LW.win = P.in[I_WIN] + (size_t)l * DM * DIN; LW.wout = P.in[I_WOUT] + (size_t)l * DM * DM; LW.w1k = P.in[I_KW1] + (size_t)l * 2048 * 256; LW.w1v = P.in[I_VW1] + (size_t)l * 2048 * 256;
            LW.kpe = P.in[I_KPE] + (size_t)l * 2048; LW.vpe = P.in[I_VPE] + (size_t)l * 2048; LW.pre1 = P.in[I_F1PRE] + l * DM; LW.prem = P.in[I_MPRE] + l * DM; LW.pre2 = P.in[I_F2PRE] + l * DM;
            phase_convert(c, LW, ws);
            if (l == 0) {
                phase_norm(c, P.in[I_X], nullptr, 0.f, nullptr, U, RS, nullptr);
                for (int i = c.bid * NTHR + c.tid; i < 65536; i += c.G * NTHR) ((u32x4*)(ws + WS_KV + 6 * 4 * 8192 * 64 * 2))[i] = (u32x4){0u, 0u, 0u, 0u};
            }
            SEAM(0);
        }
        if (IN(1)) _Pragma("unroll") for (int rep = 0; rep < REPS(1); ++rep) {
            pg8::Gemm g{U, (const bf16_t*)(ws + WS_WGU1), M, 2 * DFF, DM, DM, 128, 0}; pg8::StaticOrder S; S.init(M, 2 * DFF, c.G, c.bid, WGM_GU);
            pg8::EpiSwiglu E{HID, DFF, RS};
            pg8::gemm_phase<pg8::EpiSwiglu, pg8::StaticOrder, true, true>(c.lds, g, S, E);
            SEAM(1);
        }
        if (IN(2)) _Pragma("unroll") for (int rep = 0; rep < REPS(2); ++rep) {
            pg8::Gemm g{HID, (const bf16_t*)(ws + WS_WD1), M, DM, DFF, DFF, 128, 0}; pg8::StaticOrder S; S.init(M, DM, c.G, c.bid, WGM_N8);
            pg8::EpiStore E{T, DM};
            pg8::gemm_phase<pg8::EpiStore, pg8::StaticOrder, true, true>(c.lds, g, S, E);
            SEAM(2);
        }
        if (IN(3)) { phase_norm(c, nullptr, T, 0.5f, P.in[I_F1POST] + l * DM, U, RS, nullptr); SEAM(3); }
        if (IN(4)) _Pragma("unroll") for (int rep = 0; rep < REPS(4); ++rep) {
            pg8::Gemm g{U, (const bf16_t*)(ws + WS_WIN), M, NPROJ, DM, DM, 128, 0}; pg8::StaticOrder S; S.init(M, NPROJ, c.G, c.bid, WGM_IN);
            pg8::EpiProj E{PROJ, NPROJ, (bf16_t*)(ws + WS_KV), RS};
            pg8::gemm_phase<pg8::EpiProj, pg8::StaticOrder, true, true>(c.lds, g, S, E);
            SEAM(4);
        }
        SsdW SW; SW.conv_w = P.in[I_SCW] + (size_t)l * 4 * 1536; SW.conv_b = P.in[I_SCB] + l * 1536; SW.dt_bias = P.in[I_SDTB] + l * 16; SW.a_log = P.in[I_SALOG] + l * 16; SW.dskip = P.in[I_SD] + l * 16; SW.norm_w = P.in[I_SNW] + l * 1024;
        if (IN(5)) _Pragma("unroll") for (int rep = 0; rep < REPS(5); ++rep) {
            if (PH5_MASK & 1) for (int u = c.bid; u < 256 * (1 + DUP5A); u += c.G) ssd_a_unit(c, SW, ws, u & 255);
            if ((PH5_MASK & 2) && c.bid < 16) { const int cu = c.bid;
                const int kv = cu >> 3, pm = cu & 7;
                __syncthreads();
                pg8::Gemm g{(const bf16_t*)(ws + WS_KV) + (size_t)kv * 4 * 8192 * 64, (const bf16_t*)(ws + WS_W1) + (size_t)kv * 256 * DM, 2048, 256, 2048, 1024, 128, 0};
                pg8::OneUnit S; S.u0.pm = pm; S.u0.pn = 0;
                bf16_t* H1 = (bf16_t*)(ws + WS_H1) + (size_t)kv * 2048 * 256;
                LAS float* biasS = (LAS float*)(c.lds + 131072);
                if (c.tid < 256) { const float* b1 = (kv ? P.in[I_VB1] : P.in[I_KB1]) + l * 256; const float* pep = (const float*)(ws + WS_PEP) + kv * 256 * 256;
                    float sb = b1[c.tid];
#pragma unroll 8
                    for (int q = 0; q < 256; ++q) sb += pep[q * 256 + c.tid];
                    biasS[c.tid] = sb; }
                __syncthreads();
                pg8::EpiBiasSilu E{H1, 256, biasS};
                pg8::gemm_phase<pg8::EpiBiasSilu, pg8::OneUnit, false, true>(c.lds, g, S, E);
                nsa_cmp2(c, (kv ? P.in[I_VW2] : P.in[I_KW2]) + (size_t)l * 256 * 64, H1, (bf16_t*)(ws + WS_KC) + (size_t)kv * 2048 * 64, pm);
            }
            CnvW CW; CW.dw_w = P.in[I_CW] + (size_t)l * 31 * 512; CW.dw_b = P.in[I_CB] + l * 512; CW.ln_w = P.in[I_CLW] + l * 512; CW.ln_b = P.in[I_CLB] + l * 512;
            if (PH5_MASK & 4) { if (c.G > 32) { if (c.bid >= 16) for (int u = c.bid - 16; u < 512 * (1 + DUP5C); u += c.G - 16) cnv_unit(c, CW, ws, u & 511); }
            else for (int u = c.bid; u < 512; u += c.G) cnv_unit(c, CW, ws, u); }
            SEAM(5);
        }
        const bool split67 = IN(6) && IN(7);
        if (IN(6)) { phase_ssd_scan(c, ws); if (split67) xcd_barrier_arrive(bar); else SEAM(6); }
        if (IN(7)) _Pragma("unroll") for (int rep = 0; rep < REPS(7); ++rep) {
            if (PH5_MASK & 16) for (int v0 = c.bid; v0 < 256 * (1 + DUP7B); v0 += c.G) { const int v = v0 & 255;
                const int bg = v & 3, jq = v >> 2;
                for (int e = 0; e < 2; ++e) { const int qb = (e == 0) ? 127 - jq : jq; nsa_unit(c, ws, bg >> 1, bg & 1, qb); }
            }
            if (split67 && rep == 0) xcd_barrier_wait(bar);
            if (PH5_MASK & 8) for (int u = c.bid; u < 256 * (1 + DUP7A); u += c.G) ssd_b_unit(c, SW, ws, u & 255);
            SEAM(7);
        }
        if (IN(8)) _Pragma("unroll") for (int rep = 0; rep < REPS(8); ++rep) {
            pg8::Gemm g{Y, (const bf16_t*)(ws + WS_WOUT), M, DM, DM, DM, 128, 0}; pg8::StaticOrder S; S.init(M, DM, c.G, c.bid, WGM_N8);
            pg8::EpiStore E{T, DM};
            pg8::gemm_phase<pg8::EpiStore, pg8::StaticOrder, true, true>(c.lds, g, S, E);
            SEAM(8);
        }
        if (IN(9)) { phase_norm(c, nullptr, T, 1.0f, P.in[I_MPOST] + l * DM, U, RS, nullptr); SEAM(9); }
        if (IN(10)) _Pragma("unroll") for (int rep = 0; rep < REPS(10); ++rep) {
            pg8::Gemm g{U, (const bf16_t*)(ws + WS_WGU2), M, 2 * DFF, DM, DM, 128, 0}; pg8::StaticOrder S; S.init(M, 2 * DFF, c.G, c.bid, WGM_GU);
            pg8::EpiSwiglu E{HID, DFF, RS};
            pg8::gemm_phase<pg8::EpiSwiglu, pg8::StaticOrder, true, true>(c.lds, g, S, E);
            SEAM(10);
        }
        if (IN(11)) _Pragma("unroll") for (int rep = 0; rep < REPS(11); ++rep) {
            pg8::Gemm g{HID, (const bf16_t*)(ws + WS_WD2), M, DM, DFF, DFF, 128, 0}; pg8::StaticOrder S; S.init(M, DM, c.G, c.bid, WGM_N8);
            pg8::EpiStore E{T, DM};
            pg8::gemm_phase<pg8::EpiStore, pg8::StaticOrder, true, true>(c.lds, g, S, E);
            SEAM(11);
        }
        if (IN(12)) {
            phase_norm(c, nullptr, T, 0.5f, P.in[I_F2POST] + l * DM, U, RS, (l + 1 < DEPTH) ? nullptr : P.out);
            if (l + 1 < DEPTH) {
                const int n = l + 1;
                LayerW LW; LW.gu1 = P.in[I_F1GU] + (size_t)n * DM * 2 * DFF; LW.d1 = P.in[I_F1D] + (size_t)n * DFF * DM; LW.gu2 = P.in[I_F2GU] + (size_t)n * DM * 2 * DFF; LW.d2 = P.in[I_F2D] + (size_t)n * DFF * DM;
                LW.win = P.in[I_WIN] + (size_t)n * DM * DIN; LW.wout = P.in[I_WOUT] + (size_t)n * DM * DM; LW.w1k = P.in[I_KW1] + (size_t)n * 2048 * 256; LW.w1v = P.in[I_VW1] + (size_t)n * 2048 * 256;
                LW.kpe = P.in[I_KPE] + (size_t)n * 2048; LW.vpe = P.in[I_VPE] + (size_t)n * 2048; LW.pre1 = P.in[I_F1PRE] + n * DM; LW.prem = P.in[I_MPRE] + n * DM; LW.pre2 = P.in[I_F2PRE] + n * DM;
                phase_convert(c, LW, ws);
            }
            SEAM(12);
        }
#undef IN
#undef SEAM
    }
}

__global__ void __launch_bounds__(NTHR, 2) mega_fwd(Params P) {
    extern __shared__ __attribute__((aligned(16))) unsigned char lds_raw[];
    Ctx c; c.lds = (LAS unsigned char*)lds_raw; c.tid = threadIdx.x; c.lane = c.tid & 63; c.wave = __builtin_amdgcn_readfirstlane(c.tid >> 6); c.G = gridDim.x; c.bid = blockIdx.x;
    unsigned char* ws = P.ws;
    volatile LAS unsigned* MISC = (volatile LAS unsigned*)(c.lds + LDS_CTL_OFF);
    if (c.tid < 32) MISC[c.tid] = 0u;
    __syncthreads();
    const bool multi = !((P.l_hi - P.l_lo) == 1 && (P.p_hi - P.p_lo) == 1);
    XcdBarrier bar; bar.bar = (unsigned*)(ws + WS_CTL) + 4096; bar.x = 0; bar.st = MISC + 8;
    if (multi) bar = xcd_barrier_post((unsigned*)(ws + WS_CTL) + 4096, MISC + 8);

    if (0 >= P.l_lo && 0 < P.l_hi) run_layer<0>(c, P, bar, ws);
    if (1 >= P.l_lo && 1 < P.l_hi) run_layer<1>(c, P, bar, ws);
    if (2 >= P.l_lo && 2 < P.l_hi) run_layer<2>(c, P, bar, ws);
    if (3 >= P.l_lo && 3 < P.l_hi) run_layer<3>(c, P, bar, ws);
}

extern "C" void kernel_launch(void* const* d_in, const int* in_sizes, int n_in, void* d_out, int out_size, void* d_ws, size_t ws_size, hipStream_t stream) {
    static int grid = 0;
    if (grid == 0) {
        if (n_in != 31 || in_sizes[0] != M * DM || out_size != M * DM || ws_size < WS_END) { fprintf(stderr, "kernel_launch: unexpected shapes (n_in %d, in0 %d, out %d, ws %zu); nothing launched\n", n_in, n_in > 0 ? in_sizes[0] : -1, out_size, ws_size); grid = -1; return; }
        int dev = 0, cus = 0, per_cu = 0;
        if (hipGetDevice(&dev) != hipSuccess || hipDeviceGetAttribute(&cus, hipDeviceAttributeMultiprocessorCount, dev) != hipSuccess) { grid = -1; return; }
        if (hipFuncSetAttribute((const void*)mega_fwd, hipFuncAttributeMaxDynamicSharedMemorySize, LDS_BYTES) != hipSuccess) { fprintf(stderr, "kernel_launch: hipFuncSetAttribute failed\n"); grid = -1; return; }
        if (hipOccupancyMaxActiveBlocksPerMultiprocessor(&per_cu, (const void*)mega_fwd, NTHR, LDS_BYTES) != hipSuccess || per_cu < 1) { fprintf(stderr, "kernel_launch: occupancy query says %d\n", per_cu); per_cu = 1; }
        (void)hipGetLastError();
        grid = cus;
    }
    if (grid < 0) return;
    if (hipMemsetAsync((char*)d_ws + WS_CTL, 0, CTL_ZERO_BYTES, stream) != hipSuccess) return;
    Params p{};
    for (int i = 0; i < 31; ++i) p.in[i] = (const float*)d_in[i];
    p.out = (float*)d_out; p.ws = (unsigned char*)d_ws;
#if MK_PER_PHASE
    for (int l = 0; l < DEPTH; ++l)
        for (int k = 0; k < NPH; ++k) { p.l_lo = l; p.l_hi = l + 1; p.p_lo = k; p.p_hi = k + 1; hipLaunchKernelGGL(mega_fwd, dim3(grid), dim3(NTHR), LDS_BYTES, stream, p); }
#else
    p.l_lo = 0; p.l_hi = DEPTH; p.p_lo = 0; p.p_hi = NPH;
    hipLaunchKernelGGL(mega_fwd, dim3(grid), dim3(NTHR), LDS_BYTES, stream, p);
#endif
}
```
